# Optimizing an MI355X kernel written in HIP

```python
import functools
import jax, jax.numpy as jnp
from jax import lax
import numpy as np


D_MODEL = 1024
BATCH = 8
SEQ = 2048
DEPTH = 1
DEC_BATCH = 128
DEC_SEQ = 8
PAST_LEN = 2048
PAGE_SIZE = 128

N_HEADS = 8
HEAD_DIM = 64
D_ATTN = N_HEADS * HEAD_DIM
D_CONV = D_MODEL - D_ATTN
D_MIX = D_ATTN + D_CONV
D_IN = 3 * D_ATTN + 2 * D_CONV
PATTERNS = ((128, 1), (512, 4), (2048, 16))
WIN_MAX = max(w for w, _ in PATTERNS)
CONV_WIDTH = 31
D_FF = ((-(-8 * D_MODEL // 3) + 255) // 256) * 256
BLK = 128
RMS_EPS = 1e-6
LN_EPS = 1e-5
ATTN_SCALE = HEAD_DIM ** -0.5

kernel_name = 'hymba_dilated_conformer_decode_step'


def _rms_norm(x, g):
    xf = x.astype(jnp.float32)
    y = xf * lax.rsqrt(jnp.mean(xf * xf, axis=-1, keepdims=True) + RMS_EPS)
    return (y * g.astype(jnp.float32)).astype(x.dtype)


def _layer_norm(x, g, b):
    xf = x.astype(jnp.float32)
    xc = xf - jnp.mean(xf, axis=-1, keepdims=True)
    y = xc * lax.rsqrt(jnp.mean(xc * xc, axis=-1, keepdims=True) + LN_EPS)
    return (y * g.astype(jnp.float32) + b.astype(jnp.float32)).astype(x.dtype)


def _dilated_band_prompt(q, k, v, window, dilation):
    B, S, H, Dh = q.shape
    n_sub = window // dilation
    span = dilation * BLK
    s_pad = -(-S // span) * span
    L = s_pad // dilation
    nb = L // BLK

    def to_blocks(t):
        t = jnp.pad(t, ((0, 0), (0, s_pad - S), (0, 0), (0, 0)))
        t = t.reshape(B, L, dilation, H, Dh).transpose(0, 2, 1, 3, 4)
        return t.reshape(B, dilation, nb, BLK, H, Dh)

    def with_prev(t):
        prev = jnp.pad(t, ((0, 0), (0, 0), (1, 0), (0, 0), (0, 0), (0, 0)))[:, :, :-1]
        return jnp.concatenate([prev, t], axis=3)

    qb = to_blocks(q)
    kk = with_prev(to_blocks(k))
    vv = with_prev(to_blocks(v))
    s = jnp.einsum('brnqhd,brnkhd->brnhqk', qb, kk).astype(jnp.float32) * ATTN_SCALE
    qi = jnp.arange(BLK)[:, None]
    ki = jnp.arange(2 * BLK)[None, :]
    dist = BLK + qi - ki
    band = (dist >= 0) & (dist <= n_sub)
    blk = jnp.arange(nb)[:, None, None]
    valid = band[None] & (blk * BLK + ki[None] - BLK >= 0)
    s = jnp.where(valid[None, None, :, None], s, -jnp.inf)
    m = jnp.max(s, axis=-1, keepdims=True)
    p = jnp.exp(s - m)
    l = jnp.sum(p, axis=-1, keepdims=True)
    o = jnp.einsum('brnhqk,brnkhd->brnqhd', p / l, vv.astype(jnp.float32))
    lse = jnp.swapaxes((m + jnp.log(l))[..., 0], 3, 4)
    o = o.reshape(B, dilation, L, H, Dh).transpose(0, 2, 1, 3, 4).reshape(B, s_pad, H, Dh)[:, :S]
    lse = lse.reshape(B, dilation, L, H).transpose(0, 2, 1, 3).reshape(B, s_pad, H)[:, :S]
    return o, lse


def _dilated_gather_sample(q, k_all, v_all, window, dilation):
    T = q.shape[1]
    lb = k_all.shape[1] - T
    n_sub = window // dilation
    idx = lb + jnp.arange(T)[:, None] - dilation * jnp.arange(n_sub + 1)[None, :]
    valid = idx >= 0
    idx = jnp.maximum(idx, 0)
    kg = k_all[:, idx]
    vg = v_all[:, idx]
    s = jnp.einsum('bthd,btjhd->bthj', q, kg).astype(jnp.float32) * ATTN_SCALE
    s = jnp.where(valid[None, :, None, :], s, -jnp.inf)
    m = jnp.max(s, axis=-1, keepdims=True)
    p = jnp.exp(s - m)
    l = jnp.sum(p, axis=-1, keepdims=True)
    o = jnp.einsum('bthj,btjhd->bthd', p / l, vg.astype(jnp.float32))
    lse = (m + jnp.log(l))[..., 0]
    return o, lse


def _combine(results):
    o = jnp.stack([r[0] for r in results])
    lse = jnp.stack([r[1] for r in results])
    w = jax.nn.softmax(lse, axis=0)
    return jnp.sum(w[..., None] * o, axis=0)


def _attend_prompt(q, k, v):
    S = q.shape[1]
    out = _combine([_dilated_band_prompt(q, k, v, w, r) for w, r in PATTERNS])
    keep = min(WIN_MAX, S)
    return out, k[:, S - keep:], v[:, S - keep:]


def _attend_sample(q, k, v, k_buf, v_buf):
    k_all = jnp.concatenate([k_buf.astype(k.dtype), k], axis=1)
    v_all = jnp.concatenate([v_buf.astype(v.dtype), v], axis=1)
    out = _combine([_dilated_gather_sample(q, k_all, v_all, w, r) for w, r in PATTERNS])
    keep = min(WIN_MAX, k_all.shape[1])
    return out, k_all[:, -keep:], v_all[:, -keep:]


def _causal_depthwise(u_ext, w, b):
    out = lax.conv_general_dilated(u_ext, w[:, None, :].astype(u_ext.dtype), window_strides=(1,),
                                   padding='VALID', dimension_numbers=('NWC', 'WIO', 'NWC'),
                                   feature_group_count=u_ext.shape[-1])
    return out + b.astype(out.dtype)


def _layer(x, conv_left, attend, attn_norm_g, w_in, q_norm_g, k_norm_g, conv_w, conv_b,
           conv_ln_g, conv_ln_b, w_out, ffn_norm_g, w_gate, w_up, w_down):
    N, T, _ = x.shape
    h = _rms_norm(x, attn_norm_g)
    z = h @ w_in
    q, k, v, a, g = jnp.split(z, [D_ATTN, 2 * D_ATTN, 3 * D_ATTN, 3 * D_ATTN + D_CONV], axis=-1)
    q = _rms_norm(q.reshape(N, T, N_HEADS, HEAD_DIM), q_norm_g)
    k = _rms_norm(k.reshape(N, T, N_HEADS, HEAD_DIM), k_norm_g)
    v = v.reshape(N, T, N_HEADS, HEAD_DIM)
    attn, k_state, v_state = attend(q, k, v)
    u = a * jax.nn.sigmoid(g)
    u_ext = jnp.concatenate([conv_left.astype(u.dtype), u], axis=1)
    c = _causal_depthwise(u_ext, conv_w, conv_b)
    c = jax.nn.silu(_layer_norm(c, conv_ln_g, conv_ln_b))
    mix = jnp.concatenate([attn.reshape(N, T, D_ATTN).astype(x.dtype), c.astype(x.dtype)], axis=-1)
    x = x + mix @ w_out
    h = _rms_norm(x, ffn_norm_g)
    x = x + (jax.nn.silu(h @ w_gate) * (h @ w_up)) @ w_down
    return x, k_state, v_state, u_ext[:, -(CONV_WIDTH - 1):]


def setup_inputs(seed: int = 0) -> dict:
    key = jax.random.key(seed)
    ks = jax.random.split(key, 18)
    f32 = jnp.float32
    l_buf = min(WIN_MAX, PAST_LEN)

    def nrm(k, shape, scale):
        return scale * jax.random.normal(k, shape, f32)

    return {
        'x_prompt': nrm(ks[0], (BATCH, SEQ, D_MODEL), 1.0),
        'x_sample': nrm(ks[1], (DEC_BATCH, DEC_SEQ, D_MODEL), 1.0),
        'cache_k': nrm(ks[2], (DEPTH, DEC_BATCH, l_buf, N_HEADS, HEAD_DIM), 1.0),
        'cache_v': nrm(ks[3], (DEPTH, DEC_BATCH, l_buf, N_HEADS, HEAD_DIM), 1.0),
        'state_conv': nrm(ks[4], (DEPTH, DEC_BATCH, CONV_WIDTH - 1, D_CONV), 0.5),
        'attn_norm_g': 1.0 + nrm(ks[5], (DEPTH, D_MODEL), 0.02),
        'w_in': nrm(ks[6], (DEPTH, D_MODEL, D_IN), D_MODEL ** -0.5),
        'q_norm_g': 1.0 + nrm(ks[7], (DEPTH, HEAD_DIM), 0.02),
        'k_norm_g': 1.0 + nrm(ks[8], (DEPTH, HEAD_DIM), 0.02),
        'conv_w': nrm(ks[9], (DEPTH, CONV_WIDTH, D_CONV), CONV_WIDTH ** -0.5),
        'conv_b': nrm(ks[10], (DEPTH, D_CONV), 0.02),
        'conv_ln_g': 1.0 + nrm(ks[11], (DEPTH, D_CONV), 0.02),
        'conv_ln_b': nrm(ks[12], (DEPTH, D_CONV), 0.02),
        'w_out': nrm(ks[13], (DEPTH, D_MIX, D_MODEL), D_MIX ** -0.5),
        'ffn_norm_g': 1.0 + nrm(ks[14], (DEPTH, D_MODEL), 0.02),
        'w_gate': nrm(ks[15], (DEPTH, D_MODEL, D_FF), D_MODEL ** -0.5),
        'w_up': nrm(ks[16], (DEPTH, D_MODEL, D_FF), D_MODEL ** -0.5),
        'w_down': nrm(ks[17], (DEPTH, D_FF, D_MODEL), D_FF ** -0.5),
    }


def reference(x_prompt, x_sample, cache_k, cache_v, state_conv, attn_norm_g, w_in, q_norm_g,
              k_norm_g, conv_w, conv_b, conv_ln_g, conv_ln_b, w_out, ffn_norm_g, w_gate, w_up, w_down):
    y_p, y_s = x_prompt, x_sample
    nk_p, nv_p, nc_p, nk_s, nv_s, nc_s = [], [], [], [], [], []
    for l in range(DEPTH):
        w = (attn_norm_g[l], w_in[l], q_norm_g[l], k_norm_g[l], conv_w[l], conv_b[l],
             conv_ln_g[l], conv_ln_b[l], w_out[l], ffn_norm_g[l], w_gate[l], w_up[l], w_down[l])
        zeros_left = jnp.zeros((y_p.shape[0], CONV_WIDTH - 1, D_CONV), y_p.dtype)
        y_p, kp, vp, cp = _layer(y_p, zeros_left, _attend_prompt, *w)
        attend_s = functools.partial(_attend_sample, k_buf=cache_k[l], v_buf=cache_v[l])
        y_s, ks_, vs_, cs_ = _layer(y_s, state_conv[l], attend_s, *w)
        nk_p.append(kp)
        nv_p.append(vp)
        nc_p.append(cp)
        nk_s.append(ks_)
        nv_s.append(vs_)
        nc_s.append(cs_)
    return (y_p, y_s, jnp.stack(nk_p), jnp.stack(nv_p), jnp.stack(nc_p),
            jnp.stack(nk_s), jnp.stack(nv_s), jnp.stack(nc_s))
```

```cpp
#include <hip/hip_runtime.h>
#include <cstdio>
#include <cstdint>
#include <cmath>
namespace pg8 {
#define PG8_LAS __attribute__((address_space(3)))
typedef unsigned short bf16_t;
typedef short bf16x8 __attribute__((ext_vector_type(8)));
typedef float f32x4 __attribute__((ext_vector_type(4)));
typedef unsigned u32x4 __attribute__((ext_vector_type(4)));
constexpr int BM = 256, BK = 64, HALF = 128, HTB = HALF * BK * 2  , STAGE_BYTES = 8 * HTB, NXCD = 8, WGM = 8;

__host__ __device__ __forceinline__ int lds_byte(int r, int c) { const int st = (r >> 4) * 2 + (c >> 5), rr = r & 15, cc = c & 31, ob = rr * 64 + cc * 2; return st * 1024 + (ob ^ (((ob >> 9) & 1) << 5)); }
__host__ __device__ __forceinline__ void stage_rc(int b, int& R, int& C) { const int st = b / 1024, sb = b % 1024, swz = sb ^ (((sb >> 9) & 1) << 5); R = (st >> 1) * 16 + swz / 64; C = (st & 1) * 32 + (swz % 64) / 2; }
__host__ __device__ __forceinline__ int perm32(int rho) { const int n = rho >> 4, i = rho & 15; return 8 * (i >> 2) + 4 * n + (i & 3); }

struct Unit { int pm, pn; };
struct Gemm { const bf16_t* A; const bf16_t* Bt; int M, N, K; };

struct StaticOrder {
    int nM, nN, nwg, G, c;
    __host__ __device__ void init(int M, int N, int G_, int c_) { nM = M / BM; nN = N / BM; nwg = nM * nN; G = G_; c = c_; }
    __host__ __device__ bool next(int i, Unit& u) const {
        const long L = (long)i * G + c; if (L >= nwg) return false;
        int wgid = (int)L; { const int q = nwg / NXCD, r = nwg % NXCD, xcd = wgid % NXCD, off = wgid / NXCD; wgid = (xcd < r ? xcd * (q + 1) : r * (q + 1) + (xcd - r) * q) + off; }
        const int nig = WGM * nN, gid = wgid / nig, fm = gid * WGM, gsz = (nM - fm) < WGM ? (nM - fm) : WGM;
        u.pm = fm + ((wgid % nig) % gsz); u.pn = (wgid % nig) / gsz; return true;
    }
    __device__ __forceinline__ void a_ready(const Unit&) const {}
    __device__ __forceinline__ void done(const Unit&) const {}
};

__device__ __forceinline__ unsigned cvt_pk_bf16(float lo, float hi) { unsigned r; asm volatile("v_cvt_pk_bf16_f32 %0, %1, %2" : "=v"(r) : "v"(lo), "v"(hi)); return r; }
constexpr int E_MP = 16384;
constexpr size_t EO_KP = 17825792, EO_VP = 26214400, EO_KS = 34725888, EO_VS = 168943616;
constexpr float E_C2 = 0.125f * 1.4426950408889634f;
__device__ __forceinline__ float xrow16_sum(float x) {
    auto s = __builtin_amdgcn_permlane16_swap(__float_as_uint(x), __float_as_uint(x), false, false);
    x = __uint_as_float(s[0]) + __uint_as_float(s[1]);
    auto t = __builtin_amdgcn_permlane32_swap(__float_as_uint(x), __float_as_uint(x), false, false);
    return __uint_as_float(t[0]) + __uint_as_float(t[1]);
}
__device__ __forceinline__ float xrow16_max(float x) {
    auto s = __builtin_amdgcn_permlane16_swap(__float_as_uint(x), __float_as_uint(x), false, false);
    x = fmaxf(__uint_as_float(s[0]), __uint_as_float(s[1]));
    auto t = __builtin_amdgcn_permlane32_swap(__float_as_uint(x), __float_as_uint(x), false, false);
    return fmaxf(__uint_as_float(t[0]), __uint_as_float(t[1]));
}
__device__ __forceinline__ float sigmoidf_fast(float g) { return __builtin_amdgcn_rcpf(1.f + __builtin_amdgcn_exp2f(-1.4426950408889634f * g)); }

struct EpiIn {
    static constexpr bool PERM = true, AFTER_DRAIN = false;
    bf16_t *Qb, *Kb, *Vb; float *Qs, *U, *out; const float *gq, *gk;
    template <int SEC, bool SAMP> __device__ __forceinline__ void qkv(const f32x4 (&acc)[2][2][4][2], const Unit& u, int wr, int wc, int fr, int fq) const {
        const int row0 = u.pm * BM + wr * 64 + fr;
        const int head = (u.pn & 1) * 4 + wc, cb = head * 64 + 8 * fq;
        f32x4 gv[2][2];
#pragma unroll
        for (int bj = 0; bj < 2; ++bj)
#pragma unroll
            for (int n = 0; n < 2; ++n) { gv[bj][n] = (f32x4){1.f, 1.f, 1.f, 1.f};
                if (SEC == 0) gv[bj][n] = *(const f32x4*)(gq + 32 * bj + 8 * fq + 4 * n) * E_C2;
                if (SEC == 1) gv[bj][n] = *(const f32x4*)(gk + 32 * bj + 8 * fq + 4 * n); }
#pragma unroll
        for (int ai = 0; ai < 2; ++ai)
#pragma unroll
            for (int m = 0; m < 4; ++m) { const int row = row0 + ai * HALF + m * 16;
                f32x4 v[2][2];
#pragma unroll
                for (int bj = 0; bj < 2; ++bj)
#pragma unroll
                    for (int n = 0; n < 2; ++n) v[bj][n] = acc[ai][bj][m][n];
                if (SEC < 2) { float ss = 0.f;
#pragma unroll
                    for (int bj = 0; bj < 2; ++bj)
#pragma unroll
                        for (int n = 0; n < 2; ++n) ss += (v[bj][n][0] * v[bj][n][0] + v[bj][n][1] * v[bj][n][1]) + (v[bj][n][2] * v[bj][n][2] + v[bj][n][3] * v[bj][n][3]);
                    ss = xrow16_sum(ss);
                    const float rinv = 1.0f / sqrtf(ss * (1.f / 64.f) + 1e-6f);
#pragma unroll
                    for (int bj = 0; bj < 2; ++bj)
#pragma unroll
                        for (int n = 0; n < 2; ++n) v[bj][n] = v[bj][n] * rinv * gv[bj][n]; }
                bf16_t* dstb = (SEC == 0 ? Qb : (SEC == 1 ? Kb : Vb)) + (size_t)row * 512 + cb;
#pragma unroll
                for (int bj = 0; bj < 2; ++bj) { u32x4 w; w.x = cvt_pk_bf16(v[bj][0][0], v[bj][0][1]); w.y = cvt_pk_bf16(v[bj][0][2], v[bj][0][3]); w.z = cvt_pk_bf16(v[bj][1][0], v[bj][1][1]); w.w = cvt_pk_bf16(v[bj][1][2], v[bj][1][3]);
                    *(u32x4*)(dstb + 32 * bj) = w; }
                if (SEC == 0 && !SAMP) { asm volatile("" ::: "memory"); continue; }
                float* o;
                if (SEC == 0) o = Qs + (size_t)(row - E_MP) * 512 + cb;
                else if (!SAMP) o = out + (SEC == 1 ? EO_KP : EO_VP) + (size_t)row * 512 + cb;
                else { const int ms = row - E_MP; o = out + (SEC == 1 ? EO_KS : EO_VS) + ((size_t)(ms >> 3) * 2048 + 2040 + (ms & 7)) * 512 + cb; }
#pragma unroll
                for (int bj = 0; bj < 2; ++bj)
#pragma unroll
                    for (int n = 0; n < 2; ++n) *(f32x4*)(o + 32 * bj + 4 * n) = v[bj][n];
                asm volatile("" ::: "memory");
            }
    }
    __device__ __forceinline__ void operator()(const f32x4 (&acc)[2][2][4][2], const Unit& u, int wr, int wc, int fr, int fq) const {
        const bool samp = u.pm >= E_MP / BM; const int sec = u.pn >> 1;
        if (u.pn < 6) {
            if (sec == 0) { if (samp) qkv<0, true>(acc, u, wr, wc, fr, fq); else qkv<0, false>(acc, u, wr, wc, fr, fq); }
            else if (sec == 1) { if (samp) qkv<1, true>(acc, u, wr, wc, fr, fq); else qkv<1, false>(acc, u, wr, wc, fr, fq); }
            else { if (samp) qkv<2, true>(acc, u, wr, wc, fr, fq); else qkv<2, false>(acc, u, wr, wc, fr, fq); }
        } else {
            const int row0 = u.pm * BM + wr * 64 + fr, cb = 128 * (u.pn - 6) + 32 * wc + 8 * fq;
#pragma unroll
            for (int ai = 0; ai < 2; ++ai)
#pragma unroll
                for (int m = 0; m < 4; ++m) { float* o = U + (size_t)(row0 + ai * HALF + m * 16) * 512 + cb;
#pragma unroll
                    for (int n = 0; n < 2; ++n) { const f32x4 a = acc[ai][0][m][n], g = acc[ai][1][m][n]; f32x4 r;
#pragma unroll
                        for (int e = 0; e < 4; ++e) r[e] = a[e] * sigmoidf_fast(g[e]);
                        *(f32x4*)(o + 4 * n) = r; } }
        }
    }
};

struct EpiOut {
    static constexpr bool PERM = true, AFTER_DRAIN = false;
    const float *xp, *xs; float* y; bf16_t* X1b; float* ssq;
    __device__ __forceinline__ void operator()(const f32x4 (&acc)[2][2][4][2], const Unit& u, int wr, int wc, int fr, int fq) const {
        const int row0 = u.pm * BM + wr * 64 + fr, col = u.pn * BM + 32 * wc + 8 * fq; const bool samp = u.pm >= E_MP / BM;
#pragma unroll
        for (int ai = 0; ai < 2; ++ai)
#pragma unroll
            for (int m = 0; m < 4; ++m) { const int row = row0 + ai * HALF + m * 16;
                const float* xr = (samp ? xs + (size_t)(row - E_MP) * 1024 : xp + (size_t)row * 1024) + col;
                float* yr = y + (size_t)row * 1024 + col; bf16_t* br = X1b + (size_t)row * 1024 + col; float ss = 0.f;
#pragma unroll
                for (int bj = 0; bj < 2; ++bj) { f32x4 v0 = acc[ai][bj][m][0] + *(const f32x4*)(xr + bj * HALF), v1 = acc[ai][bj][m][1] + *(const f32x4*)(xr + bj * HALF + 4);
                    *(f32x4*)(yr + bj * HALF) = v0; *(f32x4*)(yr + bj * HALF + 4) = v1;
                    u32x4 w; w.x = cvt_pk_bf16(v0[0], v0[1]); w.y = cvt_pk_bf16(v0[2], v0[3]); w.z = cvt_pk_bf16(v1[0], v1[1]); w.w = cvt_pk_bf16(v1[2], v1[3]);
                    *(u32x4*)(br + bj * HALF) = w;
                    ss += (v0[0] * v0[0] + v0[1] * v0[1]) + (v0[2] * v0[2] + v0[3] * v0[3]) + (v1[0] * v1[0] + v1[1] * v1[1]) + (v1[2] * v1[2] + v1[3] * v1[3]); }
                ss = xrow16_sum(ss);
                if (fq == 0) ssq[(size_t)row * 16 + u.pn * 4 + wc] = ss; }
    }
};

struct EpiGateUp {
    static constexpr bool PERM = true, AFTER_DRAIN = false;
    const float* ssq; bf16_t* HID;
    __device__ __forceinline__ void operator()(const f32x4 (&acc)[2][2][4][2], const Unit& u, int wr, int wc, int fr, int fq) const {
        const int row0 = u.pm * BM + wr * 64 + fr, col = u.pn * HALF + 32 * wc + 8 * fq;
#pragma unroll
        for (int ai = 0; ai < 2; ++ai)
#pragma unroll
            for (int m = 0; m < 4; ++m) { const int row = row0 + ai * HALF + m * 16;
                const f32x4* sp = (const f32x4*)(ssq + (size_t)row * 16); const f32x4 s0 = sp[0], s1 = sp[1], s2 = sp[2], s3 = sp[3];
                const float tot = ((s0[0] + s0[1]) + (s0[2] + s0[3])) + ((s1[0] + s1[1]) + (s1[2] + s1[3])) + ((s2[0] + s2[1]) + (s2[2] + s2[3])) + ((s3[0] + s3[1]) + (s3[2] + s3[3]));
                const float rs = 1.0f / sqrtf(tot * (1.f / 1024.f) + 1e-6f);
                float h[8];
#pragma unroll
                for (int n = 0; n < 2; ++n)
#pragma unroll
                    for (int e = 0; e < 4; ++e) { const float g = acc[ai][0][m][n][e] * rs, up = acc[ai][1][m][n][e] * rs; h[4 * n + e] = g * sigmoidf_fast(g) * up; }
                u32x4 w; w.x = cvt_pk_bf16(h[0], h[1]); w.y = cvt_pk_bf16(h[2], h[3]); w.z = cvt_pk_bf16(h[4], h[5]); w.w = cvt_pk_bf16(h[6], h[7]);
                *(u32x4*)(HID + (size_t)row * 2816 + col) = w; }
    }
};

struct EpiDown {
    static constexpr bool PERM = true, AFTER_DRAIN = false;
    float* y;
    __device__ __forceinline__ void operator()(const f32x4 (&acc)[2][2][4][2], const Unit& u, int wr, int wc, int fr, int fq) const {
        const int row0 = u.pm * BM + wr * 64 + fr, col = u.pn * BM + 32 * wc + 8 * fq;
#pragma unroll
        for (int ai = 0; ai < 2; ++ai)
#pragma unroll
            for (int m = 0; m < 4; ++m) { float* yr = y + (size_t)(row0 + ai * HALF + m * 16) * 1024 + col;
#pragma unroll
                for (int bj = 0; bj < 2; ++bj)
#pragma unroll
                    for (int n = 0; n < 2; ++n) { f32x4* p = (f32x4*)(yr + bj * HALF + 4 * n); *p = *p + acc[ai][bj][m][n]; } }
    }
};

template <class Epi, class Sched, bool ALIGN_EPI = false, bool SP2 = false>
__device__ __forceinline__ void gemm_phase(PG8_LAS unsigned char* lds, const Gemm g, const Sched& S, const Epi& E) {
    int tid_ = threadIdx.x; asm volatile("" : "+v"(tid_));
    const int tid = tid_, wid = __builtin_amdgcn_readfirstlane(tid >> 6), lane = tid & 63, wr = wid >> 2, wc = wid & 3, fr = lane & 15, fq = lane >> 4;
    const int K = g.K, nt = K / BK;
    unsigned voffA[2], voffB[2];
#pragma unroll
    for (int i = 0; i < 2; ++i) { int R, C; stage_rc(tid * 16 + i * 8192, R, C); const int Rb = Epi::PERM ? ((R & ~31) + perm32(R & 31)) : R;
        voffA[i] = (unsigned)(R * K + C) * 2u; voffB[i] = (unsigned)(Rb * K + C) * 2u; }
    const size_t kstep = (size_t)(BK * 2);
    const size_t hstep = (size_t)HALF * K * 2;
    const size_t tstep = 2 * hstep;
    const unsigned ldsw = (unsigned)wid * 1024u;
    const int aoff = lds_byte(wr * 64 + fr, fq * 8), boff = lds_byte(wc * 32 + fr, fq * 8);
#define PG8_SA(b, h) (((b) * 2 + (h)) * HTB)
#define PG8_SB(b, h) ((4 + (b) * 2 + (h)) * HTB)
#define PG8_STAGE(bufoff, gbase, voff) do { _Pragma("unroll") for (int _i = 0; _i < 2; ++_i) \
        __builtin_amdgcn_global_load_lds((const unsigned*)((const char*)(gbase) + (voff)[_i]), (PG8_LAS unsigned*)(lds + (bufoff) + ldsw + _i * 8192), 16, 0, 0); } while (0)
#define PG8_LDA(dst, b, h) do { _Pragma("unroll") for (int m = 0; m < 4; ++m) _Pragma("unroll") for (int k = 0; k < 2; ++k) dst[m][k] = *(const PG8_LAS bf16x8*)(lds + PG8_SA(b, h) + aoff + m * 2048 + k * 1024); } while (0)
#define PG8_LDB(dst, b, h) do { _Pragma("unroll") for (int n = 0; n < 2; ++n) _Pragma("unroll") for (int k = 0; k < 2; ++k) dst[n][k] = *(const PG8_LAS bf16x8*)(lds + PG8_SB(b, h) + boff + n * 2048 + k * 1024); } while (0)
#define PG8_MMA(ai, bj, At, Bt) do { __builtin_amdgcn_s_setprio(1); _Pragma("unroll") for (int m = 0; m < 4; ++m) _Pragma("unroll") for (int n = 0; n < 2; ++n) _Pragma("unroll") for (int k = 0; k < 2; ++k) \
        acc[ai][bj][m][n] = __builtin_amdgcn_mfma_f32_16x16x32_bf16(Bt[n][k], At[m][k], acc[ai][bj][m][n], 0, 0, 0); __builtin_amdgcn_s_setprio(0); } while (0)
#define PG8_WAIT_V(n) asm volatile("s_waitcnt vmcnt(" #n ")" ::: "memory")
#define PG8_WAIT_L(n) asm volatile("s_waitcnt lgkmcnt(" #n ")" ::: "memory")
#define PG8_BAR __builtin_amdgcn_s_barrier()
#define PG8_SCHED __builtin_amdgcn_sched_barrier(0)
    Unit cur, nxt; int ui = 0;
    if (!S.next(0, cur)) return;
    f32x4 acc[2][2][4][2];
#pragma unroll
    for (int a = 0; a < 2; ++a)
#pragma unroll
        for (int b = 0; b < 2; ++b)
#pragma unroll
            for (int m = 0; m < 4; ++m)
#pragma unroll
                for (int n = 0; n < 2; ++n) acc[a][b][m][n] = (f32x4){0.f, 0.f, 0.f, 0.f};
    bf16x8 At[4][2], B0[2][2], B1[2][2];
    const char* cA = (const char*)g.A + (size_t)cur.pm * tstep; const char* cB = (const char*)g.Bt + (size_t)cur.pn * tstep;
    S.a_ready(cur);
    if constexpr (SP2) {
        PG8_STAGE(PG8_SB(0, 0), cB, voffB); PG8_STAGE(PG8_SB(0, 1), cB + hstep, voffB); PG8_STAGE(PG8_SA(0, 0), cA, voffA); PG8_STAGE(PG8_SA(0, 1), cA + hstep, voffA);
        if (wr == 1) PG8_BAR;
        PG8_WAIT_V(2); PG8_BAR;
        PG8_STAGE(PG8_SB(1, 0), cB + kstep, voffB); PG8_STAGE(PG8_SA(1, 0), cA + kstep, voffA); PG8_STAGE(PG8_SB(1, 1), cB + hstep + kstep, voffB);
        PG8_WAIT_V(6); PG8_BAR;
    } else {
        PG8_STAGE(PG8_SB(0, 0), cB, voffB); PG8_STAGE(PG8_SA(0, 0), cA, voffA); PG8_STAGE(PG8_SB(0, 1), cB + hstep, voffB); PG8_STAGE(PG8_SA(0, 1), cA + hstep, voffA);
        if (wr == 1) PG8_BAR;
        PG8_WAIT_V(4); PG8_BAR;
        PG8_STAGE(PG8_SB(1, 0), cB + kstep, voffB); PG8_STAGE(PG8_SA(1, 0), cA + kstep, voffA); PG8_STAGE(PG8_SB(1, 1), cB + hstep + kstep, voffB);
        PG8_WAIT_V(6); PG8_BAR;
    }
    for (;;) {
        const bool has_next = S.next(ui + 1, nxt);
        const char* nA = has_next ? (const char*)g.A + (size_t)nxt.pm * tstep : cA; const char* nB = has_next ? (const char*)g.Bt + (size_t)nxt.pn * tstep : cB;
        for (int t = 0; t < nt; t += 2) {
            const bool last = (t == nt - 2);
            const char* a1 = cA + (size_t)(t + 1) * kstep;
            const char* a2 = last ? nA : cA + (size_t)(t + 2) * kstep; const char* b2 = last ? nB : cB + (size_t)(t + 2) * kstep;
            const char* a3 = a2 + kstep; const char* b3 = b2 + kstep;
            if (last && has_next) S.a_ready(nxt);
            if constexpr (SP2) {
            PG8_LDB(B0, 0, 0); PG8_LDB(B1, 0, 1); PG8_SCHED; PG8_LDA(At, 0, 0); PG8_STAGE(PG8_SA(1, 1), a1 + hstep, voffA);
            PG8_WAIT_V(8); PG8_WAIT_L(0); PG8_BAR; PG8_MMA(0, 0, At, B0); PG8_MMA(0, 1, At, B1); PG8_BAR; PG8_SCHED;
            PG8_LDA(At, 0, 1); PG8_STAGE(PG8_SB(0, 0), b2, voffB); PG8_STAGE(PG8_SB(0, 1), b2 + hstep, voffB); PG8_STAGE(PG8_SA(0, 0), a2, voffA);
            PG8_WAIT_V(8); PG8_WAIT_L(0); PG8_BAR; PG8_MMA(1, 0, At, B0); PG8_MMA(1, 1, At, B1); PG8_BAR; PG8_SCHED;
            PG8_LDB(B0, 1, 0); PG8_LDB(B1, 1, 1); PG8_SCHED; PG8_LDA(At, 1, 0); PG8_STAGE(PG8_SA(0, 1), a2 + hstep, voffA);
            PG8_WAIT_V(8); PG8_WAIT_L(0); PG8_BAR; PG8_MMA(0, 0, At, B0); PG8_MMA(0, 1, At, B1); PG8_BAR; PG8_SCHED;
            PG8_LDA(At, 1, 1); PG8_STAGE(PG8_SB(1, 0), b3, voffB); PG8_STAGE(PG8_SB(1, 1), b3 + hstep, voffB); PG8_STAGE(PG8_SA(1, 0), a3, voffA);
            PG8_WAIT_V(8); PG8_WAIT_L(0); PG8_BAR; PG8_MMA(1, 0, At, B0); PG8_MMA(1, 1, At, B1); PG8_BAR; PG8_SCHED;
            } else {
            PG8_LDB(B0, 0, 0); PG8_SCHED; PG8_LDA(At, 0, 0); PG8_STAGE(PG8_SA(1, 1), a1 + hstep, voffA);
            PG8_WAIT_L(8); PG8_BAR; PG8_WAIT_L(0); PG8_MMA(0, 0, At, B0); PG8_BAR; PG8_SCHED;
            PG8_LDB(B1, 0, 1); PG8_STAGE(PG8_SB(0, 0), b2, voffB);
            PG8_BAR; PG8_WAIT_L(0); PG8_MMA(0, 1, At, B1); PG8_BAR;
            PG8_LDA(At, 0, 1); PG8_STAGE(PG8_SA(0, 0), a2, voffA);
            PG8_BAR; PG8_WAIT_L(0); PG8_MMA(1, 0, At, B0); PG8_BAR; PG8_SCHED;
            PG8_STAGE(PG8_SB(0, 1), b2 + hstep, voffB);
            PG8_WAIT_V(6); PG8_BAR; PG8_MMA(1, 1, At, B1); PG8_BAR;
            PG8_LDB(B0, 1, 0); PG8_SCHED; PG8_LDA(At, 1, 0); PG8_STAGE(PG8_SA(0, 1), a2 + hstep, voffA);
            PG8_WAIT_L(8); PG8_BAR; PG8_WAIT_L(0); PG8_MMA(0, 0, At, B0); PG8_BAR; PG8_SCHED;
            PG8_LDB(B1, 1, 1); PG8_STAGE(PG8_SB(1, 0), b3, voffB);
            PG8_BAR; PG8_WAIT_L(0); PG8_MMA(0, 1, At, B1); PG8_BAR;
            PG8_LDA(At, 1, 1); PG8_STAGE(PG8_SA(1, 0), a3, voffA);
            PG8_BAR; PG8_WAIT_L(0); PG8_MMA(1, 0, At, B0); PG8_BAR; PG8_SCHED;
            PG8_STAGE(PG8_SB(1, 1), b3 + hstep, voffB);
            PG8_WAIT_V(6); PG8_BAR; PG8_MMA(1, 1, At, B1); PG8_BAR;
            }
        }
        if constexpr (ALIGN_EPI) { if (wr == 0) PG8_BAR; }
        if constexpr (!Epi::AFTER_DRAIN) { E(acc, cur, wr, wc, fr, fq); S.done(cur); }
        if (!has_next) break;
#pragma unroll
        for (int a = 0; a < 2; ++a)
#pragma unroll
            for (int b = 0; b < 2; ++b)
#pragma unroll
                for (int m = 0; m < 4; ++m)
#pragma unroll
                    for (int n = 0; n < 2; ++n) acc[a][b][m][n] = (f32x4){0.f, 0.f, 0.f, 0.f};
        cur = nxt; cA = nA; cB = nB; ++ui;
        if constexpr (ALIGN_EPI) { if (wr == 1) PG8_BAR; }
    }
    PG8_WAIT_V(0);
    if constexpr (!ALIGN_EPI) { if (wr == 0) PG8_BAR; }
    PG8_BAR;
    if constexpr (Epi::AFTER_DRAIN) { E.fused(acc, cur, wr, wc, fr, fq, lds, wid, lane); S.done(cur); }
#undef PG8_SA
#undef PG8_SB
#undef PG8_STAGE
#undef PG8_LDA
#undef PG8_LDB
#undef PG8_MMA
#undef PG8_WAIT_V
#undef PG8_WAIT_L
#undef PG8_BAR
#undef PG8_SCHED
}
}

constexpr int NWAVES = 8;
constexpr int DM = 1024, NB = 8, SEQ = 2048, MP = NB * SEQ, NSMP = 128, TS = 8, MS = NSMP * TS, M = MP + MS;
constexpr int NH = 8, HD = 64, DA = 512, DC = 512, DIN = 2560, DFF = 2816, CW = 31, LBUF = 2048;
constexpr int NCH = 16, RPC = 129;
constexpr size_t O_YP = 0, O_KP = 17825792, O_VP = 26214400, O_CP = 34603008, O_KS = 34725888, O_VS = 168943616, O_CS = 303161344, O_END = 305127424;
static_assert(O_KP == pg8::EO_KP && O_VP == pg8::EO_VP && O_KS == pg8::EO_KS && O_VS == pg8::EO_VS, "output map");
constexpr size_t MiB = 1u << 20;
constexpr size_t WS_CTL = 0, CTL_ZERO_BYTES = 1 * MiB;
constexpr size_t WS_W1 = 2 * MiB, WS_W2 = 8 * MiB, WS_W3 = 10 * MiB, WS_W4 = 22 * MiB;
constexpr size_t WS_H1 = 32 * MiB;
constexpr size_t WS_QB = 66 * MiB, WS_KB = 84 * MiB, WS_VB = 102 * MiB;
constexpr size_t WS_QS = 120 * MiB;
constexpr size_t WS_U = 122 * MiB;
constexpr size_t WS_MIX = 156 * MiB;
constexpr size_t WS_X1B = 190 * MiB;
constexpr size_t WS_SSQ = 224 * MiB;
constexpr size_t WS_HID = 226 * MiB;
constexpr size_t WS_PART = 320 * MiB;
constexpr size_t WS_END = 360 * MiB;
static_assert(WS_W1 + (size_t)DIN * DM * 2 <= WS_W2 && WS_W2 + (size_t)DM * DM * 2 <= WS_W3 && WS_W3 + (size_t)2 * DFF * DM * 2 <= WS_W4 && WS_W4 + (size_t)DM * DFF * 2 <= WS_H1, "ws map 1");
static_assert(WS_H1 + (size_t)M * DM * 2 <= WS_QB && WS_QB + (size_t)M * 512 * 2 <= WS_KB && WS_KB + (size_t)M * 512 * 2 <= WS_VB && WS_VB + (size_t)M * 512 * 2 <= WS_QS, "ws map 2");
static_assert(WS_QS + (size_t)MS * 512 * 4 <= WS_U && WS_U + (size_t)M * 512 * 4 <= WS_MIX && WS_MIX + (size_t)M * DM * 2 <= WS_X1B && WS_X1B + (size_t)M * DM * 2 <= WS_SSQ, "ws map 3");
static_assert(WS_SSQ + (size_t)M * 16 * 4 <= WS_HID && WS_HID + (size_t)M * DFF * 2 <= WS_PART && WS_PART + (size_t)NSMP * NCH * 64 * 68 * 4 <= WS_END, "ws map 4");
constexpr int CW_TMO = 0, CW_CODE = 1, CW_BAR = 4096;
constexpr int RING_OFF = 0, RING_BYTES = 131072;
constexpr int LDSCTL_OFF = RING_BYTES, MISC_OFF = LDSCTL_OFF + 320;
constexpr int LDS_BYTES = 147456;
static_assert(MISC_OFF + 128 <= LDS_BYTES, "LDS map");

#define GAS __attribute__((address_space(1)))
#define LAS __attribute__((address_space(3)))
typedef unsigned short bf16;
typedef unsigned v4u __attribute__((ext_vector_type(4)));
typedef float f32x4 __attribute__((ext_vector_type(4)));
typedef short bf16x8 __attribute__((ext_vector_type(8)));
typedef GAS unsigned gu32;
typedef GAS unsigned long long gu64;
#define RLX_AGENT __ATOMIC_RELAXED, __HIP_MEMORY_SCOPE_AGENT
#define LDS_WAIT() asm volatile("s_waitcnt lgkmcnt(0)" ::: "memory")
#define VM_WAIT() asm volatile("s_waitcnt vmcnt(0)" ::: "memory")
__device__ __forceinline__ unsigned long long rt() { return __builtin_amdgcn_s_memrealtime(); }
__device__ __forceinline__ unsigned f2bf(float f) { unsigned u = __builtin_bit_cast(unsigned, f); return (u + 0x7fffu + ((u >> 16) & 1u)) >> 16; }
__device__ __forceinline__ unsigned pk2(float lo, float hi) { return f2bf(lo) | (f2bf(hi) << 16); }
#define XB_TMO      128
#define XB_XCNT(j)  (256  + 64 * (j))
#define XB_XSUB(j)  (1280 + 64 * (j))
#define XB_XGEN(j)  (2304 + 64 * (j))
#define XB_TOP      3328
#define XB_TOPGEN   3392
#define XCD_BAR_WORDS 3456
#define XB_SPIN_CAP (1u << 18)

__device__ __forceinline__ unsigned xb_ld(unsigned* p)              { return __hip_atomic_load(p, __ATOMIC_RELAXED, __HIP_MEMORY_SCOPE_AGENT); }
__device__ __forceinline__ unsigned xb_add(unsigned* p, unsigned v) { return __hip_atomic_fetch_add(p, v, __ATOMIC_RELAXED, __HIP_MEMORY_SCOPE_AGENT); }
__device__ __forceinline__ unsigned xb_xcc_id() { return (unsigned)__builtin_amdgcn_s_getreg((3 << 11) | 20) & 0xFu; }
#define XB_SPIN(cond, bar) do { unsigned _sp = 0; while (cond) { __builtin_amdgcn_s_sleep(1); \
    if ((++_sp & 255u) == 0u) { if (xb_ld(&(bar)[XB_TMO])) break; if (_sp > XB_SPIN_CAP) { atomicAdd(&(bar)[XB_TMO], 1u); break; } } } } while (0)

struct XcdBarrier {
    unsigned* bar; unsigned x;
    volatile LAS unsigned* st;
};

__device__ __forceinline__ XcdBarrier xcd_barrier_post(unsigned* bar, volatile LAS unsigned* st) {
    XcdBarrier b; b.bar = bar; b.x = xb_xcc_id(); b.st = st;
    if (threadIdx.x == 0) (void)xb_add(&bar[XB_XCNT(b.x)], 1u);
    return b;
}
__device__ __forceinline__ void xcd_barrier_complete(unsigned* bar, unsigned x, unsigned& nloc, unsigned& nx) {
    const unsigned G = gridDim.x * gridDim.y * gridDim.z;
    unsigned sum, cnt, mine, sp = 0u;
    for (;;) {
        sum = 0u; cnt = 0u; mine = 0u;
#pragma unroll
        for (unsigned j = 0; j < 16; ++j) { const unsigned c = xb_ld(&bar[XB_XCNT(j)]); sum += c; cnt += (c > 0u) ? 1u : 0u; mine = (j == x) ? c : mine; }
        if (sum == G) break;
        __builtin_amdgcn_s_sleep(1);
        if ((++sp & 255u) == 0u) { if (xb_ld(&bar[XB_TMO])) break; if (sp > XB_SPIN_CAP) { atomicAdd(&bar[XB_TMO], 1u); break; } }
    }
    nloc = mine > 0u ? mine : 1u; nx = cnt > 0u ? cnt : 1u;
}

__device__ __forceinline__ void xcd_barrier(const XcdBarrier& b) {
    asm volatile("s_waitcnt vmcnt(0)" ::: "memory");
    __syncthreads();
    if (threadIdx.x == 0) {
        unsigned* bar = b.bar;
        __builtin_amdgcn_s_waitcnt(0);
        unsigned nloc = b.st[0], nx = b.st[1];
        if (nloc == 0u) { xcd_barrier_complete(bar, b.x, nloc, nx); b.st[0] = nloc; b.st[1] = nx; }
        const unsigned old = xb_add(&bar[XB_XSUB(b.x)], 1u);
        const unsigned gen = old / nloc;
        if (old + 1u == (gen + 1u) * nloc) {
            __builtin_amdgcn_fence(__ATOMIC_RELEASE, "agent");
            asm volatile("s_waitcnt vmcnt(0)" ::: "memory");
            const unsigned og = xb_add(&bar[XB_TOP], 1u);
            const unsigned tg = og / nx;
            if (og + 1u == (tg + 1u) * nx) xb_add(&bar[XB_TOPGEN], 1u);
            else XB_SPIN(xb_ld(&bar[XB_TOPGEN]) == tg, bar);
            __builtin_amdgcn_fence(__ATOMIC_ACQUIRE, "agent");
            xb_add(&bar[XB_XGEN(b.x)], 1u);
            asm volatile("s_waitcnt vmcnt(0)" ::: "memory");
        } else {
            XB_SPIN(xb_ld(&bar[XB_XGEN(b.x)]) == gen, bar);
            __builtin_amdgcn_fence(__ATOMIC_ACQUIRE, "agent");
            asm volatile("s_waitcnt vmcnt(0)" ::: "memory");
        }
    }
    __syncthreads();
}

typedef short s16x4 __attribute__((ext_vector_type(4)));
typedef unsigned u32x2 __attribute__((ext_vector_type(2)));
__device__ __forceinline__ float wave_sum(float v) {
#pragma unroll
    for (int o = 1; o < 64; o <<= 1) v += __shfl_xor(v, o);
    return v;
}
template <int CTRL> __device__ __forceinline__ float dppf(float x) { return __builtin_bit_cast(float, __builtin_amdgcn_mov_dpp(__builtin_bit_cast(int, x), CTRL, 0xf, 0xf, true)); }
__device__ __forceinline__ float row16_sum(float x) {
    x += dppf<0xB1>(x); x += dppf<0x4E>(x); x += dppf<0x141>(x); x += dppf<0x128>(x); return x;
}
__device__ __forceinline__ float ex2(float x) { return __builtin_amdgcn_exp2f(x); }

template <int MAP> __device__ __forceinline__ int p0_dst_row(int n0) {
    if (MAP == 1) {
        if (n0 < 1536) { const int sec = n0 >> 9, hh = (n0 & 511) >> 6, d = n0 & 63; return 256 * (2 * sec + (hh >> 2)) + 128 * (d >> 5) + 32 * (hh & 3) + (d & 31); }
        if (n0 < 2048) { const int c = n0 - 1536; return 256 * (6 + (c >> 7)) + (c & 127); }
        const int c = n0 - 2048; return 256 * (6 + (c >> 7)) + 128 + (c & 127);
    }
    if (MAP == 2) return 256 * (n0 >> 7) + (n0 & 127);
    if (MAP == 3) return 256 * (n0 >> 7) + 128 + (n0 & 127);
    return n0;
}
template <int MAP> __device__ __forceinline__ void p0_item(const float* W, int K, int N, bf16* WT, const float* g, LAS float* scr, int item, int lane) {
    const int nblk = N / 32, kb = item / nblk, nb = item % nblk, k0 = 64 * kb, n0 = 32 * nb;
#pragma unroll 8
    for (int i = 0; i < 32; ++i) { const int kk = 2 * i + (lane >> 5); float w = W[(size_t)(k0 + kk) * N + n0 + (lane & 31)]; if (g) w *= g[k0 + kk]; scr[kk * 33 + (lane & 31)] = w; }
    LDS_WAIT(); asm volatile("" ::: "memory");
    const int c = lane & 7, drow0 = p0_dst_row<MAP>(n0);
#pragma unroll
    for (int j = 0; j < 4; ++j) { const int n = (lane >> 3) + 8 * j; const LAS float* s = scr + (8 * c) * 33 + n;
        v4u o; o.x = pk2(s[0 * 33], s[1 * 33]); o.y = pk2(s[2 * 33], s[3 * 33]); o.z = pk2(s[4 * 33], s[5 * 33]); o.w = pk2(s[6 * 33], s[7 * 33]);
        *(GAS v4u*)(WT + (size_t)(drow0 + n) * K + k0 + 8 * c) = o; }
    LDS_WAIT(); asm volatile("" ::: "memory");
}
__device__ __forceinline__ void rms_row_to_bf16(const float* xrow, const f32x4 (&gv)[4], bf16* orow, int lane) {
    const GAS f32x4* xr = (const GAS f32x4*)xrow + lane;
    f32x4 v[4]; float s = 0.f;
#pragma unroll
    for (int j = 0; j < 4; ++j) { v[j] = xr[64 * j]; s += (v[j].x * v[j].x + v[j].y * v[j].y) + (v[j].z * v[j].z + v[j].w * v[j].w); }
    const float rs = 1.f / sqrtf(wave_sum(s) * (1.f / 1024.f) + 1e-6f);
    GAS unsigned long long* o8 = (GAS unsigned long long*)orow + lane;
#pragma unroll
    for (int j = 0; j < 4; ++j) { const f32x4 y = v[j] * rs * gv[j]; o8[64 * j] = (unsigned long long)pk2(y.x, y.y) | ((unsigned long long)pk2(y.z, y.w) << 32); }
}

__device__ __forceinline__ void stream_task(const float* __restrict__ ck, const float* __restrict__ cv, float* out, const float* __restrict__ Qs, float* PART, LAS f32x4* ql, int n, int c, int lane) {
    f32x4 O[8][2]; float mx[8][2], ls[8][2];
#pragma unroll
    for (int t = 0; t < 8; ++t) { const float* qp = Qs + (size_t)(n * 8 + t) * 512 + 4 * lane; ql[(t * 2 + 0) * 64 + lane] = *(const f32x4*)qp; ql[(t * 2 + 1) * 64 + lane] = *(const f32x4*)(qp + 256);
#pragma unroll
        for (int hf = 0; hf < 2; ++hf) { O[t][hf] = (f32x4){0.f, 0.f, 0.f, 0.f}; mx[t][hf] = -1e30f; ls[t][hf] = 0.f; } }
    const int a0 = c * RPC, a1 = (a0 + RPC < LBUF + TS) ? a0 + RPC : LBUF + TS;
    const float* kbase = ck + (size_t)n * LBUF * 512; const float* vbase = cv + (size_t)n * LBUF * 512;
    float* oks = out + O_KS + (size_t)n * LBUF * 512; float* ovs = out + O_VS + (size_t)n * LBUF * 512;
    f32x4 nk0, nk1, nv0, nv1;
    { const int a = a0; const float* kp = (a < LBUF) ? kbase + (size_t)a * 512 : oks + (size_t)(a - 8) * 512; const float* vp = (a < LBUF) ? vbase + (size_t)a * 512 : ovs + (size_t)(a - 8) * 512;
      nk0 = *(const f32x4*)(kp + 4 * lane); nk1 = *(const f32x4*)(kp + 256 + 4 * lane); nv0 = *(const f32x4*)(vp + 4 * lane); nv1 = *(const f32x4*)(vp + 256 + 4 * lane); }
    for (int a = a0; a < a1; ++a) {
        const f32x4 k0 = nk0, k1 = nk1, v0 = nv0, v1 = nv1;
        if (a + 1 < a1) { const int b = a + 1; const float* kp = (b < LBUF) ? kbase + (size_t)b * 512 : oks + (size_t)(b - 8) * 512; const float* vp = (b < LBUF) ? vbase + (size_t)b * 512 : ovs + (size_t)(b - 8) * 512;
            nk0 = *(const f32x4*)(kp + 4 * lane); nk1 = *(const f32x4*)(kp + 256 + 4 * lane); nv0 = *(const f32x4*)(vp + 4 * lane); nv1 = *(const f32x4*)(vp + 256 + 4 * lane); }
        if (a >= 8 && a < LBUF) { float* ko = oks + (size_t)(a - 8) * 512 + 4 * lane; float* vo = ovs + (size_t)(a - 8) * 512 + 4 * lane;
            *(f32x4*)ko = k0; *(f32x4*)(ko + 256) = k1; *(f32x4*)vo = v0; *(f32x4*)(vo + 256) = v1; }
#pragma unroll
        for (int t = 0; t < 8; ++t) {
            const int dist = LBUF + t - a;
            const int w = (dist >= 0) ? ((dist <= 128 ? 1 : 0) + (((dist & 3) == 0 && dist <= 512) ? 1 : 0) + (((dist & 15) == 0 && dist <= 2048) ? 1 : 0)) : 0;
            if (w) { const float wf = (float)w;
#pragma unroll
                for (int hf = 0; hf < 2; ++hf) { const f32x4 kk = hf ? k1 : k0, vv = hf ? v1 : v0; const f32x4 qq = ql[(t * 2 + hf) * 64 + lane];
                    float s = (qq.x * kk.x + qq.y * kk.y) + (qq.z * kk.z + qq.w * kk.w);
                    s = row16_sum(s);
                    const float mn = fmaxf(mx[t][hf], s), al = ex2(mx[t][hf] - mn), p = wf * ex2(s - mn);
                    ls[t][hf] = ls[t][hf] * al + p; O[t][hf] = O[t][hf] * al + vv * p; mx[t][hf] = mn; } }
        }
    }
#pragma unroll
    for (int t = 0; t < 8; ++t)
#pragma unroll
        for (int hf = 0; hf < 2; ++hf) { float* pp = PART + ((((size_t)n * NCH + c) * 8 + t) * 8 + (hf * 4 + (lane >> 4))) * 68;
            *(f32x4*)(pp + 4 * (lane & 15)) = O[t][hf]; if ((lane & 15) == 0) { pp[64] = mx[t][hf]; pp[65] = ls[t][hf]; } }
}
__device__ __forceinline__ void combine_task(const float* PART, bf16* MIX, int n, int t, int lane) {
#pragma unroll
    for (int hf = 0; hf < 2; ++hf) { const int head = hf * 4 + (lane >> 4);
        float mm = -1e30f;
        for (int c = 0; c < NCH; ++c) mm = fmaxf(mm, PART[((((size_t)n * NCH + c) * 8 + t) * 8 + head) * 68 + 64]);
        f32x4 num = (f32x4){0.f, 0.f, 0.f, 0.f}; float den = 0.f;
        for (int c = 0; c < NCH; ++c) { const float* pp = PART + ((((size_t)n * NCH + c) * 8 + t) * 8 + head) * 68;
            const float f = ex2(pp[64] - mm); den += f * pp[65]; num = num + *(const f32x4*)(pp + 4 * (lane & 15)) * f; }
        const float inv = 1.f / den;
        u32x2 w; w.x = pk2(num.x * inv, num.y * inv); w.y = pk2(num.z * inv, num.w * inv);
        *(u32x2*)(MIX + (size_t)(MP + n * 8 + t) * 1024 + head * 64 + 4 * (lane & 15)) = w; }
}

__device__ __forceinline__ int at_kstart(int s, int tb, int r) { return s < 5 ? 16 * tb - 128 + 32 * s : (s < 11 ? 64 * tb + (r >> 2) - 128 + 32 * (s - 5) : 256 * tb + r - 128 + 32 * (s - 11)); }
__device__ __forceinline__ int at_next(int s, int tb, int r) { do { ++s; } while (s < 23 && at_kstart(s, tb, r) + 31 < 0); return s; }
__device__ __forceinline__ s16x4 vtr(const LAS unsigned char* p) { typedef short v4i16_t __attribute__((ext_vector_type(4))); return __builtin_bit_cast(s16x4, __builtin_amdgcn_ds_read_tr16_b64_v4i16((LAS v4i16_t*)p)); }
__device__ __forceinline__ void attn_tile(const bf16* __restrict__ Qb, const bf16* __restrict__ Kb, const bf16* __restrict__ Vb, bf16* MIX, LAS unsigned char* vst, int b, int h, int tb, int r, int lane) {
    const int fr = lane & 15, g = lane >> 4;
    const size_t rowbase = (size_t)b * SEQ;
    const bf16* qp = Qb + (rowbase + 256 * tb + r + 16 * fr) * 512 + h * 64 + 8 * g;
    bf16x8 qf[2]; qf[0] = *(const bf16x8*)qp; qf[1] = *(const bf16x8*)(qp + 32);
    f32x4 o[4];
#pragma unroll
    for (int c = 0; c < 4; ++c) o[c] = (f32x4){0.f, 0.f, 0.f, 0.f};
    float mrun = -1e30f, lsum = 0.f;
    const bf16* Kh = Kb + rowbase * 512 + h * 64; const bf16* Vh = Vb + rowbase * 512 + h * 64;
    const LAS unsigned char* trp = vst + (4 * g + (fr >> 2)) * 144 + 8 * (fr & 3);
    bf16x8 kreg[2][2]; v4u vreg[4];
#define AT_LOAD(S) do { const int s_ = (S); const int dsh_ = s_ < 5 ? 4 : (s_ < 11 ? 2 : 0), rd_ = s_ < 5 ? r : (s_ < 11 ? (r & 3) : 0), ks_ = at_kstart(s_, tb, r); \
        _Pragma("unroll") for (int T = 0; T < 2; ++T) { int pos = rd_ + ((ks_ + 16 * T + fr) << dsh_); pos = pos < 0 ? 0 : (pos > SEQ - 1 ? SEQ - 1 : pos); const bf16* kp = Kh + (size_t)pos * 512 + 8 * g; \
            kreg[T][0] = *(const bf16x8*)kp; kreg[T][1] = *(const bf16x8*)(kp + 32); } \
        _Pragma("unroll") for (int i = 0; i < 4; ++i) { const int ci = i * 64 + lane; int pos = rd_ + ((ks_ + (ci >> 3)) << dsh_); pos = pos < 0 ? 0 : (pos > SEQ - 1 ? SEQ - 1 : pos); \
            vreg[i] = *(const v4u*)(Vh + (size_t)pos * 512 + 8 * (ci & 7)); } } while (0)
    int s = at_kstart(0, tb, r) + 31 < 0 ? at_next(0, tb, r) : 0;
    AT_LOAD(s);
    while (s < 23) {
        const int c0 = s < 5 ? 16 * tb : (s < 11 ? 64 * tb + (r >> 2) : 256 * tb + r), sqsh = s < 5 ? 0 : (s < 11 ? 2 : 4), ks = at_kstart(s, tb, r);
#pragma unroll
        for (int i = 0; i < 4; ++i) { const int ci = i * 64 + lane; *(LAS v4u*)(vst + (ci >> 3) * 144 + (ci & 7) * 16) = vreg[i]; }
        bf16x8 kc[2][2];
#pragma unroll
        for (int T = 0; T < 2; ++T) { kc[T][0] = kreg[T][0]; kc[T][1] = kreg[T][1]; }
        const int sn = at_next(s, tb, r);
        if (sn < 23) AT_LOAD(sn);
        f32x4 st[2];
#pragma unroll
        for (int T = 0; T < 2; ++T) { st[T] = __builtin_amdgcn_mfma_f32_16x16x32_bf16(kc[T][0], qf[0], (f32x4){0.f, 0.f, 0.f, 0.f}, 0, 0, 0); st[T] = __builtin_amdgcn_mfma_f32_16x16x32_bf16(kc[T][1], qf[1], st[T], 0, 0, 0); }
        const int ci = c0 + (fr << sqsh);
        float rm = -INFINITY;
#pragma unroll
        for (int T = 0; T < 2; ++T)
#pragma unroll
            for (int e = 0; e < 4; ++e) { const int kcx = ks + 16 * T + 4 * g + e, dist = ci - kcx; if (!(kcx >= 0 && dist >= 0 && dist <= 128)) st[T][e] = -INFINITY; rm = fmaxf(rm, st[T][e]); }
        rm = pg8::xrow16_max(rm);
        const float mn = fmaxf(mrun, rm), al = ex2(mrun - mn); mrun = mn;
        float ps = 0.f;
#pragma unroll
        for (int T = 0; T < 2; ++T)
#pragma unroll
            for (int e = 0; e < 4; ++e) { st[T][e] = ex2(st[T][e] - mn); ps += st[T][e]; }
        lsum = lsum * al + ps;
#pragma unroll
        for (int c = 0; c < 4; ++c) o[c] = o[c] * al;
        v4u pw; pw.x = pg8::cvt_pk_bf16(st[0][0], st[0][1]); pw.y = pg8::cvt_pk_bf16(st[0][2], st[0][3]); pw.z = pg8::cvt_pk_bf16(st[1][0], st[1][1]); pw.w = pg8::cvt_pk_bf16(st[1][2], st[1][3]);
        const bf16x8 pb = __builtin_bit_cast(bf16x8, pw);
        asm volatile("s_waitcnt lgkmcnt(0)" ::: "memory");
#pragma unroll
        for (int c = 0; c < 4; ++c) { const s16x4 lo = vtr(trp + 32 * c), hi = vtr(trp + 16 * 144 + 32 * c);
            const bf16x8 va = (bf16x8){lo[0], lo[1], lo[2], lo[3], hi[0], hi[1], hi[2], hi[3]};
            o[c] = __builtin_amdgcn_mfma_f32_16x16x32_bf16(va, pb, o[c], 0, 0, 0); }
        asm volatile("s_waitcnt lgkmcnt(0)" ::: "memory");
        s = sn;
    }
#undef AT_LOAD
    lsum = pg8::xrow16_sum(lsum);
    const float inv = 1.f / lsum;
    bf16* op = MIX + (rowbase + 256 * tb + r + 16 * fr) * 1024 + h * 64 + 4 * g;
#pragma unroll
    for (int c = 0; c < 4; ++c) { u32x2 w; w.x = pg8::cvt_pk_bf16(o[c][0] * inv, o[c][1] * inv); w.y = pg8::cvt_pk_bf16(o[c][2] * inv, o[c][3] * inv); *(u32x2*)(op + 16 * c) = w; }
}

__device__ __forceinline__ void conv_task(const float* __restrict__ U, const float* __restrict__ state, const float* __restrict__ cw, const float* __restrict__ cb, const float* __restrict__ lng, const float* __restrict__ lnb,
                                          bf16* MIX, float* out, LAS float* cl, int task, int lane) {
    const bool samp = task >= 2048; const int n = task - 2048, b = task >> 8, t0 = (task & 255) * 8;
    const size_t row0 = samp ? (size_t)MP + (size_t)n * 8 : (size_t)b * SEQ + t0;
    float sum[8];
#pragma unroll
    for (int t = 0; t < 8; ++t) sum[t] = 0.f;
#pragma unroll 1
    for (int cg = 0; cg < 8; ++cg) { const int ch = 64 * cg + lane;
        float win[38];
#pragma unroll
        for (int j = 0; j < 38; ++j) {
            if (samp) win[j] = (j < 30) ? state[((size_t)n * 30 + j) * 512 + ch] : U[(row0 + (j - 30)) * 512 + ch];
            else { const int tt = t0 - 30 + j; win[j] = (tt >= 0) ? U[((size_t)b * SEQ + tt) * 512 + ch] : 0.f; } }
        float wv[31];
#pragma unroll
        for (int j = 0; j < 31; ++j) wv[j] = cw[j * 512 + ch];
        const float bias = cb[ch];
#pragma unroll
        for (int t = 0; t < 8; ++t) { float a = bias;
#pragma unroll
            for (int j = 0; j < 31; ++j) a += wv[j] * win[t + j];
            cl[t * 512 + ch] = a; sum[t] += a; }
        if (samp) {
#pragma unroll
            for (int i = 0; i < 30; ++i) out[O_CS + ((size_t)n * 30 + i) * 512 + ch] = win[8 + i];
        } else if (t0 >= 2016) {
#pragma unroll
            for (int j = 30; j < 38; ++j) { const int tt = t0 - 30 + j; if (tt >= 2018) out[O_CP + ((size_t)b * 30 + (tt - 2018)) * 512 + ch] = win[j]; }
        }
    }
    LDS_WAIT(); asm volatile("" ::: "memory");
    float mean[8], rstd[8], s2[8];
#pragma unroll
    for (int t = 0; t < 8; ++t) { mean[t] = wave_sum(sum[t]) * (1.f / 512.f); s2[t] = 0.f; }
#pragma unroll 1
    for (int cg = 0; cg < 8; ++cg) { const int ch = 64 * cg + lane;
#pragma unroll
        for (int t = 0; t < 8; ++t) { const float d = cl[t * 512 + ch] - mean[t]; s2[t] += d * d; } }
#pragma unroll
    for (int t = 0; t < 8; ++t) rstd[t] = 1.f / sqrtf(wave_sum(s2[t]) * (1.f / 512.f) + 1e-5f);
#pragma unroll 1
    for (int cg = 0; cg < 8; ++cg) { const int ch = 64 * cg + lane; const float gg = lng[ch], bb = lnb[ch];
#pragma unroll
        for (int t = 0; t < 8; ++t) { const float y = (cl[t * 512 + ch] - mean[t]) * rstd[t] * gg + bb; const float sw = y * pg8::sigmoidf_fast(y);
            MIX[(row0 + t) * 1024 + 512 + ch] = (bf16)f2bf(sw); } }
    LDS_WAIT(); asm volatile("" ::: "memory");
}

#ifndef PH_MASK
#define PH_MASK 0xFFFF
#endif
struct Args { const float* in[18]; float* out; unsigned char* ws; };
__global__ void __launch_bounds__(NWAVES * 64, 2) hymba_fwd(Args args) {
    extern __shared__ __attribute__((aligned(16))) unsigned char lds[];
    LAS unsigned char* L = (LAS unsigned char*)lds;
    volatile LAS unsigned* MISC = (volatile LAS unsigned*)(L + MISC_OFF);
    const int tid = threadIdx.x, lane = tid & 63, wave = __builtin_amdgcn_readfirstlane(tid >> 6);
    const int G = gridDim.x; const int bx = blockIdx.x; const int vcu = (G % 8 == 0) ? (bx % 8) * (G / 8) + bx / 8 : bx;
    unsigned char* ws = args.ws; float* out = args.out;
    gu32* ctl = (gu32*)(ws + WS_CTL);
    const float* x_p = args.in[0]; const float* x_s = args.in[1]; const float* cache_k = args.in[2]; const float* cache_v = args.in[3]; const float* state_conv = args.in[4];
    const float* g_attn = args.in[5]; const float* w_in = args.in[6]; const float* g_q = args.in[7]; const float* g_k = args.in[8]; const float* conv_w = args.in[9]; const float* conv_b = args.in[10];
    const float* ln_g = args.in[11]; const float* ln_b = args.in[12]; const float* w_out = args.in[13]; const float* g_ffn = args.in[14]; const float* w_gate = args.in[15]; const float* w_up = args.in[16]; const float* w_down = args.in[17];
    bf16* W1t = (bf16*)(ws + WS_W1); bf16* W2t = (bf16*)(ws + WS_W2); bf16* W3t = (bf16*)(ws + WS_W3); bf16* W4t = (bf16*)(ws + WS_W4);
    bf16* H1 = (bf16*)(ws + WS_H1); bf16* Qb = (bf16*)(ws + WS_QB); bf16* Kb = (bf16*)(ws + WS_KB); bf16* Vb = (bf16*)(ws + WS_VB);
    float* Qs = (float*)(ws + WS_QS); float* U = (float*)(ws + WS_U); bf16* MIX = (bf16*)(ws + WS_MIX); bf16* X1b = (bf16*)(ws + WS_X1B); float* SSQ = (float*)(ws + WS_SSQ);
    bf16* HID = (bf16*)(ws + WS_HID); float* PART = (float*)(ws + WS_PART);

    for (int u = tid; u < (LDS_BYTES - LDSCTL_OFF) / 4; u += NWAVES * 64) ((LAS unsigned*)(L + LDSCTL_OFF))[u] = 0u;
    __syncthreads();
    XcdBarrier bar = xcd_barrier_post((unsigned*)(ctl + CW_BAR), MISC + 8);
    const int gw = vcu * NWAVES + wave, NGW = G * NWAVES;

    if (PH_MASK & 1) {
        LAS float* scr = (LAS float*)(L + RING_OFF + wave * 16384);
        constexpr int I_1 = (DM / 64) * (DIN / 32), I_2 = (DM / 64) * (DM / 32), I_3 = (DM / 64) * (DFF / 32), I_4 = (DFF / 64) * (DM / 32);
        constexpr int NITEMS = I_1 + I_2 + 2 * I_3 + I_4;
        for (int it = gw; it < NITEMS; it += NGW) {
            int r = it;
            if (r < I_1) { p0_item<1>(w_in, DM, DIN, W1t, nullptr, scr, r, lane); continue; } r -= I_1;
            if (r < I_2) { p0_item<0>(w_out, DM, DM, W2t, nullptr, scr, r, lane); continue; } r -= I_2;
            if (r < I_3) { p0_item<2>(w_gate, DM, DFF, W3t, g_ffn, scr, r, lane); continue; } r -= I_3;
            if (r < I_3) { p0_item<3>(w_up, DM, DFF, W3t, g_ffn, scr, r, lane); continue; } r -= I_3;
            p0_item<0>(w_down, DFF, DM, W4t, nullptr, scr, r, lane);
        }
        f32x4 gv[4];
#pragma unroll
        for (int j = 0; j < 4; ++j) gv[j] = *((const f32x4*)g_attn + lane + 64 * j);
        for (int m = gw; m < M; m += NGW) rms_row_to_bf16(m < MP ? x_p + (size_t)m * DM : x_s + (size_t)(m - MP) * DM, gv, H1 + (size_t)m * DM, lane);
    }
    xcd_barrier(bar);

    if (PH_MASK & 2) {
        pg8::Gemm g{H1, W1t, M, DIN, DM}; pg8::StaticOrder S; S.init(M, DIN, G, bx);
        pg8::EpiIn E{Qb, Kb, Vb, Qs, U, out, g_q, g_k};
        pg8::gemm_phase<pg8::EpiIn, pg8::StaticOrder, true, true>(L + RING_OFF, g, S, E);
    }
    xcd_barrier(bar);

    {
        if (PH_MASK & 4) for (int it = gw; it < NSMP * NCH; it += NGW) stream_task(cache_k, cache_v, out, Qs, PART, (LAS f32x4*)(L + RING_OFF + wave * 16384), it >> 4, it & 15, lane);
        LAS unsigned char* vst = L + RING_OFF + wave * 16384;
        if (PH_MASK & 8) for (int it = gw; it < NB * NH * 8 * 16; it += NGW) attn_tile(Qb, Kb, Vb, MIX, vst, it >> 10, (it >> 7) & 7, (it >> 4) & 7, it & 15, lane);
        if (PH_MASK & 16) for (int it = gw; it < 2048 + NSMP; it += NGW) conv_task(U, state_conv, conv_w, conv_b, ln_g, ln_b, MIX, out, (LAS float*)vst, it, lane);
    }
    xcd_barrier(bar);
    if (PH_MASK & 32) for (int it = gw; it < MS; it += NGW) combine_task(PART, MIX, it >> 3, it & 7, lane);
    xcd_barrier(bar);

    if (PH_MASK & 64) {
        pg8::Gemm g{MIX, W2t, M, DM, DM}; pg8::StaticOrder S; S.init(M, DM, G, bx);
        pg8::EpiOut E{x_p, x_s, out, X1b, SSQ};
        pg8::gemm_phase<pg8::EpiOut, pg8::StaticOrder, true, true>(L + RING_OFF, g, S, E);
    }
    xcd_barrier(bar);
    if (PH_MASK & 128) {
        pg8::Gemm g{X1b, W3t, M, 2 * DFF, DM}; pg8::StaticOrder S; S.init(M, 2 * DFF, G, bx);
        pg8::EpiGateUp E{SSQ, HID};
        pg8::gemm_phase<pg8::EpiGateUp, pg8::StaticOrder, true, true>(L + RING_OFF, g, S, E);
    }
    xcd_barrier(bar);
    if (PH_MASK & 256) {
        pg8::Gemm g{HID, W4t, M, DM, DFF}; pg8::StaticOrder S; S.init(M, DM, G, bx);
        pg8::EpiDown E{out};
        pg8::gemm_phase<pg8::EpiDown, pg8::StaticOrder, true, true>(L + RING_OFF, g, S, E);
    }
}

extern "C" void kernel_launch(void* const* d_in, const int* in_sizes, int n_in, void* d_out, int out_size, void* d_ws, size_t ws_size, hipStream_t stream) {
    static int grid = 0;
    if (grid == 0) {
        if (n_in != 18 || (size_t)out_size != O_END || ws_size < WS_END) { fprintf(stderr, "kernel_launch: unexpected shapes (n_in %d, out %d, ws %zu); nothing launched\n", n_in, out_size, ws_size); grid = -1; return; }
        int dev = 0, cus = 0, per_cu = 0;
        if (hipGetDevice(&dev) != hipSuccess || hipDeviceGetAttribute(&cus, hipDeviceAttributeMultiprocessorCount, dev) != hipSuccess) { grid = -1; return; }
        if (hipFuncSetAttribute((const void*)hymba_fwd, hipFuncAttributeMaxDynamicSharedMemorySize, LDS_BYTES) != hipSuccess) { fprintf(stderr, "kernel_launch: hipFuncSetAttribute failed\n"); grid = -1; return; }
        if (hipOccupancyMaxActiveBlocksPerMultiprocessor(&per_cu, (const void*)hymba_fwd, NWAVES * 64, LDS_BYTES) != hipSuccess || per_cu < 1)
            fprintf(stderr, "kernel_launch: note: occupancy query reports %d workgroups per CU\n", per_cu);
        (void)hipGetLastError();
        grid = cus;
    }
    if (grid < 0) return;
    if (hipMemsetAsync((char*)d_ws + WS_CTL, 0, CTL_ZERO_BYTES, stream) != hipSuccess) return;
    Args a{};
    for (int i = 0; i < 18; ++i) a.in[i] = (const float*)d_in[i];
    a.out = (float*)d_out; a.ws = (unsigned char*)d_ws;
    hipLaunchKernelGGL(hymba_fwd, dim3(grid), dim3(NWAVES * 64), LDS_BYTES, stream, a);
}
```

```cpp
#include <hip/hip_runtime.h>
#include <cstdio>
#include <cstdint>
#include <cmath>
namespace pg8 {
#define PG8_LAS __attribute__((address_space(3)))
typedef unsigned short bf16_t;
typedef short bf16x8 __attribute__((ext_vector_type(8)));
typedef float f32x4 __attribute__((ext_vector_type(4)));
typedef unsigned u32x4 __attribute__((ext_vector_type(4)));
constexpr int BM = 256, BK = 64, HALF = 128, HTB = HALF * BK * 2  , STAGE_BYTES = 8 * HTB, NXCD = 8, WGM = 8;

__host__ __device__ __forceinline__ int lds_byte(int r, int c) { const int st = (r >> 4) * 2 + (c >> 5), rr = r & 15, cc = c & 31, ob = rr * 64 + cc * 2; return st * 1024 + (ob ^ (((ob >> 9) & 1) << 5)); }
__host__ __device__ __forceinline__ void stage_rc(int b, int& R, int& C) { const int st = b / 1024, sb = b % 1024, swz = sb ^ (((sb >> 9) & 1) << 5); R = (st >> 1) * 16 + swz / 64; C = (st & 1) * 32 + (swz % 64) / 2; }
__host__ __device__ __forceinline__ int perm32(int rho) { const int n = rho >> 4, i = rho & 15; return 8 * (i >> 2) + 4 * n + (i & 3); }

struct Unit { int pm, pn; };
struct Gemm { const bf16_t* A; const bf16_t* Bt; int M, N, K; };

struct StaticOrder {
    int nM, nN, nwg, G, c;
    __host__ __device__ void init(int M, int N, int G_, int c_) { nM = M / BM; nN = N / BM; nwg = nM * nN; G = G_; c = c_; }
    __host__ __device__ bool next(int i, Unit& u) const {
        const long L = (long)i * G + c; if (L >= nwg) return false;
        int wgid = (int)L; { const int q = nwg / NXCD, r = nwg % NXCD, xcd = wgid % NXCD, off = wgid / NXCD; wgid = (xcd < r ? xcd * (q + 1) : r * (q + 1) + (xcd - r) * q) + off; }
        const int nig = WGM * nN, gid = wgid / nig, fm = gid * WGM, gsz = (nM - fm) < WGM ? (nM - fm) : WGM;
        u.pm = fm + ((wgid % nig) % gsz); u.pn = (wgid % nig) / gsz; return true;
    }
    __device__ __forceinline__ void a_ready(const Unit&) const {}
    __device__ __forceinline__ void done(const Unit&) const {}
};

__device__ __forceinline__ unsigned cvt_pk_bf16(float lo, float hi) { unsigned r; asm volatile("v_cvt_pk_bf16_f32 %0, %1, %2" : "=v"(r) : "v"(lo), "v"(hi)); return r; }
constexpr int E_MP = 16384;
constexpr size_t EO_KP = 17825792, EO_VP = 26214400, EO_KS = 34725888, EO_VS = 168943616;
constexpr float E_C2 = 0.125f * 1.4426950408889634f;
__device__ __forceinline__ float xrow16_sum(float x) {
    auto s = __builtin_amdgcn_permlane16_swap(__float_as_uint(x), __float_as_uint(x), false, false);
    x = __uint_as_float(s[0]) + __uint_as_float(s[1]);
    auto t = __builtin_amdgcn_permlane32_swap(__float_as_uint(x), __float_as_uint(x), false, false);
    return __uint_as_float(t[0]) + __uint_as_float(t[1]);
}
__device__ __forceinline__ float xrow16_max(float x) {
    auto s = __builtin_amdgcn_permlane16_swap(__float_as_uint(x), __float_as_uint(x), false, false);
    x = fmaxf(__uint_as_float(s[0]), __uint_as_float(s[1]));
    auto t = __builtin_amdgcn_permlane32_swap(__float_as_uint(x), __float_as_uint(x), false, false);
    return fmaxf(__uint_as_float(t[0]), __uint_as_float(t[1]));
}
__device__ __forceinline__ float sigmoidf_fast(float g) { return __builtin_amdgcn_rcpf(1.f + __builtin_amdgcn_exp2f(-1.4426950408889634f * g)); }

struct EpiIn {
    static constexpr bool PERM = true, AFTER_DRAIN = false;
    bf16_t *Qb, *Kb, *Vb; float *Qs, *U, *out; const float *gq, *gk;
    template <int SEC, bool SAMP> __device__ __forceinline__ void qkv(const f32x4 (&acc)[2][2][4][2], const Unit& u, int wr, int wc, int fr, int fq) const {
        const int row0 = u.pm * BM + wr * 64 + fr;
        const int head = (u.pn & 1) * 4 + wc, cb = head * 64 + 8 * fq;
        f32x4 gv[2][2];
#pragma unroll
        for (int bj = 0; bj < 2; ++bj)
#pragma unroll
            for (int n = 0; n < 2; ++n) { gv[bj][n] = (f32x4){1.f, 1.f, 1.f, 1.f};
                if (SEC == 0) gv[bj][n] = *(const f32x4*)(gq + 32 * bj + 8 * fq + 4 * n) * E_C2;
                if (SEC == 1) gv[bj][n] = *(const f32x4*)(gk + 32 * bj + 8 * fq + 4 * n); }
#pragma unroll
        for (int ai = 0; ai < 2; ++ai)
#pragma unroll
            for (int m = 0; m < 4; ++m) { const int row = row0 + ai * HALF + m * 16;
                f32x4 v[2][2];
#pragma unroll
                for (int bj = 0; bj < 2; ++bj)
#pragma unroll
                    for (int n = 0; n < 2; ++n) v[bj][n] = acc[ai][bj][m][n];
                if (SEC < 2) { float ss = 0.f;
#pragma unroll
                    for (int bj = 0; bj < 2; ++bj)
#pragma unroll
                        for (int n = 0; n < 2; ++n) ss += (v[bj][n][0] * v[bj][n][0] + v[bj][n][1] * v[bj][n][1]) + (v[bj][n][2] * v[bj][n][2] + v[bj][n][3] * v[bj][n][3]);
                    ss = xrow16_sum(ss);
                    const float rinv = 1.0f / sqrtf(ss * (1.f / 64.f) + 1e-6f);
#pragma unroll
                    for (int bj = 0; bj < 2; ++bj)
#pragma unroll
                        for (int n = 0; n < 2; ++n) v[bj][n] = v[bj][n] * rinv * gv[bj][n]; }
                bf16_t* dstb = (SEC == 0 ? Qb : (SEC == 1 ? Kb : Vb)) + (size_t)row * 512 + cb;
#pragma unroll
                for (int bj = 0; bj < 2; ++bj) { u32x4 w; w.x = cvt_pk_bf16(v[bj][0][0], v[bj][0][1]); w.y = cvt_pk_bf16(v[bj][0][2], v[bj][0][3]); w.z = cvt_pk_bf16(v[bj][1][0], v[bj][1][1]); w.w = cvt_pk_bf16(v[bj][1][2], v[bj][1][3]);
                    *(u32x4*)(dstb + 32 * bj) = w; }
                if (SEC == 0 && !SAMP) { asm volatile("" ::: "memory"); continue; }
                float* o;
                if (SEC == 0) o = Qs + (size_t)(row - E_MP) * 512 + cb;
                else if (!SAMP) o = out + (SEC == 1 ? EO_KP : EO_VP) + (size_t)row * 512 + cb;
                else { const int ms = row - E_MP; o = out + (SEC == 1 ? EO_KS : EO_VS) + ((size_t)(ms >> 3) * 2048 + 2040 + (ms & 7)) * 512 + cb; }
#pragma unroll
                for (int bj = 0; bj < 2; ++bj)
#pragma unroll
                    for (int n = 0; n < 2; ++n) *(f32x4*)(o + 32 * bj + 4 * n) = v[bj][n];
                asm volatile("" ::: "memory");
            }
    }
    __device__ __forceinline__ void operator()(const f32x4 (&acc)[2][2][4][2], const Unit& u, int wr, int wc, int fr, int fq) const {
        const bool samp = u.pm >= E_MP / BM; const int sec = u.pn >> 1;
        if (u.pn < 6) {
            if (sec == 0) { if (samp) qkv<0, true>(acc, u, wr, wc, fr, fq); else qkv<0, false>(acc, u, wr, wc, fr, fq); }
            else if (sec == 1) { if (samp) qkv<1, true>(acc, u, wr, wc, fr, fq); else qkv<1, false>(acc, u, wr, wc, fr, fq); }
            else { if (samp) qkv<2, true>(acc, u, wr, wc, fr, fq); else qkv<2, false>(acc, u, wr, wc, fr, fq); }
        } else {
            const int row0 = u.pm * BM + wr * 64 + fr, cb = 128 * (u.pn - 6) + 32 * wc + 8 * fq;
#pragma unroll
            for (int ai = 0; ai < 2; ++ai)
#pragma unroll
                for (int m = 0; m < 4; ++m) { float* o = U + (size_t)(row0 + ai * HALF + m * 16) * 512 + cb;
#pragma unroll
                    for (int n = 0; n < 2; ++n) { const f32x4 a = acc[ai][0][m][n], g = acc[ai][1][m][n]; f32x4 r;
#pragma unroll
                        for (int e = 0; e < 4; ++e) r[e] = a[e] * sigmoidf_fast(g[e]);
                        *(f32x4*)(o + 4 * n) = r; } }
        }
    }
};

struct EpiOut {
    static constexpr bool PERM = true, AFTER_DRAIN = false;
    const float *xp, *xs; float* y; bf16_t* X1b; float* ssq;
    __device__ __forceinline__ void operator()(const f32x4 (&acc)[2][2][4][2], const Unit& u, int wr, int wc, int fr, int fq) const {
        const int row0 = u.pm * BM + wr * 64 + fr, col = u.pn * BM + 32 * wc + 8 * fq; const bool samp = u.pm >= E_MP / BM;
#pragma unroll
        for (int ai = 0; ai < 2; ++ai)
#pragma unroll
            for (int m = 0; m < 4; ++m) { const int row = row0 + ai * HALF + m * 16;
                const float* xr = (samp ? xs + (size_t)(row - E_MP) * 1024 : xp + (size_t)row * 1024) + col;
                float* yr = y + (size_t)row * 1024 + col; bf16_t* br = X1b + (size_t)row * 1024 + col; float ss = 0.f;
#pragma unroll
                for (int bj = 0; bj < 2; ++bj) { f32x4 v0 = acc[ai][bj][m][0] + *(const f32x4*)(xr + bj * HALF), v1 = acc[ai][bj][m][1] + *(const f32x4*)(xr + bj * HALF + 4);
                    *(f32x4*)(yr + bj * HALF) = v0; *(f32x4*)(yr + bj * HALF + 4) = v1;
                    u32x4 w; w.x = cvt_pk_bf16(v0[0], v0[1]); w.y = cvt_pk_bf16(v0[2], v0[3]); w.z = cvt_pk_bf16(v1[0], v1[1]); w.w = cvt_pk_bf16(v1[2], v1[3]);
                    *(u32x4*)(br + bj * HALF) = w;
                    ss += (v0[0] * v0[0] + v0[1] * v0[1]) + (v0[2] * v0[2] + v0[3] * v0[3]) + (v1[0] * v1[0] + v1[1] * v1[1]) + (v1[2] * v1[2] + v1[3] * v1[3]); }
                ss = xrow16_sum(ss);
                if (fq == 0) ssq[(size_t)row * 16 + u.pn * 4 + wc] = ss; }
    }
};

struct EpiGateUp {
    static constexpr bool PERM = true, AFTER_DRAIN = false;
    const float* ssq; bf16_t* HID;
    __device__ __forceinline__ void operator()(const f32x4 (&acc)[2][2][4][2], const Unit& u, int wr, int wc, int fr, int fq) const {
        const int row0 = u.pm * BM + wr * 64 + fr, col = u.pn * HALF + 32 * wc + 8 * fq;
#pragma unroll
        for (int ai = 0; ai < 2; ++ai)
#pragma unroll
            for (int m = 0; m < 4; ++m) { const int row = row0 + ai * HALF + m * 16;
                const f32x4* sp = (const f32x4*)(ssq + (size_t)row * 16); const f32x4 s0 = sp[0], s1 = sp[1], s2 = sp[2], s3 = sp[3];
                const float tot = ((s0[0] + s0[1]) + (s0[2] + s0[3])) + ((s1[0] + s1[1]) + (s1[2] + s1[3])) + ((s2[0] + s2[1]) + (s2[2] + s2[3])) + ((s3[0] + s3[1]) + (s3[2] + s3[3]));
                const float rs = 1.0f / sqrtf(tot * (1.f / 1024.f) + 1e-6f);
                float h[8];
#pragma unroll
                for (int n = 0; n < 2; ++n)
#pragma unroll
                    for (int e = 0; e < 4; ++e) { const float g = acc[ai][0][m][n][e] * rs, up = acc[ai][1][m][n][e] * rs; h[4 * n + e] = g * sigmoidf_fast(g) * up; }
                u32x4 w; w.x = cvt_pk_bf16(h[0], h[1]); w.y = cvt_pk_bf16(h[2], h[3]); w.z = cvt_pk_bf16(h[4], h[5]); w.w = cvt_pk_bf16(h[6], h[7]);
                *(u32x4*)(HID + (size_t)row * 2816 + col) = w; }
    }
};

struct EpiDown {
    static constexpr bool PERM = true, AFTER_DRAIN = false;
    float* y;
    __device__ __forceinline__ void operator()(const f32x4 (&acc)[2][2][4][2], const Unit& u, int wr, int wc, int fr, int fq) const {
        const int row0 = u.pm * BM + wr * 64 + fr, col = u.pn * BM + 32 * wc + 8 * fq;
#pragma unroll
        for (int ai = 0; ai < 2; ++ai)
#pragma unroll
            for (int m = 0; m < 4; ++m) { float* yr = y + (size_t)(row0 + ai * HALF + m * 16) * 1024 + col;
#pragma unroll
                for (int bj = 0; bj < 2; ++bj)
#pragma unroll
                    for (int n = 0; n < 2; ++n) { f32x4* p = (f32x4*)(yr + bj * HALF + 4 * n); *p = *p + acc[ai][bj][m][n]; } }
    }
};

template <class Epi, class Sched, bool ALIGN_EPI = false, bool SP2 = false>
__device__ __forceinline__ void gemm_phase(PG8_LAS unsigned char* lds, const Gemm g, const Sched& S, const Epi& E) {
    int tid_ = threadIdx.x; asm volatile("" : "+v"(tid_));
    const int tid = tid_, wid = __builtin_amdgcn_readfirstlane(tid >> 6), lane = tid & 63, wr = wid >> 2, wc = wid & 3, fr = lane & 15, fq = lane >> 4;
    const int K = g.K, nt = K / BK;
    unsigned voffA[2], voffB[2];
#pragma unroll
    for (int i = 0; i < 2; ++i) { int R, C; stage_rc(tid * 16 + i * 8192, R, C); const int Rb = Epi::PERM ? ((R & ~31) + perm32(R & 31)) : R;
        voffA[i] = (unsigned)(R * K + C) * 2u; voffB[i] = (unsigned)(Rb * K + C) * 2u; }
    const size_t kstep = (size_t)(BK * 2);
    const size_t hstep = (size_t)HALF * K * 2;
    const size_t tstep = 2 * hstep;
    const unsigned ldsw = (unsigned)wid * 1024u;
    const int aoff = lds_byte(wr * 64 + fr, fq * 8), boff = lds_byte(wc * 32 + fr, fq * 8);
#define PG8_SA(b, h) (((b) * 2 + (h)) * HTB)
#define PG8_SB(b, h) ((4 + (b) * 2 + (h)) * HTB)
#define PG8_STAGE(bufoff, gbase, voff) do { _Pragma("unroll") for (int _i = 0; _i < 2; ++_i) \
        __builtin_amdgcn_global_load_lds((const unsigned*)((const char*)(gbase) + (voff)[_i]), (PG8_LAS unsigned*)(lds + (bufoff) + ldsw + _i * 8192), 16, 0, 0); } while (0)
#define PG8_LDA(dst, b, h) do { _Pragma("unroll") for (int m = 0; m < 4; ++m) _Pragma("unroll") for (int k = 0; k < 2; ++k) dst[m][k] = *(const PG8_LAS bf16x8*)(lds + PG8_SA(b, h) + aoff + m * 2048 + k * 1024); } while (0)
#define PG8_LDB(dst, b, h) do { _Pragma("unroll") for (int n = 0; n < 2; ++n) _Pragma("unroll") for (int k = 0; k < 2; ++k) dst[n][k] = *(const PG8_LAS bf16x8*)(lds + PG8_SB(b, h) + boff + n * 2048 + k * 1024); } while (0)
#define PG8_MMA(ai, bj, At, Bt) do { __builtin_amdgcn_s_setprio(1); _Pragma("unroll") for (int m = 0; m < 4; ++m) _Pragma("unroll") for (int n = 0; n < 2; ++n) _Pragma("unroll") for (int k = 0; k < 2; ++k) \
        acc[ai][bj][m][n] = __builtin_amdgcn_mfma_f32_16x16x32_bf16(Bt[n][k], At[m][k], acc[ai][bj][m][n], 0, 0, 0); __builtin_amdgcn_s_setprio(0); } while (0)
#define PG8_WAIT_V(n) asm volatile("s_waitcnt vmcnt(" #n ")" ::: "memory")
#define PG8_WAIT_L(n) asm volatile("s_waitcnt lgkmcnt(" #n ")" ::: "memory")
#define PG8_BAR __builtin_amdgcn_s_barrier()
#define PG8_SCHED __builtin_amdgcn_sched_barrier(0)
    Unit cur, nxt; int ui = 0;
    if (!S.next(0, cur)) return;
    f32x4 acc[2][2][4][2];
#pragma unroll
    for (int a = 0; a < 2; ++a)
#pragma unroll
        for (int b = 0; b < 2; ++b)
#pragma unroll
            for (int m = 0; m < 4; ++m)
#pragma unroll
                for (int n = 0; n < 2; ++n) acc[a][b][m][n] = (f32x4){0.f, 0.f, 0.f, 0.f};
    bf16x8 At[4][2], B0[2][2], B1[2][2];
    const char* cA = (const char*)g.A + (size_t)cur.pm * tstep; const char* cB = (const char*)g.Bt + (size_t)cur.pn * tstep;
    S.a_ready(cur);
    if constexpr (SP2) {
        PG8_STAGE(PG8_SB(0, 0), cB, voffB); PG8_STAGE(PG8_SB(0, 1), cB + hstep, voffB); PG8_STAGE(PG8_SA(0, 0), cA, voffA); PG8_STAGE(PG8_SA(0, 1), cA + hstep, voffA);
        if (wr == 1) PG8_BAR;
        PG8_WAIT_V(2); PG8_BAR;
        PG8_STAGE(PG8_SB(1, 0), cB + kstep, voffB); PG8_STAGE(PG8_SA(1, 0), cA + kstep, voffA); PG8_STAGE(PG8_SB(1, 1), cB + hstep + kstep, voffB);
        PG8_WAIT_V(6); PG8_BAR;
    } else {
        PG8_STAGE(PG8_SB(0, 0), cB, voffB); PG8_STAGE(PG8_SA(0, 0), cA, voffA); PG8_STAGE(PG8_SB(0, 1), cB + hstep, voffB); PG8_STAGE(PG8_SA(0, 1), cA + hstep, voffA);
        if (wr == 1) PG8_BAR;
        PG8_WAIT_V(4); PG8_BAR;
        PG8_STAGE(PG8_SB(1, 0), cB + kstep, voffB); PG8_STAGE(PG8_SA(1, 0), cA + kstep, voffA); PG8_STAGE(PG8_SB(1, 1), cB + hstep + kstep, voffB);
        PG8_WAIT_V(6); PG8_BAR;
    }
    for (;;) {
        const bool has_next = S.next(ui + 1, nxt);
        const char* nA = has_next ? (const char*)g.A + (size_t)nxt.pm * tstep : cA; const char* nB = has_next ? (const char*)g.Bt + (size_t)nxt.pn * tstep : cB;
        for (int t = 0; t < nt; t += 2) {
            const bool last = (t == nt - 2);
            const char* a1 = cA + (size_t)(t + 1) * kstep;
            const char* a2 = last ? nA : cA + (size_t)(t + 2) * kstep; const char* b2 = last ? nB : cB + (size_t)(t + 2) * kstep;
            const char* a3 = a2 + kstep; const char* b3 = b2 + kstep;
            if (last && has_next) S.a_ready(nxt);
            if constexpr (SP2) {
            PG8_LDB(B0, 0, 0); PG8_LDB(B1, 0, 1); PG8_SCHED; PG8_LDA(At, 0, 0); PG8_STAGE(PG8_SA(1, 1), a1 + hstep, voffA);
            PG8_WAIT_V(8); PG8_WAIT_L(0); PG8_BAR; PG8_MMA(0, 0, At, B0); PG8_MMA(0, 1, At, B1); PG8_BAR; PG8_SCHED;
            PG8_LDA(At, 0, 1); PG8_STAGE(PG8_SB(0, 0), b2, voffB); PG8_STAGE(PG8_SB(0, 1), b2 + hstep, voffB); PG8_STAGE(PG8_SA(0, 0), a2, voffA);
            PG8_WAIT_V(8); PG8_WAIT_L(0); PG8_BAR; PG8_MMA(1, 0, At, B0); PG8_MMA(1, 1, At, B1); PG8_BAR; PG8_SCHED;
            PG8_LDB(B0, 1, 0); PG8_LDB(B1, 1, 1); PG8_SCHED; PG8_LDA(At, 1, 0); PG8_STAGE(PG8_SA(0, 1), a2 + hstep, voffA);
            PG8_WAIT_V(8); PG8_WAIT_L(0); PG8_BAR; PG8_MMA(0, 0, At, B0); PG8_MMA(0, 1, At, B1); PG8_BAR; PG8_SCHED;
            PG8_LDA(At, 1, 1); PG8_STAGE(PG8_SB(1, 0), b3, voffB); PG8_STAGE(PG8_SB(1, 1), b3 + hstep, voffB); PG8_STAGE(PG8_SA(1, 0), a3, voffA);
            PG8_WAIT_V(8); PG8_WAIT_L(0); PG8_BAR; PG8_MMA(1, 0, At, B0); PG8_MMA(1, 1, At, B1); PG8_BAR; PG8_SCHED;
            } else {
            PG8_LDB(B0, 0, 0); PG8_SCHED; PG8_LDA(At, 0, 0); PG8_STAGE(PG8_SA(1, 1), a1 + hstep, voffA);
            PG8_WAIT_L(8); PG8_BAR; PG8_WAIT_L(0); PG8_MMA(0, 0, At, B0); PG8_BAR; PG8_SCHED;
            PG8_LDB(B1, 0, 1); PG8_STAGE(PG8_SB(0, 0), b2, voffB);
            PG8_BAR; PG8_WAIT_L(0); PG8_MMA(0, 1, At, B1); PG8_BAR;
            PG8_LDA(At, 0, 1); PG8_STAGE(PG8_SA(0, 0), a2, voffA);
            PG8_BAR; PG8_WAIT_L(0); PG8_MMA(1, 0, At, B0); PG8_BAR; PG8_SCHED;
            PG8_STAGE(PG8_SB(0, 1), b2 + hstep, voffB);
            PG8_WAIT_V(6); PG8_BAR; PG8_MMA(1, 1, At, B1); PG8_BAR;
            PG8_LDB(B0, 1, 0); PG8_SCHED; PG8_LDA(At, 1, 0); PG8_STAGE(PG8_SA(0, 1), a2 + hstep, voffA);
            PG8_WAIT_L(8); PG8_BAR; PG8_WAIT_L(0); PG8_MMA(0, 0, At, B0); PG8_BAR; PG8_SCHED;
            PG8_LDB(B1, 1, 1); PG8_STAGE(PG8_SB(1, 0), b3, voffB);
            PG8_BAR; PG8_WAIT_L(0); PG8_MMA(0, 1, At, B1); PG8_BAR;
            PG8_LDA(At, 1, 1); PG8_STAGE(PG8_SA(1, 0), a3, voffA);
            PG8_BAR; PG8_WAIT_L(0); PG8_MMA(1, 0, At, B0); PG8_BAR; PG8_SCHED;
            PG8_STAGE(PG8_SB(1, 1), b3 + hstep, voffB);
            PG8_WAIT_V(6); PG8_BAR; PG8_MMA(1, 1, At, B1); PG8_BAR;
            }
        }
        if constexpr (ALIGN_EPI) { if (wr == 0) PG8_BAR; }
        if constexpr (!Epi::AFTER_DRAIN) { E(acc, cur, wr, wc, fr, fq); S.done(cur); }
        if (!has_next) break;
#pragma unroll
        for (int a = 0; a < 2; ++a)
#pragma unroll
            for (int b = 0; b < 2; ++b)
#pragma unroll
                for (int m = 0; m < 4; ++m)
#pragma unroll
                    for (int n = 0; n < 2; ++n) acc[a][b][m][n] = (f32x4){0.f, 0.f, 0.f, 0.f};
        cur = nxt; cA = nA; cB = nB; ++ui;
        if constexpr (ALIGN_EPI) { if (wr == 1) PG8_BAR; }
    }
    PG8_WAIT_V(0);
    if constexpr (!ALIGN_EPI) { if (wr == 0) PG8_BAR; }
    PG8_BAR;
    if constexpr (Epi::AFTER_DRAIN) { E.fused(acc, cur, wr, wc, fr, fq, lds, wid, lane); S.done(cur); }
#undef PG8_SA
#undef PG8_SB
#undef PG8_STAGE
#undef PG8_LDA
#undef PG8_LDB
#undef PG8_MMA
#undef PG8_WAIT_V
#undef PG8_WAIT_L
#undef PG8_BAR
#undef PG8_SCHED
}
}

constexpr int NWAVES = 8;
constexpr int DM = 1024, NB = 8, SEQ = 2048, MP = NB * SEQ, NSMP = 128, TS = 8, MS = NSMP * TS, M = MP + MS;
constexpr int NH = 8, HD = 64, DA = 512, DC = 512, DIN = 2560, DFF = 2816, CW = 31, LBUF = 2048;
constexpr int NCH = 11;
constexpr int N_SATTN = NSMP * NCH, N_COPY = 256 * 64, N_ATT = NB * NH * 8 * 16, N_CONV = 2048 + NSMP;
constexpr size_t O_YP = 0, O_KP = 17825792, O_VP = 26214400, O_CP = 34603008, O_KS = 34725888, O_VS = 168943616, O_CS = 303161344, O_END = 305127424;
static_assert(O_KP == pg8::EO_KP && O_VP == pg8::EO_VP && O_KS == pg8::EO_KS && O_VS == pg8::EO_VS, "output map");
constexpr size_t MiB = 1u << 20;
constexpr size_t WS_CTL = 0, CTL_ZERO_BYTES = 1 * MiB;
constexpr size_t WS_W1 = 2 * MiB, WS_W2 = 8 * MiB, WS_W3 = 10 * MiB, WS_W4 = 22 * MiB;
constexpr size_t WS_H1 = 32 * MiB;
constexpr size_t WS_QB = 66 * MiB, WS_KB = 84 * MiB, WS_VB = 102 * MiB;
constexpr size_t WS_QS = 120 * MiB;
constexpr size_t WS_U = 122 * MiB;
constexpr size_t WS_MIX = 156 * MiB;
constexpr size_t WS_X1B = 190 * MiB;
constexpr size_t WS_SSQ = 224 * MiB;
constexpr size_t WS_HID = 226 * MiB;
constexpr size_t WS_PART = 320 * MiB;
constexpr size_t WS_END = 360 * MiB;
static_assert(WS_W1 + (size_t)DIN * DM * 2 <= WS_W2 && WS_W2 + (size_t)DM * DM * 2 <= WS_W3 && WS_W3 + (size_t)2 * DFF * DM * 2 <= WS_W4 && WS_W4 + (size_t)DM * DFF * 2 <= WS_H1, "ws map 1");
static_assert(WS_H1 + (size_t)M * DM * 2 <= WS_QB && WS_QB + (size_t)M * 512 * 2 <= WS_KB && WS_KB + (size_t)M * 512 * 2 <= WS_VB && WS_VB + (size_t)M * 512 * 2 <= WS_QS, "ws map 2");
static_assert(WS_QS + (size_t)MS * 512 * 4 <= WS_U && WS_U + (size_t)M * 512 * 4 <= WS_MIX && WS_MIX + (size_t)M * DM * 2 <= WS_X1B && WS_X1B + (size_t)M * DM * 2 <= WS_SSQ, "ws map 3");
static_assert(WS_SSQ + (size_t)M * 16 * 4 <= WS_HID && WS_HID + (size_t)M * DFF * 2 <= WS_PART && WS_PART + (size_t)NSMP * NCH * 64 * 68 * 4 <= WS_END, "ws map 4");
constexpr int CW_TMO = 0, CW_CODE = 1, CW_BAR = 4096, CW_QS = 8192, CW_QC = 8192 + 64;
constexpr int RING_OFF = 0, RING_BYTES = 131072;
constexpr int LDSCTL_OFF = RING_BYTES, MISC_OFF = LDSCTL_OFF + 320;
constexpr int LDS_BYTES = 147456;
static_assert(MISC_OFF + 128 <= LDS_BYTES, "LDS map");

#define GAS __attribute__((address_space(1)))
#define LAS __attribute__((address_space(3)))
typedef unsigned short bf16;
typedef unsigned v4u __attribute__((ext_vector_type(4)));
typedef float f32x4 __attribute__((ext_vector_type(4)));
typedef short bf16x8 __attribute__((ext_vector_type(8)));
typedef GAS unsigned gu32;
typedef GAS unsigned long long gu64;
#define RLX_AGENT __ATOMIC_RELAXED, __HIP_MEMORY_SCOPE_AGENT
#define LDS_WAIT() asm volatile("s_waitcnt lgkmcnt(0)" ::: "memory")
#define VM_WAIT() asm volatile("s_waitcnt vmcnt(0)" ::: "memory")
__device__ __forceinline__ unsigned long long rt() { return __builtin_amdgcn_s_memrealtime(); }
__device__ __forceinline__ unsigned f2bf(float f) { unsigned u = __builtin_bit_cast(unsigned, f); return (u + 0x7fffu + ((u >> 16) & 1u)) >> 16; }
__device__ __forceinline__ unsigned pk2(float lo, float hi) { return f2bf(lo) | (f2bf(hi) << 16); }
#define XB_TMO      128
#define XB_XCNT(j)  (256  + 64 * (j))
#define XB_XSUB(j)  (1280 + 64 * (j))
#define XB_XGEN(j)  (2304 + 64 * (j))
#define XB_TOP      3328
#define XB_TOPGEN   3392
#define XCD_BAR_WORDS 3456
#define XB_SPIN_CAP (1u << 18)

__device__ __forceinline__ unsigned xb_ld(unsigned* p)              { return __hip_atomic_load(p, __ATOMIC_RELAXED, __HIP_MEMORY_SCOPE_AGENT); }
__device__ __forceinline__ unsigned xb_add(unsigned* p, unsigned v) { return __hip_atomic_fetch_add(p, v, __ATOMIC_RELAXED, __HIP_MEMORY_SCOPE_AGENT); }
__device__ __forceinline__ unsigned xb_xcc_id() { return (unsigned)__builtin_amdgcn_s_getreg((3 << 11) | 20) & 0xFu; }
#define XB_SPIN(cond, bar) do { unsigned _sp = 0; while (cond) { __builtin_amdgcn_s_sleep(1); \
    if ((++_sp & 255u) == 0u) { if (xb_ld(&(bar)[XB_TMO])) break; if (_sp > XB_SPIN_CAP) { atomicAdd(&(bar)[XB_TMO], 1u); break; } } } } while (0)

struct XcdBarrier {
    unsigned* bar; unsigned x;
    volatile LAS unsigned* st;
};

__device__ __forceinline__ XcdBarrier xcd_barrier_post(unsigned* bar, volatile LAS unsigned* st) {
    XcdBarrier b; b.bar = bar; b.x = xb_xcc_id(); b.st = st;
    if (threadIdx.x == 0) (void)xb_add(&bar[XB_XCNT(b.x)], 1u);
    return b;
}
__device__ __forceinline__ void xcd_barrier_complete(unsigned* bar, unsigned x, unsigned& nloc, unsigned& nx) {
    const unsigned G = gridDim.x * gridDim.y * gridDim.z;
    unsigned sum, cnt, mine, sp = 0u;
    for (;;) {
        sum = 0u; cnt = 0u; mine = 0u;
#pragma unroll
        for (unsigned j = 0; j < 16; ++j) { const unsigned c = xb_ld(&bar[XB_XCNT(j)]); sum += c; cnt += (c > 0u) ? 1u : 0u; mine = (j == x) ? c : mine; }
        if (sum == G) break;
        __builtin_amdgcn_s_sleep(1);
        if ((++sp & 255u) == 0u) { if (xb_ld(&bar[XB_TMO])) break; if (sp > XB_SPIN_CAP) { atomicAdd(&bar[XB_TMO], 1u); break; } }
    }
    nloc = mine > 0u ? mine : 1u; nx = cnt > 0u ? cnt : 1u;
}

__device__ __forceinline__ void xcd_barrier(const XcdBarrier& b) {
    asm volatile("s_waitcnt vmcnt(0)" ::: "memory");
    __syncthreads();
    if (threadIdx.x == 0) {
        unsigned* bar = b.bar;
        __builtin_amdgcn_s_waitcnt(0);
        unsigned nloc = b.st[0], nx = b.st[1];
        if (nloc == 0u) { xcd_barrier_complete(bar, b.x, nloc, nx); b.st[0] = nloc; b.st[1] = nx; }
        const unsigned old = xb_add(&bar[XB_XSUB(b.x)], 1u);
        const unsigned gen = old / nloc;
        if (old + 1u == (gen + 1u) * nloc) {
            __builtin_amdgcn_fence(__ATOMIC_RELEASE, "agent");
            asm volatile("s_waitcnt vmcnt(0)" ::: "memory");
            const unsigned og = xb_add(&bar[XB_TOP], 1u);
            const unsigned tg = og / nx;
            if (og + 1u == (tg + 1u) * nx) xb_add(&bar[XB_TOPGEN], 1u);
            else XB_SPIN(xb_ld(&bar[XB_TOPGEN]) == tg, bar);
            __builtin_amdgcn_fence(__ATOMIC_ACQUIRE, "agent");
            xb_add(&bar[XB_XGEN(b.x)], 1u);
            asm volatile("s_waitcnt vmcnt(0)" ::: "memory");
        } else {
            XB_SPIN(xb_ld(&bar[XB_XGEN(b.x)]) == gen, bar);
            __builtin_amdgcn_fence(__ATOMIC_ACQUIRE, "agent");
            asm volatile("s_waitcnt vmcnt(0)" ::: "memory");
        }
    }
    __syncthreads();
}

typedef short s16x4 __attribute__((ext_vector_type(4)));
typedef unsigned u32x2 __attribute__((ext_vector_type(2)));
__device__ __forceinline__ float wave_sum(float v) {
#pragma unroll
    for (int o = 1; o < 64; o <<= 1) v += __shfl_xor(v, o);
    return v;
}
template <int CTRL> __device__ __forceinline__ float dppf(float x) { return __builtin_bit_cast(float, __builtin_amdgcn_mov_dpp(__builtin_bit_cast(int, x), CTRL, 0xf, 0xf, true)); }
__device__ __forceinline__ float row16_sum(float x) {
    x += dppf<0xB1>(x); x += dppf<0x4E>(x); x += dppf<0x141>(x); x += dppf<0x128>(x); return x;
}
__device__ __forceinline__ float ex2(float x) { return __builtin_amdgcn_exp2f(x); }

template <int MAP> __device__ __forceinline__ int p0_dst_row(int n0) {
    if (MAP == 1) {
        if (n0 < 1536) { const int sec = n0 >> 9, hh = (n0 & 511) >> 6, d = n0 & 63; return 256 * (2 * sec + (hh >> 2)) + 128 * (d >> 5) + 32 * (hh & 3) + (d & 31); }
        if (n0 < 2048) { const int c = n0 - 1536; return 256 * (6 + (c >> 7)) + (c & 127); }
        const int c = n0 - 2048; return 256 * (6 + (c >> 7)) + 128 + (c & 127);
    }
    if (MAP == 2) return 256 * (n0 >> 7) + (n0 & 127);
    if (MAP == 3) return 256 * (n0 >> 7) + 128 + (n0 & 127);
    return n0;
}
template <int MAP> __device__ __forceinline__ void p0_item(const float* W, int K, int N, bf16* WT, const float* g, LAS float* scr, int item, int lane) {
    const int nblk = N / 32, kb = item / nblk, nb = item % nblk, k0 = 64 * kb, n0 = 32 * nb;
#pragma unroll 8
    for (int i = 0; i < 32; ++i) { const int kk = 2 * i + (lane >> 5); float w = W[(size_t)(k0 + kk) * N + n0 + (lane & 31)]; if (g) w *= g[k0 + kk]; scr[kk * 33 + (lane & 31)] = w; }
    LDS_WAIT(); asm volatile("" ::: "memory");
    const int c = lane & 7, drow0 = p0_dst_row<MAP>(n0);
#pragma unroll
    for (int j = 0; j < 4; ++j) { const int n = (lane >> 3) + 8 * j; const LAS float* s = scr + (8 * c) * 33 + n;
        v4u o; o.x = pk2(s[0 * 33], s[1 * 33]); o.y = pk2(s[2 * 33], s[3 * 33]); o.z = pk2(s[4 * 33], s[5 * 33]); o.w = pk2(s[6 * 33], s[7 * 33]);
        *(GAS v4u*)(WT + (size_t)(drow0 + n) * K + k0 + 8 * c) = o; }
    LDS_WAIT(); asm volatile("" ::: "memory");
}
__device__ __forceinline__ void rms_row_to_bf16(const float* xrow, const f32x4 (&gv)[4], bf16* orow, int lane) {
    const GAS f32x4* xr = (const GAS f32x4*)xrow + lane;
    f32x4 v[4]; float s = 0.f;
#pragma unroll
    for (int j = 0; j < 4; ++j) { v[j] = xr[64 * j]; s += (v[j].x * v[j].x + v[j].y * v[j].y) + (v[j].z * v[j].z + v[j].w * v[j].w); }
    const float rs = 1.f / sqrtf(wave_sum(s) * (1.f / 1024.f) + 1e-6f);
    GAS unsigned long long* o8 = (GAS unsigned long long*)orow + lane;
#pragma unroll
    for (int j = 0; j < 4; ++j) { const f32x4 y = v[j] * rs * gv[j]; o8[64 * j] = (unsigned long long)pk2(y.x, y.y) | ((unsigned long long)pk2(y.z, y.w) << 32); }
}

__device__ __forceinline__ int sa_count(int c) { return c < 4 ? 192 : (c < 7 ? 128 : 34); }
__device__ __forceinline__ int sa_row(int c, int i) { if (c < 4) { const int j = 192 * c + i; return ((j >> 3) << 4) + (j & 7); } return (c < 7 ? 1536 + 128 * (c - 4) : 1920 + 34 * (c - 7)) + i; }
__device__ __forceinline__ void sattn_task(const float* __restrict__ ck, const float* __restrict__ cv, const float* __restrict__ out, const float* __restrict__ Qs, float* PART, LAS f32x4* ql, int n, int c, int lane) {
    asm volatile("" : "+v"(lane));
    f32x4 O[8][2]; float mx[8][2], ls[8][2];
#pragma unroll
    for (int t = 0; t < 8; ++t) { const float* qp = Qs + (size_t)(n * 8 + t) * 512 + 4 * lane; ql[(t * 2 + 0) * 64 + lane] = *(const f32x4*)qp; ql[(t * 2 + 1) * 64 + lane] = *(const f32x4*)(qp + 256);
#pragma unroll
        for (int hf = 0; hf < 2; ++hf) { O[t][hf] = (f32x4){0.f, 0.f, 0.f, 0.f}; mx[t][hf] = -1e30f; ls[t][hf] = 0.f; } }
    const int cnt = sa_count(c);
    const float* kbase = ck + (size_t)n * LBUF * 512; const float* vbase = cv + (size_t)n * LBUF * 512;
    const float* oks = out + O_KS + (size_t)n * LBUF * 512; const float* ovs = out + O_VS + (size_t)n * LBUF * 512;
    f32x4 kb[2][2], vb[2][2];
#define SA_LOAD(U, I) do { const int a_ = sa_row(c, (I)); const float* kp_ = (a_ < LBUF) ? kbase + (size_t)a_ * 512 : oks + (size_t)(a_ - 8) * 512; const float* vp_ = (a_ < LBUF) ? vbase + (size_t)a_ * 512 : ovs + (size_t)(a_ - 8) * 512; \
        kb[U][0] = *(const f32x4*)(kp_ + 4 * lane); kb[U][1] = *(const f32x4*)(kp_ + 256 + 4 * lane); vb[U][0] = *(const f32x4*)(vp_ + 4 * lane); vb[U][1] = *(const f32x4*)(vp_ + 256 + 4 * lane); } while (0)
#pragma unroll
    for (int u = 0; u < 2; ++u) if (u < cnt) SA_LOAD(u, u);
#pragma unroll 1
    for (int i0 = 0; i0 < cnt; i0 += 2) {
#pragma unroll
        for (int u = 0; u < 2; ++u) { const int i = i0 + u;
            if (i < cnt) {
                const int a = sa_row(c, i);
                const f32x4 k0 = kb[u][0], k1 = kb[u][1], v0 = vb[u][0], v1 = vb[u][1];
                if (i + 2 < cnt) SA_LOAD(u, i + 2);
#pragma unroll
                for (int t = 0; t < 8; ++t) {
                    const int dist = LBUF + t - a;
                    const int w = (dist >= 0) ? ((dist <= 128 ? 1 : 0) + (((dist & 3) == 0 && dist <= 512) ? 1 : 0) + (((dist & 15) == 0 && dist <= 2048) ? 1 : 0)) : 0;
                    if (w) { const float wf = (float)w;
#pragma unroll
                        for (int hf = 0; hf < 2; ++hf) { const f32x4 kk = hf ? k1 : k0, vv = hf ? v1 : v0; const f32x4 qq = ql[(t * 2 + hf) * 64 + lane];
                            float sc = (qq.x * kk.x + qq.y * kk.y) + (qq.z * kk.z + qq.w * kk.w);
                            sc = row16_sum(sc);
                            const float mn = fmaxf(mx[t][hf], sc), al = ex2(mx[t][hf] - mn), p = wf * ex2(sc - mn);
                            ls[t][hf] = ls[t][hf] * al + p; O[t][hf] = O[t][hf] * al + vv * p; mx[t][hf] = mn; } }
                }
            } }
    }
#undef SA_LOAD
#pragma unroll
    for (int t = 0; t < 8; ++t)
#pragma unroll
        for (int hf = 0; hf < 2; ++hf) { float* pp = PART + ((((size_t)n * NCH + c) * 8 + t) * 8 + (hf * 4 + (lane >> 4))) * 68;
            *(f32x4*)(pp + 4 * (lane & 15)) = O[t][hf]; if ((lane & 15) == 0) { pp[64] = mx[t][hf]; pp[65] = ls[t][hf]; } }
    LDS_WAIT(); asm volatile("" ::: "memory");
}
__device__ __forceinline__ void copy_piece(const float* __restrict__ ck, const float* __restrict__ cv, float* out, int id, int lane) {
    asm volatile("" : "+v"(lane));
    const int seg = id >> 6, piece = id & 63, n = seg >> 1, kv = seg & 1;
    const f32x4* src = (const f32x4*)((kv ? cv : ck) + ((size_t)n * LBUF + 8) * 512) + (size_t)piece * 4096 + lane;
    f32x4* dst = (f32x4*)(out + (kv ? O_VS : O_KS) + (size_t)n * LBUF * 512) + (size_t)piece * 4096 + lane;
    const int iters = piece == 63 ? 48 : 64;
    for (int i = 0; i < iters; i += 8) { f32x4 v[8];
#pragma unroll
        for (int u = 0; u < 8; ++u) v[u] = __builtin_nontemporal_load(src + (size_t)(i + u) * 64);
#pragma unroll
        for (int u = 0; u < 8; ++u) __builtin_nontemporal_store(v[u], dst + (size_t)(i + u) * 64); }
}
__device__ __forceinline__ int dequeue(gu32* q, int lane) { unsigned v = 0; if (lane == 0) v = __hip_atomic_fetch_add(q, 1u, __ATOMIC_RELAXED, __HIP_MEMORY_SCOPE_AGENT); return (int)__builtin_amdgcn_readfirstlane(v); }
__device__ __forceinline__ void combine_task(const float* PART, bf16* MIX, int n, int t, int lane) {
#pragma unroll
    for (int hf = 0; hf < 2; ++hf) { const int head = hf * 4 + (lane >> 4);
        float mm = -1e30f;
        for (int c = 0; c < NCH; ++c) mm = fmaxf(mm, PART[((((size_t)n * NCH + c) * 8 + t) * 8 + head) * 68 + 64]);
        f32x4 num = (f32x4){0.f, 0.f, 0.f, 0.f}; float den = 0.f;
        for (int c = 0; c < NCH; ++c) { const float* pp = PART + ((((size_t)n * NCH + c) * 8 + t) * 8 + head) * 68;
            const float f = ex2(pp[64] - mm); den += f * pp[65]; num = num + *(const f32x4*)(pp + 4 * (lane & 15)) * f; }
        const float inv = 1.f / den;
        u32x2 w; w.x = pk2(num.x * inv, num.y * inv); w.y = pk2(num.z * inv, num.w * inv);
        *(u32x2*)(MIX + (size_t)(MP + n * 8 + t) * 1024 + head * 64 + 4 * (lane & 15)) = w; }
}

__device__ __forceinline__ int at_kstart(int s, int tb, int r) { return s < 5 ? 16 * tb - 128 + 32 * s : (s < 11 ? 64 * tb + (r >> 2) - 128 + 32 * (s - 5) : 256 * tb + r - 128 + 32 * (s - 11)); }
__device__ __forceinline__ int at_next(int s, int tb, int r) { do { ++s; } while (s < 23 && at_kstart(s, tb, r) + 31 < 0); return s; }
__device__ __forceinline__ s16x4 vtr(const LAS unsigned char* p) { typedef short v4i16_t __attribute__((ext_vector_type(4))); return __builtin_bit_cast(s16x4, __builtin_amdgcn_ds_read_tr16_b64_v4i16((LAS v4i16_t*)p)); }
__device__ __forceinline__ void attn_tile(const bf16* __restrict__ Qb, const bf16* __restrict__ Kb, const bf16* __restrict__ Vb, bf16* MIX, LAS unsigned char* vst, int b, int h, int tb, int r, int lane) {
    asm volatile("" : "+v"(lane));
    const int fr = lane & 15, g = lane >> 4;
    const size_t rowbase = (size_t)b * SEQ;
    const bf16* qp = Qb + (rowbase + 256 * tb + r + 16 * fr) * 512 + h * 64 + 8 * g;
    bf16x8 qf[2]; qf[0] = *(const bf16x8*)qp; qf[1] = *(const bf16x8*)(qp + 32);
    f32x4 o[4];
#pragma unroll
    for (int c = 0; c < 4; ++c) o[c] = (f32x4){0.f, 0.f, 0.f, 0.f};
    float mrun = -1e30f, lsum = 0.f;
    const bf16* Kh = Kb + rowbase * 512 + h * 64; const bf16* Vh = Vb + rowbase * 512 + h * 64;
    const LAS unsigned char* trp = vst + (4 * g + (fr >> 2)) * 144 + 8 * (fr & 3);
    bf16x8 kreg[2][2][2]; v4u vreg[2][4];
#define AT_LOAD(B, S) do { const int s_ = (S); const int dsh_ = s_ < 5 ? 4 : (s_ < 11 ? 2 : 0), rd_ = s_ < 5 ? r : (s_ < 11 ? (r & 3) : 0), ks_ = at_kstart(s_, tb, r); \
        _Pragma("unroll") for (int T = 0; T < 2; ++T) { int pos = rd_ + ((ks_ + 16 * T + fr) << dsh_); pos = pos < 0 ? 0 : (pos > SEQ - 1 ? SEQ - 1 : pos); const bf16* kp = Kh + (size_t)pos * 512 + 8 * g; \
            kreg[B][T][0] = *(const bf16x8*)kp; kreg[B][T][1] = *(const bf16x8*)(kp + 32); } \
        _Pragma("unroll") for (int i = 0; i < 4; ++i) { const int ci = i * 64 + lane; int pos = rd_ + ((ks_ + (ci >> 3)) << dsh_); pos = pos < 0 ? 0 : (pos > SEQ - 1 ? SEQ - 1 : pos); \
            vreg[B][i] = *(const v4u*)(Vh + (size_t)pos * 512 + 8 * (ci & 7)); } } while (0)
#define AT_STEP(B, S, SN) do { const int s = (S); \
        const int c0 = s < 5 ? 16 * tb : (s < 11 ? 64 * tb + (r >> 2) : 256 * tb + r), sqsh = s < 5 ? 0 : (s < 11 ? 2 : 4), ks = at_kstart(s, tb, r); \
        _Pragma("unroll") for (int i = 0; i < 4; ++i) { const int ci = i * 64 + lane; *(LAS v4u*)(vst + (ci >> 3) * 144 + (ci & 7) * 16) = vreg[B][i]; } \
        f32x4 st[2]; \
        _Pragma("unroll") for (int T = 0; T < 2; ++T) { st[T] = __builtin_amdgcn_mfma_f32_16x16x32_bf16(kreg[B][T][0], qf[0], (f32x4){0.f, 0.f, 0.f, 0.f}, 0, 0, 0); st[T] = __builtin_amdgcn_mfma_f32_16x16x32_bf16(kreg[B][T][1], qf[1], st[T], 0, 0, 0); } \
        if ((SN) < 23) AT_LOAD(B, (SN)); \
        const int ci = c0 + (fr << sqsh); \
        float rm = -INFINITY; \
        _Pragma("unroll") for (int T = 0; T < 2; ++T) \
            _Pragma("unroll") for (int e = 0; e < 4; ++e) { const int kcx = ks + 16 * T + 4 * g + e, dist = ci - kcx; if (!(kcx >= 0 && dist >= 0 && dist <= 128)) st[T][e] = -INFINITY; rm = fmaxf(rm, st[T][e]); } \
        rm = pg8::xrow16_max(rm); \
        const float mn = fmaxf(mrun, rm), al = ex2(mrun - mn); mrun = mn; \
        float ps = 0.f; \
        _Pragma("unroll") for (int T = 0; T < 2; ++T) \
            _Pragma("unroll") for (int e = 0; e < 4; ++e) { st[T][e] = ex2(st[T][e] - mn); ps += st[T][e]; } \
        lsum = lsum * al + ps; \
        _Pragma("unroll") for (int c = 0; c < 4; ++c) o[c] = o[c] * al; \
        v4u pw; pw.x = pg8::cvt_pk_bf16(st[0][0], st[0][1]); pw.y = pg8::cvt_pk_bf16(st[0][2], st[0][3]); pw.z = pg8::cvt_pk_bf16(st[1][0], st[1][1]); pw.w = pg8::cvt_pk_bf16(st[1][2], st[1][3]); \
        const bf16x8 pb = __builtin_bit_cast(bf16x8, pw); \
        asm volatile("s_waitcnt lgkmcnt(0)" ::: "memory"); \
        _Pragma("unroll") for (int c = 0; c < 4; ++c) { const s16x4 lo = vtr(trp + 32 * c), hi = vtr(trp + 16 * 144 + 32 * c); \
            const bf16x8 va = (bf16x8){lo[0], lo[1], lo[2], lo[3], hi[0], hi[1], hi[2], hi[3]}; \
            o[c] = __builtin_amdgcn_mfma_f32_16x16x32_bf16(va, pb, o[c], 0, 0, 0); } \
        asm volatile("s_waitcnt lgkmcnt(0)" ::: "memory"); } while (0)
    int sa = at_kstart(0, tb, r) + 31 < 0 ? at_next(0, tb, r) : 0, sb = at_next(sa, tb, r);
    AT_LOAD(0, sa); if (sb < 23) AT_LOAD(1, sb);
    for (;;) {
        const int sc = (sb < 23) ? at_next(sb, tb, r) : 23;
        AT_STEP(0, sa, sc);
        if (sb >= 23) break;
        const int sd = (sc < 23) ? at_next(sc, tb, r) : 23;
        AT_STEP(1, sb, sd);
        if (sc >= 23) break;
        sa = sc; sb = sd;
    }
#undef AT_STEP
#undef AT_LOAD
    lsum = pg8::xrow16_sum(lsum);
    const float inv = 1.f / lsum;
    bf16* op = MIX + (rowbase + 256 * tb + r + 16 * fr) * 1024 + h * 64 + 4 * g;
#pragma unroll
    for (int c = 0; c < 4; ++c) { u32x2 w; w.x = pg8::cvt_pk_bf16(o[c][0] * inv, o[c][1] * inv); w.y = pg8::cvt_pk_bf16(o[c][2] * inv, o[c][3] * inv); *(u32x2*)(op + 16 * c) = w; }
}

__device__ __forceinline__ void conv_task(const float* __restrict__ U, const float* __restrict__ state, const float* __restrict__ cw, const float* __restrict__ cb, const float* __restrict__ lng, const float* __restrict__ lnb,
                                          bf16* MIX, float* out, LAS float* cl, int task, int lane) {
    asm volatile("" : "+v"(lane));
    const bool samp = task >= 2048; const int n = task - 2048, b = task >> 8, t0 = (task & 255) * 8;
    const size_t row0 = samp ? (size_t)MP + (size_t)n * 8 : (size_t)b * SEQ + t0;
    float sum[8];
#pragma unroll
    for (int t = 0; t < 8; ++t) sum[t] = 0.f;
#pragma unroll 1
    for (int cg = 0; cg < 8; ++cg) { const int ch = 64 * cg + lane;
        float win[38];
#pragma unroll
        for (int j = 0; j < 38; ++j) {
            if (samp) win[j] = (j < 30) ? state[((size_t)n * 30 + j) * 512 + ch] : U[(row0 + (j - 30)) * 512 + ch];
            else { const int tt = t0 - 30 + j; win[j] = (tt >= 0) ? U[((size_t)b * SEQ + tt) * 512 + ch] : 0.f; } }
        float wv[31];
#pragma unroll
        for (int j = 0; j < 31; ++j) wv[j] = cw[j * 512 + ch];
        const float bias = cb[ch];
#pragma unroll
        for (int t = 0; t < 8; ++t) { float a = bias;
#pragma unroll
            for (int j = 0; j < 31; ++j) a += wv[j] * win[t + j];
            cl[t * 512 + ch] = a; sum[t] += a; }
        if (samp) {
#pragma unroll
            for (int i = 0; i < 30; ++i) out[O_CS + ((size_t)n * 30 + i) * 512 + ch] = win[8 + i];
        } else if (t0 >= 2016) {
#pragma unroll
            for (int j = 30; j < 38; ++j) { const int tt = t0 - 30 + j; if (tt >= 2018) out[O_CP + ((size_t)b * 30 + (tt - 2018)) * 512 + ch] = win[j]; }
        }
    }
    LDS_WAIT(); asm volatile("" ::: "memory");
    float mean[8], rstd[8], s2[8];
#pragma unroll
    for (int t = 0; t < 8; ++t) { mean[t] = wave_sum(sum[t]) * (1.f / 512.f); s2[t] = 0.f; }
#pragma unroll 1
    for (int cg = 0; cg < 8; ++cg) { const int ch = 64 * cg + lane;
#pragma unroll
        for (int t = 0; t < 8; ++t) { const float d = cl[t * 512 + ch] - mean[t]; s2[t] += d * d; } }
#pragma unroll
    for (int t = 0; t < 8; ++t) rstd[t] = 1.f / sqrtf(wave_sum(s2[t]) * (1.f / 512.f) + 1e-5f);
#pragma unroll 1
    for (int cg = 0; cg < 8; ++cg) { const int ch = 64 * cg + lane; const float gg = lng[ch], bb = lnb[ch];
#pragma unroll
        for (int t = 0; t < 8; ++t) { const float y = (cl[t * 512 + ch] - mean[t]) * rstd[t] * gg + bb; const float sw = y * pg8::sigmoidf_fast(y);
            MIX[(row0 + t) * 1024 + 512 + ch] = (bf16)f2bf(sw); } }
    LDS_WAIT(); asm volatile("" ::: "memory");
}

#ifndef PH_MASK
#define PH_MASK 0xFFFF
#endif
struct Args { const float* in[18]; float* out; unsigned char* ws; };
__global__ void __launch_bounds__(NWAVES * 64, 2) hymba_fwd(Args args) {
    extern __shared__ __attribute__((aligned(16))) unsigned char lds[];
    LAS unsigned char* L = (LAS unsigned char*)lds;
    volatile LAS unsigned* MISC = (volatile LAS unsigned*)(L + MISC_OFF);
    const int tid = threadIdx.x, lane = tid & 63, wave = __builtin_amdgcn_readfirstlane(tid >> 6);
    const int G = gridDim.x; const int bx = blockIdx.x; const int vcu = (G % 8 == 0) ? (bx % 8) * (G / 8) + bx / 8 : bx;
    unsigned char* ws = args.ws; float* out = args.out;
    gu32* ctl = (gu32*)(ws + WS_CTL);
    const float* x_p = args.in[0]; const float* x_s = args.in[1]; const float* cache_k = args.in[2]; const float* cache_v = args.in[3]; const float* state_conv = args.in[4];
    const float* g_attn = args.in[5]; const float* w_in = args.in[6]; const float* g_q = args.in[7]; const float* g_k = args.in[8]; const float* conv_w = args.in[9]; const float* conv_b = args.in[10];
    const float* ln_g = args.in[11]; const float* ln_b = args.in[12]; const float* w_out = args.in[13]; const float* g_ffn = args.in[14]; const float* w_gate = args.in[15]; const float* w_up = args.in[16]; const float* w_down = args.in[17];
    bf16* W1t = (bf16*)(ws + WS_W1); bf16* W2t = (bf16*)(ws + WS_W2); bf16* W3t = (bf16*)(ws + WS_W3); bf16* W4t = (bf16*)(ws + WS_W4);
    bf16* H1 = (bf16*)(ws + WS_H1); bf16* Qb = (bf16*)(ws + WS_QB); bf16* Kb = (bf16*)(ws + WS_KB); bf16* Vb = (bf16*)(ws + WS_VB);
    float* Qs = (float*)(ws + WS_QS); float* U = (float*)(ws + WS_U); bf16* MIX = (bf16*)(ws + WS_MIX); bf16* X1b = (bf16*)(ws + WS_X1B); float* SSQ = (float*)(ws + WS_SSQ);
    bf16* HID = (bf16*)(ws + WS_HID); float* PART = (float*)(ws + WS_PART);

    for (int u = tid; u < (LDS_BYTES - LDSCTL_OFF) / 4; u += NWAVES * 64) ((LAS unsigned*)(L + LDSCTL_OFF))[u] = 0u;
    __syncthreads();
    XcdBarrier bar = xcd_barrier_post((unsigned*)(ctl + CW_BAR), MISC + 8);
    const int gw = vcu * NWAVES + wave, NGW = G * NWAVES;

    if (PH_MASK & 1) {
        LAS float* scr = (LAS float*)(L + RING_OFF + wave * 16384);
        constexpr int I_1 = (DM / 64) * (DIN / 32), I_2 = (DM / 64) * (DM / 32), I_3 = (DM / 64) * (DFF / 32), I_4 = (DFF / 64) * (DM / 32);
        constexpr int NITEMS = I_1 + I_2 + 2 * I_3 + I_4;
        for (int it = gw; it < NITEMS; it += NGW) {
            int r = it;
            if (r < I_1) { p0_item<1>(w_in, DM, DIN, W1t, nullptr, scr, r, lane); continue; } r -= I_1;
            if (r < I_2) { p0_item<0>(w_out, DM, DM, W2t, nullptr, scr, r, lane); continue; } r -= I_2;
            if (r < I_3) { p0_item<2>(w_gate, DM, DFF, W3t, g_ffn, scr, r, lane); continue; } r -= I_3;
            if (r < I_3) { p0_item<3>(w_up, DM, DFF, W3t, g_ffn, scr, r, lane); continue; } r -= I_3;
            p0_item<0>(w_down, DFF, DM, W4t, nullptr, scr, r, lane);
        }
        f32x4 gv[4];
#pragma unroll
        for (int j = 0; j < 4; ++j) gv[j] = *((const f32x4*)g_attn + lane + 64 * j);
        for (int m = gw; m < M; m += NGW) rms_row_to_bf16(m < MP ? x_p + (size_t)m * DM : x_s + (size_t)(m - MP) * DM, gv, H1 + (size_t)m * DM, lane);
    }
    xcd_barrier(bar);

    if (PH_MASK & 2) {
        pg8::Gemm g{H1, W1t, M, DIN, DM}; pg8::StaticOrder S; S.init(M, DIN, G, bx);
        pg8::EpiIn E{Qb, Kb, Vb, Qs, U, out, g_q, g_k};
        pg8::gemm_phase<pg8::EpiIn, pg8::StaticOrder, true, true>(L + RING_OFF, g, S, E);
    }
    xcd_barrier(bar);

    {
        LAS unsigned char* vst = L + RING_OFF + wave * 16384;
        gu32* qs = ctl + CW_QS; gu32* qc = ctl + CW_QC;
#pragma unroll 1
        for (int pass = 0; pass < 2; ++pass) {
            if ((pass == 0) == (wave < 4)) {
                for (;;) { const int id = dequeue(qs, lane); if (id >= N_SATTN + N_COPY) break;
                    if (id < N_SATTN) { if (PH_MASK & 4) sattn_task(cache_k, cache_v, out, Qs, PART, (LAS f32x4*)vst, id & 127, NCH - 1 - (id >> 7), lane); }
                    else if (PH_MASK & 512) copy_piece(cache_k, cache_v, out, id - N_SATTN, lane); }
            } else {
                for (;;) { const int id = dequeue(qc, lane); if (id >= N_ATT + N_CONV) break;
                    if (id < N_ATT) { if (PH_MASK & 8) attn_tile(Qb, Kb, Vb, MIX, vst, id >> 10, (id >> 7) & 7, (id >> 4) & 7, id & 15, lane); }
                    else if (PH_MASK & 16) conv_task(U, state_conv, conv_w, conv_b, ln_g, ln_b, MIX, out, (LAS float*)vst, id - N_ATT, lane); }
            }
        }
    }
    xcd_barrier(bar);
    if (PH_MASK & 32) for (int it = gw; it < MS; it += NGW) combine_task(PART, MIX, it >> 3, it & 7, lane);
    xcd_barrier(bar);

    if (PH_MASK & 64) {
        pg8::Gemm g{MIX, W2t, M, DM, DM}; pg8::StaticOrder S; S.init(M, DM, G, bx);
        pg8::EpiOut E{x_p, x_s, out, X1b, SSQ};
        pg8::gemm_phase<pg8::EpiOut, pg8::StaticOrder, true, true>(L + RING_OFF, g, S, E);
    }
    xcd_barrier(bar);
    if (PH_MASK & 128) {
        pg8::Gemm g{X1b, W3t, M, 2 * DFF, DM}; pg8::StaticOrder S; S.init(M, 2 * DFF, G, bx);
        pg8::EpiGateUp E{SSQ, HID};
        pg8::gemm_phase<pg8::EpiGateUp, pg8::StaticOrder, true, true>(L + RING_OFF, g, S, E);
    }
    xcd_barrier(bar);
    if (PH_MASK & 256) {
        pg8::Gemm g{HID, W4t, M, DM, DFF}; pg8::StaticOrder S; S.init(M, DM, G, bx);
        pg8::EpiDown E{out};
        pg8::gemm_phase<pg8::EpiDown, pg8::StaticOrder, true, true>(L + RING_OFF, g, S, E);
    }
}

extern "C" void kernel_launch(void* const* d_in, const int* in_sizes, int n_in, void* d_out, int out_size, void* d_ws, size_t ws_size, hipStream_t stream) {
    static int grid = 0;
    if (grid == 0) {
        if (n_in != 18 || (size_t)out_size != O_END || ws_size < WS_END) { fprintf(stderr, "kernel_launch: unexpected shapes (n_in %d, out %d, ws %zu); nothing launched\n", n_in, out_size, ws_size); grid = -1; return; }
        int dev = 0, cus = 0, per_cu = 0;
        if (hipGetDevice(&dev) != hipSuccess || hipDeviceGetAttribute(&cus, hipDeviceAttributeMultiprocessorCount, dev) != hipSuccess) { grid = -1; return; }
        if (hipFuncSetAttribute((const void*)hymba_fwd, hipFuncAttributeMaxDynamicSharedMemorySize, LDS_BYTES) != hipSuccess) { fprintf(stderr, "kernel_launch: hipFuncSetAttribute failed\n"); grid = -1; return; }
        if (hipOccupancyMaxActiveBlocksPerMultiprocessor(&per_cu, (const void*)hymba_fwd, NWAVES * 64, LDS_BYTES) != hipSuccess || per_cu < 1)
            fprintf(stderr, "kernel_launch: note: occupancy query reports %d workgroups per CU\n", per_cu);
        (void)hipGetLastError();
        grid = cus;
    }
    if (grid < 0) return;
    if (hipMemsetAsync((char*)d_ws + WS_CTL, 0, CTL_ZERO_BYTES, stream) != hipSuccess) return;
    Args a{};
    for (int i = 0; i < 18; ++i) a.in[i] = (const float*)d_in[i];
    a.out = (float*)d_out; a.ws = (unsigned char*)d_ws;
    hipLaunchKernelGGL(hymba_fwd, dim3(grid), dim3(NWAVES * 64), LDS_BYTES, stream, a);
}
```

```cpp
#include <hip/hip_runtime.h>
#include <cstdio>
#include <cstdint>
#include <cmath>
namespace pg8 {
#define PG8_LAS __attribute__((address_space(3)))
typedef unsigned short bf16_t;
typedef short bf16x8 __attribute__((ext_vector_type(8)));
typedef float f32x4 __attribute__((ext_vector_type(4)));
typedef unsigned u32x4 __attribute__((ext_vector_type(4)));
constexpr int BM = 256, BK = 64, HALF = 128, HTB = HALF * BK * 2  , STAGE_BYTES = 8 * HTB, NXCD = 8, WGM = 8;

__host__ __device__ __forceinline__ int lds_byte(int r, int c) { const int st = (r >> 4) * 2 + (c >> 5), rr = r & 15, cc = c & 31, ob = rr * 64 + cc * 2; return st * 1024 + (ob ^ (((ob >> 9) & 1) << 5)); }
__host__ __device__ __forceinline__ void stage_rc(int b, int& R, int& C) { const int st = b / 1024, sb = b % 1024, swz = sb ^ (((sb >> 9) & 1) << 5); R = (st >> 1) * 16 + swz / 64; C = (st & 1) * 32 + (swz % 64) / 2; }
__host__ __device__ __forceinline__ int perm32(int rho) { const int n = rho >> 4, i = rho & 15; return 8 * (i >> 2) + 4 * n + (i & 3); }

struct Unit { int pm, pn; };
struct Gemm { const bf16_t* A; const bf16_t* Bt; int M, N, K; };

struct StaticOrder {
    int nM, nN, nwg, G, c;
    __host__ __device__ void init(int M, int N, int G_, int c_) { nM = M / BM; nN = N / BM; nwg = nM * nN; G = G_; c = c_; }
    __host__ __device__ bool next(int i, Unit& u) const {
        const long L = (long)i * G + c; if (L >= nwg) return false;
        int wgid = (int)L; { const int q = nwg / NXCD, r = nwg % NXCD, xcd = wgid % NXCD, off = wgid / NXCD; wgid = (xcd < r ? xcd * (q + 1) : r * (q + 1) + (xcd - r) * q) + off; }
        const int nig = WGM * nN, gid = wgid / nig, fm = gid * WGM, gsz = (nM - fm) < WGM ? (nM - fm) : WGM;
        u.pm = fm + ((wgid % nig) % gsz); u.pn = (wgid % nig) / gsz; return true;
    }
    __device__ __forceinline__ void a_ready(const Unit&) const {}
    __device__ __forceinline__ void done(const Unit&) const {}
};

__device__ __forceinline__ unsigned cvt_pk_bf16(float lo, float hi) { unsigned r; asm volatile("v_cvt_pk_bf16_f32 %0, %1, %2" : "=v"(r) : "v"(lo), "v"(hi)); return r; }
constexpr int E_MP = 16384;
constexpr size_t EO_KP = 17825792, EO_VP = 26214400, EO_KS = 34725888, EO_VS = 168943616;
constexpr float E_C2 = 0.125f * 1.4426950408889634f;
__device__ __forceinline__ float xrow16_sum(float x) {
    auto s = __builtin_amdgcn_permlane16_swap(__float_as_uint(x), __float_as_uint(x), false, false);
    x = __uint_as_float(s[0]) + __uint_as_float(s[1]);
    auto t = __builtin_amdgcn_permlane32_swap(__float_as_uint(x), __float_as_uint(x), false, false);
    return __uint_as_float(t[0]) + __uint_as_float(t[1]);
}
__device__ __forceinline__ float xrow16_max(float x) {
    auto s = __builtin_amdgcn_permlane16_swap(__float_as_uint(x), __float_as_uint(x), false, false);
    x = fmaxf(__uint_as_float(s[0]), __uint_as_float(s[1]));
    auto t = __builtin_amdgcn_permlane32_swap(__float_as_uint(x), __float_as_uint(x), false, false);
    return fmaxf(__uint_as_float(t[0]), __uint_as_float(t[1]));
}
__device__ __forceinline__ float sigmoidf_fast(float g) { return __builtin_amdgcn_rcpf(1.f + __builtin_amdgcn_exp2f(-1.4426950408889634f * g)); }

struct EpiIn {
    static constexpr bool PERM = true, AFTER_DRAIN = false;
    bf16_t *Qb, *Kb, *Vb; float *Qs, *U, *out; const float *gq, *gk; float *NKs, *NVs;
    __device__ __forceinline__ void init(f32x4 (&acc)[2][2][4][2], const Unit&, int, int, int, int) const {
#pragma unroll
        for (int a = 0; a < 2; ++a)
#pragma unroll
            for (int b = 0; b < 2; ++b)
#pragma unroll
                for (int m = 0; m < 4; ++m)
#pragma unroll
                    for (int n = 0; n < 2; ++n) acc[a][b][m][n] = (f32x4){0.f, 0.f, 0.f, 0.f};
    }
    template <int SEC, bool SAMP> __device__ __forceinline__ void qkv(const f32x4 (&acc)[2][2][4][2], const Unit& u, int wr, int wc, int fr, int fq) const {
        const int row0 = u.pm * BM + wr * 64 + fr;
        const int head = (u.pn & 1) * 4 + wc, cb = head * 64 + 8 * fq;
        f32x4 gv[2][2];
#pragma unroll
        for (int bj = 0; bj < 2; ++bj)
#pragma unroll
            for (int n = 0; n < 2; ++n) { gv[bj][n] = (f32x4){1.f, 1.f, 1.f, 1.f};
                if (SEC == 0) gv[bj][n] = *(const f32x4*)(gq + 32 * bj + 8 * fq + 4 * n) * E_C2;
                if (SEC == 1) gv[bj][n] = *(const f32x4*)(gk + 32 * bj + 8 * fq + 4 * n); }
#pragma unroll
        for (int ai = 0; ai < 2; ++ai)
#pragma unroll
            for (int m = 0; m < 4; ++m) { const int row = row0 + ai * HALF + m * 16;
                f32x4 v[2][2];
#pragma unroll
                for (int bj = 0; bj < 2; ++bj)
#pragma unroll
                    for (int n = 0; n < 2; ++n) v[bj][n] = acc[ai][bj][m][n];
                if (SEC < 2) { float ss = 0.f;
#pragma unroll
                    for (int bj = 0; bj < 2; ++bj)
#pragma unroll
                        for (int n = 0; n < 2; ++n) ss += (v[bj][n][0] * v[bj][n][0] + v[bj][n][1] * v[bj][n][1]) + (v[bj][n][2] * v[bj][n][2] + v[bj][n][3] * v[bj][n][3]);
                    ss = xrow16_sum(ss);
                    const float rinv = 1.0f / sqrtf(ss * (1.f / 64.f) + 1e-6f);
#pragma unroll
                    for (int bj = 0; bj < 2; ++bj)
#pragma unroll
                        for (int n = 0; n < 2; ++n) v[bj][n] = v[bj][n] * rinv * gv[bj][n]; }
                bf16_t* dstb = (SEC == 0 ? Qb : (SEC == 1 ? Kb : Vb)) + (size_t)row * 512 + cb;
#pragma unroll
                for (int bj = 0; bj < 2; ++bj) { u32x4 w; w.x = cvt_pk_bf16(v[bj][0][0], v[bj][0][1]); w.y = cvt_pk_bf16(v[bj][0][2], v[bj][0][3]); w.z = cvt_pk_bf16(v[bj][1][0], v[bj][1][1]); w.w = cvt_pk_bf16(v[bj][1][2], v[bj][1][3]);
                    *(u32x4*)(dstb + 32 * bj) = w; }
                if (SEC == 0 && !SAMP) { asm volatile("" ::: "memory"); continue; }
                float* o;
                if (SEC == 0) o = Qs + (size_t)(row - E_MP) * 512 + cb;
                else if (!SAMP) o = out + (SEC == 1 ? EO_KP : EO_VP) + (size_t)row * 512 + cb;
                else { const int ms = row - E_MP; o = out + (SEC == 1 ? EO_KS : EO_VS) + ((size_t)(ms >> 3) * 2048 + 2040 + (ms & 7)) * 512 + cb; }
#pragma unroll
                for (int bj = 0; bj < 2; ++bj)
#pragma unroll
                    for (int n = 0; n < 2; ++n) *(f32x4*)(o + 32 * bj + 4 * n) = v[bj][n];
                if (SEC != 0 && SAMP) { float* o2 = (SEC == 1 ? NKs : NVs) + (size_t)(row - E_MP) * 512 + cb;
#pragma unroll
                    for (int bj = 0; bj < 2; ++bj)
#pragma unroll
                        for (int n = 0; n < 2; ++n) *(f32x4*)(o2 + 32 * bj + 4 * n) = v[bj][n]; }
                asm volatile("" ::: "memory");
            }
    }
    __device__ __forceinline__ void operator()(const f32x4 (&acc)[2][2][4][2], const Unit& u, int wr, int wc, int fr, int fq) const {
        const bool samp = u.pm >= E_MP / BM; const int sec = u.pn >> 1;
        if (u.pn < 6) {
            if (sec == 0) { if (samp) qkv<0, true>(acc, u, wr, wc, fr, fq); else qkv<0, false>(acc, u, wr, wc, fr, fq); }
            else if (sec == 1) { if (samp) qkv<1, true>(acc, u, wr, wc, fr, fq); else qkv<1, false>(acc, u, wr, wc, fr, fq); }
            else { if (samp) qkv<2, true>(acc, u, wr, wc, fr, fq); else qkv<2, false>(acc, u, wr, wc, fr, fq); }
        } else {
            const int row0 = u.pm * BM + wr * 64 + fr, cb = 128 * (u.pn - 6) + 32 * wc + 8 * fq;
#pragma unroll
            for (int ai = 0; ai < 2; ++ai)
#pragma unroll
                for (int m = 0; m < 4; ++m) { float* o = U + (size_t)(row0 + ai * HALF + m * 16) * 512 + cb;
#pragma unroll
                    for (int n = 0; n < 2; ++n) { const f32x4 a = acc[ai][0][m][n], g = acc[ai][1][m][n]; f32x4 r;
#pragma unroll
                        for (int e = 0; e < 4; ++e) r[e] = a[e] * sigmoidf_fast(g[e]);
                        *(f32x4*)(o + 4 * n) = r; } }
        }
    }
};

struct EpiOut {
    static constexpr bool PERM = true, AFTER_DRAIN = false;
    const float *xp, *xs; float* y; bf16_t* X1b; float* ssq;
    __device__ __forceinline__ void init(f32x4 (&acc)[2][2][4][2], const Unit& u, int wr, int wc, int fr, int fq) const {
        const int row0 = u.pm * BM + wr * 64 + fr, col = u.pn * BM + 32 * wc + 8 * fq; const bool samp = u.pm >= E_MP / BM;
#pragma unroll
        for (int ai = 0; ai < 2; ++ai)
#pragma unroll
            for (int m = 0; m < 4; ++m) { const int row = row0 + ai * HALF + m * 16;
                const float* xr = (samp ? xs + (size_t)(row - E_MP) * 1024 : xp + (size_t)row * 1024) + col;
#pragma unroll
                for (int bj = 0; bj < 2; ++bj)
#pragma unroll
                    for (int n = 0; n < 2; ++n) acc[ai][bj][m][n] = *(const f32x4*)(xr + bj * HALF + 4 * n); }
    }
    __device__ __forceinline__ void operator()(const f32x4 (&acc)[2][2][4][2], const Unit& u, int wr, int wc, int fr, int fq) const {
        const int row0 = u.pm * BM + wr * 64 + fr, col = u.pn * BM + 32 * wc + 8 * fq;
#pragma unroll
        for (int ai = 0; ai < 2; ++ai)
#pragma unroll
            for (int m = 0; m < 4; ++m) { const int row = row0 + ai * HALF + m * 16;
                float* yr = y + (size_t)row * 1024 + col; bf16_t* br = X1b + (size_t)row * 1024 + col; float ss = 0.f;
#pragma unroll
                for (int bj = 0; bj < 2; ++bj) { const f32x4 v0 = acc[ai][bj][m][0], v1 = acc[ai][bj][m][1];
                    *(f32x4*)(yr + bj * HALF) = v0; *(f32x4*)(yr + bj * HALF + 4) = v1;
                    u32x4 w; w.x = cvt_pk_bf16(v0[0], v0[1]); w.y = cvt_pk_bf16(v0[2], v0[3]); w.z = cvt_pk_bf16(v1[0], v1[1]); w.w = cvt_pk_bf16(v1[2], v1[3]);
                    *(u32x4*)(br + bj * HALF) = w;
                    ss += (v0[0] * v0[0] + v0[1] * v0[1]) + (v0[2] * v0[2] + v0[3] * v0[3]) + (v1[0] * v1[0] + v1[1] * v1[1]) + (v1[2] * v1[2] + v1[3] * v1[3]); }
                ss = xrow16_sum(ss);
                if (fq == 0) ssq[(size_t)row * 16 + u.pn * 4 + wc] = ss; }
    }
};

struct EpiGateUp {
    static constexpr bool PERM = true, AFTER_DRAIN = false;
    const float* ssq; bf16_t* HID; PG8_LAS float* rstab;
    __device__ __forceinline__ void init(f32x4 (&acc)[2][2][4][2], const Unit&, int, int, int, int) const {
#pragma unroll
        for (int a = 0; a < 2; ++a)
#pragma unroll
            for (int b = 0; b < 2; ++b)
#pragma unroll
                for (int m = 0; m < 4; ++m)
#pragma unroll
                    for (int n = 0; n < 2; ++n) acc[a][b][m][n] = (f32x4){0.f, 0.f, 0.f, 0.f};
    }
    __device__ __forceinline__ void operator()(const f32x4 (&acc)[2][2][4][2], const Unit& u, int wr, int wc, int fr, int fq) const {
        const int row0 = u.pm * BM + wr * 64 + fr, col = u.pn * HALF + 32 * wc + 8 * fq, lane = fr + 16 * fq;
        PG8_LAS float* tab = rstab + (wr * 4 + wc) * 128;
#pragma unroll
        for (int k = 0; k < 2; ++k) { const int j = lane + 64 * k, row = u.pm * BM + (j >> 6) * HALF + wr * 64 + ((j >> 4) & 3) * 16 + (j & 15);
            const f32x4* sp = (const f32x4*)(ssq + (size_t)row * 16); const f32x4 s0 = sp[0], s1 = sp[1], s2 = sp[2], s3 = sp[3];
            const float tot = ((s0[0] + s0[1]) + (s0[2] + s0[3])) + ((s1[0] + s1[1]) + (s1[2] + s1[3])) + ((s2[0] + s2[1]) + (s2[2] + s2[3])) + ((s3[0] + s3[1]) + (s3[2] + s3[3]));
            tab[j] = 1.0f / sqrtf(tot * (1.f / 1024.f) + 1e-6f); }
        asm volatile("s_waitcnt lgkmcnt(0)" ::: "memory");
#pragma unroll
        for (int ai = 0; ai < 2; ++ai)
#pragma unroll
            for (int m = 0; m < 4; ++m) { const int row = row0 + ai * HALF + m * 16;
                const float rs = tab[(ai * 4 + m) * 16 + fr];
                float h[8];
#pragma unroll
                for (int n = 0; n < 2; ++n)
#pragma unroll
                    for (int e = 0; e < 4; ++e) { const float g = acc[ai][0][m][n][e] * rs, up = acc[ai][1][m][n][e] * rs; h[4 * n + e] = g * sigmoidf_fast(g) * up; }
                u32x4 w; w.x = cvt_pk_bf16(h[0], h[1]); w.y = cvt_pk_bf16(h[2], h[3]); w.z = cvt_pk_bf16(h[4], h[5]); w.w = cvt_pk_bf16(h[6], h[7]);
                *(u32x4*)(HID + (size_t)row * 2816 + col) = w; }
        asm volatile("s_waitcnt lgkmcnt(0)" ::: "memory");
    }
};

struct EpiDown {
    static constexpr bool PERM = true, AFTER_DRAIN = false;
    const float* x1; float* y;
    __device__ __forceinline__ void init(f32x4 (&acc)[2][2][4][2], const Unit& u, int wr, int wc, int fr, int fq) const {
        const int row0 = u.pm * BM + wr * 64 + fr, col = u.pn * BM + 32 * wc + 8 * fq;
#pragma unroll
        for (int ai = 0; ai < 2; ++ai)
#pragma unroll
            for (int m = 0; m < 4; ++m) { const float* yr = x1 + (size_t)(row0 + ai * HALF + m * 16) * 1024 + col;
#pragma unroll
                for (int bj = 0; bj < 2; ++bj)
#pragma unroll
                    for (int n = 0; n < 2; ++n) acc[ai][bj][m][n] = *(const f32x4*)(yr + bj * HALF + 4 * n); }
    }
    __device__ __forceinline__ void operator()(const f32x4 (&acc)[2][2][4][2], const Unit& u, int wr, int wc, int fr, int fq) const {
        const int row0 = u.pm * BM + wr * 64 + fr, col = u.pn * BM + 32 * wc + 8 * fq;
#pragma unroll
        for (int ai = 0; ai < 2; ++ai)
#pragma unroll
            for (int m = 0; m < 4; ++m) { float* yr = y + (size_t)(row0 + ai * HALF + m * 16) * 1024 + col;
#pragma unroll
                for (int bj = 0; bj < 2; ++bj)
#pragma unroll
                    for (int n = 0; n < 2; ++n) *(f32x4*)(yr + bj * HALF + 4 * n) = acc[ai][bj][m][n]; }
    }
};

template <class Epi, class Sched, bool ALIGN_EPI = false, bool SP2 = false>
__device__ __forceinline__ void gemm_phase(PG8_LAS unsigned char* lds, const Gemm g, const Sched& S, const Epi& E) {
    int tid_ = threadIdx.x; asm volatile("" : "+v"(tid_));
    const int tid = tid_, wid = __builtin_amdgcn_readfirstlane(tid >> 6), lane = tid & 63, wr = wid >> 2, wc = wid & 3, fr = lane & 15, fq = lane >> 4;
    const int K = g.K, nt = K / BK;
    unsigned voffA[2], voffB[2];
#pragma unroll
    for (int i = 0; i < 2; ++i) { int R, C; stage_rc(tid * 16 + i * 8192, R, C); const int Rb = Epi::PERM ? ((R & ~31) + perm32(R & 31)) : R;
        voffA[i] = (unsigned)(R * K + C) * 2u; voffB[i] = (unsigned)(Rb * K + C) * 2u; }
    const size_t kstep = (size_t)(BK * 2);
    const size_t hstep = (size_t)HALF * K * 2;
    const size_t tstep = 2 * hstep;
    const unsigned ldsw = (unsigned)wid * 1024u;
    const int aoff = lds_byte(wr * 64 + fr, fq * 8), boff = lds_byte(wc * 32 + fr, fq * 8);
#define PG8_SA(b, h) (((b) * 2 + (h)) * HTB)
#define PG8_SB(b, h) ((4 + (b) * 2 + (h)) * HTB)
#define PG8_STAGE(bufoff, gbase, voff) do { _Pragma("unroll") for (int _i = 0; _i < 2; ++_i) \
        __builtin_amdgcn_global_load_lds((const unsigned*)((const char*)(gbase) + (voff)[_i]), (PG8_LAS unsigned*)(lds + (bufoff) + ldsw + _i * 8192), 16, 0, 0); } while (0)
#define PG8_LDA(dst, b, h) do { _Pragma("unroll") for (int m = 0; m < 4; ++m) _Pragma("unroll") for (int k = 0; k < 2; ++k) dst[m][k] = *(const PG8_LAS bf16x8*)(lds + PG8_SA(b, h) + aoff + m * 2048 + k * 1024); } while (0)
#define PG8_LDB(dst, b, h) do { _Pragma("unroll") for (int n = 0; n < 2; ++n) _Pragma("unroll") for (int k = 0; k < 2; ++k) dst[n][k] = *(const PG8_LAS bf16x8*)(lds + PG8_SB(b, h) + boff + n * 2048 + k * 1024); } while (0)
#define PG8_MMA(ai, bj, At, Bt) do { __builtin_amdgcn_s_setprio(1); _Pragma("unroll") for (int m = 0; m < 4; ++m) _Pragma("unroll") for (int n = 0; n < 2; ++n) _Pragma("unroll") for (int k = 0; k < 2; ++k) \
        acc[ai][bj][m][n] = __builtin_amdgcn_mfma_f32_16x16x32_bf16(Bt[n][k], At[m][k], acc[ai][bj][m][n], 0, 0, 0); __builtin_amdgcn_s_setprio(0); } while (0)
#define PG8_WAIT_V(n) asm volatile("s_waitcnt vmcnt(" #n ")" ::: "memory")
#define PG8_WAIT_L(n) asm volatile("s_waitcnt lgkmcnt(" #n ")" ::: "memory")
#define PG8_BAR __builtin_amdgcn_s_barrier()
#define PG8_SCHED __builtin_amdgcn_sched_barrier(0)
    Unit cur, nxt; int ui = 0;
    if (!S.next(0, cur)) return;
    f32x4 acc[2][2][4][2];
    E.init(acc, cur, wr, wc, fr, fq);
    bf16x8 At[4][2], B0[2][2], B1[2][2];
    const char* cA = (const char*)g.A + (size_t)cur.pm * tstep; const char* cB = (const char*)g.Bt + (size_t)cur.pn * tstep;
    S.a_ready(cur);
    if constexpr (SP2) {
        PG8_STAGE(PG8_SB(0, 0), cB, voffB); PG8_STAGE(PG8_SB(0, 1), cB + hstep, voffB); PG8_STAGE(PG8_SA(0, 0), cA, voffA); PG8_STAGE(PG8_SA(0, 1), cA + hstep, voffA);
        if (wr == 1) PG8_BAR;
        PG8_WAIT_V(2); PG8_BAR;
        PG8_STAGE(PG8_SB(1, 0), cB + kstep, voffB); PG8_STAGE(PG8_SA(1, 0), cA + kstep, voffA); PG8_STAGE(PG8_SB(1, 1), cB + hstep + kstep, voffB);
        PG8_WAIT_V(6); PG8_BAR;
    } else {
        PG8_STAGE(PG8_SB(0, 0), cB, voffB); PG8_STAGE(PG8_SA(0, 0), cA, voffA); PG8_STAGE(PG8_SB(0, 1), cB + hstep, voffB); PG8_STAGE(PG8_SA(0, 1), cA + hstep, voffA);
        if (wr == 1) PG8_BAR;
        PG8_WAIT_V(4); PG8_BAR;
        PG8_STAGE(PG8_SB(1, 0), cB + kstep, voffB); PG8_STAGE(PG8_SA(1, 0), cA + kstep, voffA); PG8_STAGE(PG8_SB(1, 1), cB + hstep + kstep, voffB);
        PG8_WAIT_V(6); PG8_BAR;
    }
    for (;;) {
        const bool has_next = S.next(ui + 1, nxt);
        const char* nA = has_next ? (const char*)g.A + (size_t)nxt.pm * tstep : cA; const char* nB = has_next ? (const char*)g.Bt + (size_t)nxt.pn * tstep : cB;
        for (int t = 0; t < nt; t += 2) {
            const bool last = (t == nt - 2);
            const char* a1 = cA + (size_t)(t + 1) * kstep;
            const char* a2 = last ? nA : cA + (size_t)(t + 2) * kstep; const char* b2 = last ? nB : cB + (size_t)(t + 2) * kstep;
            const char* a3 = a2 + kstep; const char* b3 = b2 + kstep;
            if (last && has_next) S.a_ready(nxt);
            if constexpr (SP2) {
            PG8_LDB(B0, 0, 0); PG8_LDB(B1, 0, 1); PG8_SCHED; PG8_LDA(At, 0, 0); PG8_STAGE(PG8_SA(1, 1), a1 + hstep, voffA);
            PG8_WAIT_V(8); PG8_WAIT_L(0); PG8_BAR; PG8_MMA(0, 0, At, B0); PG8_MMA(0, 1, At, B1); PG8_BAR; PG8_SCHED;
            PG8_LDA(At, 0, 1); PG8_STAGE(PG8_SB(0, 0), b2, voffB); PG8_STAGE(PG8_SB(0, 1), b2 + hstep, voffB); PG8_STAGE(PG8_SA(0, 0), a2, voffA);
            PG8_WAIT_V(8); PG8_WAIT_L(0); PG8_BAR; PG8_MMA(1, 0, At, B0); PG8_MMA(1, 1, At, B1); PG8_BAR; PG8_SCHED;
            PG8_LDB(B0, 1, 0); PG8_LDB(B1, 1, 1); PG8_SCHED; PG8_LDA(At, 1, 0); PG8_STAGE(PG8_SA(0, 1), a2 + hstep, voffA);
            PG8_WAIT_V(8); PG8_WAIT_L(0); PG8_BAR; PG8_MMA(0, 0, At, B0); PG8_MMA(0, 1, At, B1); PG8_BAR; PG8_SCHED;
            PG8_LDA(At, 1, 1); PG8_STAGE(PG8_SB(1, 0), b3, voffB); PG8_STAGE(PG8_SB(1, 1), b3 + hstep, voffB); PG8_STAGE(PG8_SA(1, 0), a3, voffA);
            PG8_WAIT_V(8); PG8_WAIT_L(0); PG8_BAR; PG8_MMA(1, 0, At, B0); PG8_MMA(1, 1, At, B1); PG8_BAR; PG8_SCHED;
            } else {
            PG8_LDB(B0, 0, 0); PG8_SCHED; PG8_LDA(At, 0, 0); PG8_STAGE(PG8_SA(1, 1), a1 + hstep, voffA);
            PG8_WAIT_L(8); PG8_BAR; PG8_WAIT_L(0); PG8_MMA(0, 0, At, B0); PG8_BAR; PG8_SCHED;
            PG8_LDB(B1, 0, 1); PG8_STAGE(PG8_SB(0, 0), b2, voffB);
            PG8_BAR; PG8_WAIT_L(0); PG8_MMA(0, 1, At, B1); PG8_BAR;
            PG8_LDA(At, 0, 1); PG8_STAGE(PG8_SA(0, 0), a2, voffA);
            PG8_BAR; PG8_WAIT_L(0); PG8_MMA(1, 0, At, B0); PG8_BAR; PG8_SCHED;
            PG8_STAGE(PG8_SB(0, 1), b2 + hstep, voffB);
            PG8_WAIT_V(6); PG8_BAR; PG8_MMA(1, 1, At, B1); PG8_BAR;
            PG8_LDB(B0, 1, 0); PG8_SCHED; PG8_LDA(At, 1, 0); PG8_STAGE(PG8_SA(0, 1), a2 + hstep, voffA);
            PG8_WAIT_L(8); PG8_BAR; PG8_WAIT_L(0); PG8_MMA(0, 0, At, B0); PG8_BAR; PG8_SCHED;
            PG8_LDB(B1, 1, 1); PG8_STAGE(PG8_SB(1, 0), b3, voffB);
            PG8_BAR; PG8_WAIT_L(0); PG8_MMA(0, 1, At, B1); PG8_BAR;
            PG8_LDA(At, 1, 1); PG8_STAGE(PG8_SA(1, 0), a3, voffA);
            PG8_BAR; PG8_WAIT_L(0); PG8_MMA(1, 0, At, B0); PG8_BAR; PG8_SCHED;
            PG8_STAGE(PG8_SB(1, 1), b3 + hstep, voffB);
            PG8_WAIT_V(6); PG8_BAR; PG8_MMA(1, 1, At, B1); PG8_BAR;
            }
        }
        if constexpr (ALIGN_EPI) { if (wr == 0) PG8_BAR; }
        if constexpr (!Epi::AFTER_DRAIN) { E(acc, cur, wr, wc, fr, fq); S.done(cur); }
        if (!has_next) break;
        E.init(acc, nxt, wr, wc, fr, fq);
        cur = nxt; cA = nA; cB = nB; ++ui;
        if constexpr (ALIGN_EPI) { if (wr == 1) PG8_BAR; }
    }
    PG8_WAIT_V(0);
    if constexpr (!ALIGN_EPI) { if (wr == 0) PG8_BAR; }
    PG8_BAR;
    if constexpr (Epi::AFTER_DRAIN) { E.fused(acc, cur, wr, wc, fr, fq, lds, wid, lane); S.done(cur); }
#undef PG8_SA
#undef PG8_SB
#undef PG8_STAGE
#undef PG8_LDA
#undef PG8_LDB
#undef PG8_MMA
#undef PG8_WAIT_V
#undef PG8_WAIT_L
#undef PG8_BAR
#undef PG8_SCHED
}
}

constexpr int NWAVES = 8;
constexpr int DM = 1024, NB = 8, SEQ = 2048, MP = NB * SEQ, NSMP = 128, TS = 8, MS = NSMP * TS, M = MP + MS;
constexpr int NH = 8, HD = 64, DA = 512, DC = 512, DIN = 2560, DFF = 2816, CW = 31, LBUF = 2048;
constexpr int NCH = 2;
constexpr int N_SATTN = NSMP * NCH, N_COPY = 256 * 64, N_ATT = NB * NH * 8 * 16, N_CONV = 2048 + NSMP;
constexpr size_t O_YP = 0, O_KP = 17825792, O_VP = 26214400, O_CP = 34603008, O_KS = 34725888, O_VS = 168943616, O_CS = 303161344, O_END = 305127424;
static_assert(O_KP == pg8::EO_KP && O_VP == pg8::EO_VP && O_KS == pg8::EO_KS && O_VS == pg8::EO_VS, "output map");
constexpr size_t MiB = 1u << 20;
constexpr size_t WS_CTL = 0, CTL_ZERO_BYTES = 1 * MiB;
constexpr size_t WS_W1 = 2 * MiB, WS_W2 = 8 * MiB, WS_W3 = 10 * MiB, WS_W4 = 22 * MiB;
constexpr size_t WS_H1 = 32 * MiB;
constexpr size_t WS_QB = 66 * MiB, WS_KB = 84 * MiB, WS_VB = 102 * MiB;
constexpr size_t WS_QS = 120 * MiB;
constexpr size_t WS_U = 122 * MiB;
constexpr size_t WS_MIX = 156 * MiB;
constexpr size_t WS_X1B = 190 * MiB;
constexpr size_t WS_SSQ = 224 * MiB;
constexpr size_t WS_HID = 226 * MiB;
constexpr size_t WS_PART = 320 * MiB;
constexpr size_t WS_X1F = 360 * MiB;
constexpr size_t WS_NKS = 432 * MiB, WS_NVS = 434 * MiB;
constexpr size_t WS_END = 436 * MiB;
static_assert(WS_W1 + (size_t)DIN * DM * 2 <= WS_W2 && WS_W2 + (size_t)DM * DM * 2 <= WS_W3 && WS_W3 + (size_t)2 * DFF * DM * 2 <= WS_W4 && WS_W4 + (size_t)DM * DFF * 2 <= WS_H1, "ws map 1");
static_assert(WS_H1 + (size_t)M * DM * 2 <= WS_QB && WS_QB + (size_t)M * 512 * 2 <= WS_KB && WS_KB + (size_t)M * 512 * 2 <= WS_VB && WS_VB + (size_t)M * 512 * 2 <= WS_QS, "ws map 2");
static_assert(WS_QS + (size_t)MS * 512 * 4 <= WS_U && WS_U + (size_t)M * 512 * 4 <= WS_MIX && WS_MIX + (size_t)M * DM * 2 <= WS_X1B && WS_X1B + (size_t)M * DM * 2 <= WS_SSQ, "ws map 3");
static_assert(WS_SSQ + (size_t)M * 16 * 4 <= WS_HID && WS_HID + (size_t)M * DFF * 2 <= WS_PART && WS_PART + (size_t)NSMP * NCH * 64 * 68 * 4 <= WS_X1F && WS_X1F + (size_t)M * DM * 4 <= WS_END, "ws map 4");
constexpr int CW_TMO = 0, CW_CODE = 1, CW_BAR = 4096, CW_QS = 8192, CW_QC = 8192 + 64, CW_QCOPY = 8192 + 512, CW_DONE = 8192 + 1024;
constexpr int RING_OFF = 0, RING_BYTES = 131072;
constexpr int LDSCTL_OFF = RING_BYTES, MISC_OFF = LDSCTL_OFF + 320;
constexpr int RSTAB_OFF = RING_BYTES + 1024;
constexpr int LDS_BYTES = 147456;
static_assert(MISC_OFF + 128 <= RSTAB_OFF && RSTAB_OFF + 4096 <= LDS_BYTES, "LDS map");

#define GAS __attribute__((address_space(1)))
#define LAS __attribute__((address_space(3)))
typedef unsigned short bf16;
typedef unsigned v4u __attribute__((ext_vector_type(4)));
typedef float f32x4 __attribute__((ext_vector_type(4)));
typedef short bf16x8 __attribute__((ext_vector_type(8)));
typedef GAS unsigned gu32;
typedef GAS unsigned long long gu64;
#define RLX_AGENT __ATOMIC_RELAXED, __HIP_MEMORY_SCOPE_AGENT
#define LDS_WAIT() asm volatile("s_waitcnt lgkmcnt(0)" ::: "memory")
#define VM_WAIT() asm volatile("s_waitcnt vmcnt(0)" ::: "memory")
__device__ __forceinline__ unsigned long long rt() { return __builtin_amdgcn_s_memrealtime(); }
__device__ __forceinline__ unsigned f2bf(float f) { unsigned u = __builtin_bit_cast(unsigned, f); return (u + 0x7fffu + ((u >> 16) & 1u)) >> 16; }
__device__ __forceinline__ unsigned pk2(float lo, float hi) { return f2bf(lo) | (f2bf(hi) << 16); }
#define XB_TMO      128
#define XB_XCNT(j)  (256  + 64 * (j))
#define XB_XSUB(j)  (1280 + 64 * (j))
#define XB_XGEN(j)  (2304 + 64 * (j))
#define XB_TOP      3328
#define XB_TOPGEN   3392
#define XCD_BAR_WORDS 3456
#define XB_SPIN_CAP (1u << 18)

__device__ __forceinline__ unsigned xb_ld(unsigned* p)              { return __hip_atomic_load(p, __ATOMIC_RELAXED, __HIP_MEMORY_SCOPE_AGENT); }
__device__ __forceinline__ unsigned xb_add(unsigned* p, unsigned v) { return __hip_atomic_fetch_add(p, v, __ATOMIC_RELAXED, __HIP_MEMORY_SCOPE_AGENT); }
__device__ __forceinline__ unsigned xb_xcc_id() { return (unsigned)__builtin_amdgcn_s_getreg((3 << 11) | 20) & 0xFu; }
#define XB_SPIN(cond, bar) do { unsigned _sp = 0; while (cond) { __builtin_amdgcn_s_sleep(1); \
    if ((++_sp & 255u) == 0u) { if (xb_ld(&(bar)[XB_TMO])) break; if (_sp > XB_SPIN_CAP) { atomicAdd(&(bar)[XB_TMO], 1u); break; } } } } while (0)

struct XcdBarrier {
    unsigned* bar; unsigned x;
    volatile LAS unsigned* st;
};

__device__ __forceinline__ XcdBarrier xcd_barrier_post(unsigned* bar, volatile LAS unsigned* st) {
    XcdBarrier b; b.bar = bar; b.x = xb_xcc_id(); b.st = st;
    if (threadIdx.x == 0) (void)xb_add(&bar[XB_XCNT(b.x)], 1u);
    return b;
}
__device__ __forceinline__ void xcd_barrier_complete(unsigned* bar, unsigned x, unsigned& nloc, unsigned& nx) {
    const unsigned G = gridDim.x * gridDim.y * gridDim.z;
    unsigned sum, cnt, mine, sp = 0u;
    for (;;) {
        sum = 0u; cnt = 0u; mine = 0u;
#pragma unroll
        for (unsigned j = 0; j < 16; ++j) { const unsigned c = xb_ld(&bar[XB_XCNT(j)]); sum += c; cnt += (c > 0u) ? 1u : 0u; mine = (j == x) ? c : mine; }
        if (sum == G) break;
        __builtin_amdgcn_s_sleep(1);
        if ((++sp & 255u) == 0u) { if (xb_ld(&bar[XB_TMO])) break; if (sp > XB_SPIN_CAP) { atomicAdd(&bar[XB_TMO], 1u); break; } }
    }
    nloc = mine > 0u ? mine : 1u; nx = cnt > 0u ? cnt : 1u;
}

__device__ __forceinline__ void xcd_barrier(const XcdBarrier& b) {
    asm volatile("s_waitcnt vmcnt(0)" ::: "memory");
    __syncthreads();
    if (threadIdx.x == 0) {
        unsigned* bar = b.bar;
        __builtin_amdgcn_s_waitcnt(0);
        unsigned nloc = b.st[0], nx = b.st[1];
        if (nloc == 0u) { xcd_barrier_complete(bar, b.x, nloc, nx); b.st[0] = nloc; b.st[1] = nx; }
        const unsigned old = xb_add(&bar[XB_XSUB(b.x)], 1u);
        const unsigned gen = old / nloc;
        if (old + 1u == (gen + 1u) * nloc) {
            __builtin_amdgcn_fence(__ATOMIC_RELEASE, "agent");
            asm volatile("s_waitcnt vmcnt(0)" ::: "memory");
            const unsigned og = xb_add(&bar[XB_TOP], 1u);
            const unsigned tg = og / nx;
            if (og + 1u == (tg + 1u) * nx) xb_add(&bar[XB_TOPGEN], 1u);
            else XB_SPIN(xb_ld(&bar[XB_TOPGEN]) == tg, bar);
            __builtin_amdgcn_fence(__ATOMIC_ACQUIRE, "agent");
            xb_add(&bar[XB_XGEN(b.x)], 1u);
            asm volatile("s_waitcnt vmcnt(0)" ::: "memory");
        } else {
            XB_SPIN(xb_ld(&bar[XB_XGEN(b.x)]) == gen, bar);
            __builtin_amdgcn_fence(__ATOMIC_ACQUIRE, "agent");
            asm volatile("s_waitcnt vmcnt(0)" ::: "memory");
        }
    }
    __syncthreads();
}

typedef short s16x4 __attribute__((ext_vector_type(4)));
typedef unsigned u32x2 __attribute__((ext_vector_type(2)));
__device__ __forceinline__ float wave_sum(float v) {
#pragma unroll
    for (int o = 1; o < 64; o <<= 1) v += __shfl_xor(v, o);
    return v;
}
template <int CTRL> __device__ __forceinline__ float dppf(float x) { return __builtin_bit_cast(float, __builtin_amdgcn_mov_dpp(__builtin_bit_cast(int, x), CTRL, 0xf, 0xf, true)); }
__device__ __forceinline__ float row16_sum(float x) {
    x += dppf<0xB1>(x); x += dppf<0x4E>(x); x += dppf<0x141>(x); x += dppf<0x128>(x); return x;
}
__device__ __forceinline__ float ex2(float x) { return __builtin_amdgcn_exp2f(x); }

template <int MAP> __device__ __forceinline__ int p0_dst_row(int n0) {
    if (MAP == 1) {
        if (n0 < 1536) { const int sec = n0 >> 9, hh = (n0 & 511) >> 6, d = n0 & 63; return 256 * (2 * sec + (hh >> 2)) + 128 * (d >> 5) + 32 * (hh & 3) + (d & 31); }
        if (n0 < 2048) { const int c = n0 - 1536; return 256 * (6 + (c >> 7)) + (c & 127); }
        const int c = n0 - 2048; return 256 * (6 + (c >> 7)) + 128 + (c & 127);
    }
    if (MAP == 2) return 256 * (n0 >> 7) + (n0 & 127);
    if (MAP == 3) return 256 * (n0 >> 7) + 128 + (n0 & 127);
    return n0;
}
template <int MAP> __device__ __forceinline__ void p0_item(const float* W, int K, int N, bf16* WT, const float* g, LAS float* scr, int item, int lane) {
    const int nblk = N / 64, kb = item / nblk, nb = item % nblk, k0 = 32 * kb, n0 = 64 * nb;
    f32x4 v[8];
#pragma unroll
    for (int i = 0; i < 8; ++i) v[i] = *(const f32x4*)(W + (size_t)(k0 + 4 * i + (lane >> 4)) * N + n0 + 4 * (lane & 15));
#pragma unroll
    for (int i = 0; i < 8; ++i) { const int kk = 4 * i + (lane >> 4); f32x4 w = v[i]; if (g) w = w * g[k0 + kk];
        LAS float* d = scr + kk * 65 + 4 * (lane & 15); d[0] = w.x; d[1] = w.y; d[2] = w.z; d[3] = w.w; }
    LDS_WAIT(); asm volatile("" ::: "memory");
#pragma unroll
    for (int j = 0; j < 4; ++j) { const int id = j * 64 + lane, n = id >> 2, c = id & 3; const LAS float* sp = scr + (8 * c) * 65 + n;
        v4u o; o.x = pk2(sp[0 * 65], sp[1 * 65]); o.y = pk2(sp[2 * 65], sp[3 * 65]); o.z = pk2(sp[4 * 65], sp[5 * 65]); o.w = pk2(sp[6 * 65], sp[7 * 65]);
        const int drow = p0_dst_row<MAP>(n0 + (n & 32)) + (n & 31);
        *(GAS v4u*)(WT + (size_t)drow * K + k0 + 8 * c) = o; }
    LDS_WAIT(); asm volatile("" ::: "memory");
}
__device__ __forceinline__ void rms_row_to_bf16(const float* xrow, const f32x4 (&gv)[4], bf16* orow, int lane) {
    const GAS f32x4* xr = (const GAS f32x4*)xrow + lane;
    f32x4 v[4]; float s = 0.f;
#pragma unroll
    for (int j = 0; j < 4; ++j) { v[j] = xr[64 * j]; s += (v[j].x * v[j].x + v[j].y * v[j].y) + (v[j].z * v[j].z + v[j].w * v[j].w); }
    const float rs = 1.f / sqrtf(wave_sum(s) * (1.f / 1024.f) + 1e-6f);
    GAS unsigned long long* o8 = (GAS unsigned long long*)orow + lane;
#pragma unroll
    for (int j = 0; j < 4; ++j) { const f32x4 y = v[j] * rs * gv[j]; o8[64 * j] = (unsigned long long)pk2(y.x, y.y) | ((unsigned long long)pk2(y.z, y.w) << 32); }
}

__device__ __forceinline__ void rms_row2_to_bf16(const float* xa, const float* xb, const f32x4 (&gv)[4], bf16* oa, bf16* ob, int lane) {
    const GAS f32x4* pa = (const GAS f32x4*)xa + lane; const GAS f32x4* pb = (const GAS f32x4*)(xb ? xb : xa) + lane;
    f32x4 va[4], vb[4]; float sa = 0.f, sb = 0.f;
#pragma unroll
    for (int j = 0; j < 4; ++j) { va[j] = pa[64 * j]; vb[j] = pb[64 * j]; }
#pragma unroll
    for (int j = 0; j < 4; ++j) { sa += (va[j].x * va[j].x + va[j].y * va[j].y) + (va[j].z * va[j].z + va[j].w * va[j].w); sb += (vb[j].x * vb[j].x + vb[j].y * vb[j].y) + (vb[j].z * vb[j].z + vb[j].w * vb[j].w); }
    const float ra = 1.f / sqrtf(wave_sum(sa) * (1.f / 1024.f) + 1e-6f), rb = 1.f / sqrtf(wave_sum(sb) * (1.f / 1024.f) + 1e-6f);
    GAS unsigned long long* qa = (GAS unsigned long long*)oa + lane; GAS unsigned long long* qb = (GAS unsigned long long*)ob + lane;
#pragma unroll
    for (int j = 0; j < 4; ++j) { const f32x4 y = va[j] * ra * gv[j]; qa[64 * j] = (unsigned long long)pk2(y.x, y.y) | ((unsigned long long)pk2(y.z, y.w) << 32); }
    if (xb) {
#pragma unroll
        for (int j = 0; j < 4; ++j) { const f32x4 y = vb[j] * rb * gv[j]; qb[64 * j] = (unsigned long long)pk2(y.x, y.y) | ((unsigned long long)pk2(y.z, y.w) << 32); } }
}

__device__ __forceinline__ int sa_count(int c) { return c < 6 ? 128 : (c < 12 ? 64 : (c < 15 ? 36 : 28)); }
__device__ __forceinline__ int sa_row(int c, int i) { if (c < 6) { const int j = 128 * c + i; return ((j >> 3) << 4) + (j & 7); } return (c < 12 ? 1536 + 64 * (c - 6) : 1920 + 36 * (c - 12)) + i; }
__device__ __forceinline__ void sattn_task(const float* __restrict__ ck, const float* __restrict__ cv, const float* __restrict__ out, const float* __restrict__ Qs, float* PART, LAS f32x4* ql, int n, int c, int lane) {
    asm volatile("" : "+v"(lane));
    f32x4 O[8][2]; float mx[8][2], ls[8][2];
#pragma unroll
    for (int t = 0; t < 8; ++t) { const float* qp = Qs + (size_t)(n * 8 + t) * 512 + 4 * lane; ql[(t * 2 + 0) * 64 + lane] = *(const f32x4*)qp; ql[(t * 2 + 1) * 64 + lane] = *(const f32x4*)(qp + 256);
#pragma unroll
        for (int hf = 0; hf < 2; ++hf) { O[t][hf] = (f32x4){0.f, 0.f, 0.f, 0.f}; mx[t][hf] = -1e30f; ls[t][hf] = 0.f; } }
    const int cnt = sa_count(c);
    const float* kbase = ck + (size_t)n * LBUF * 512; const float* vbase = cv + (size_t)n * LBUF * 512;
    const float* oks = out + O_KS + (size_t)n * LBUF * 512; const float* ovs = out + O_VS + (size_t)n * LBUF * 512;
    f32x4 kb[3][2], vb[3][2];
#define SA_LOAD(U, I) do { const int a_ = sa_row(c, (I)); const float* kp_ = (a_ < LBUF) ? kbase + (size_t)a_ * 512 : oks + (size_t)(a_ - 8) * 512; const float* vp_ = (a_ < LBUF) ? vbase + (size_t)a_ * 512 : ovs + (size_t)(a_ - 8) * 512; \
        kb[U][0] = *(const f32x4*)(kp_ + 4 * lane); kb[U][1] = *(const f32x4*)(kp_ + 256 + 4 * lane); vb[U][0] = *(const f32x4*)(vp_ + 4 * lane); vb[U][1] = *(const f32x4*)(vp_ + 256 + 4 * lane); } while (0)
#pragma unroll
    for (int u = 0; u < 3; ++u) SA_LOAD(u, u);
#pragma unroll 1
    for (int i0 = 0; i0 < cnt; i0 += 3) {
#pragma unroll
        for (int u = 0; u < 3; ++u) { const int i = i0 + u;
            const f32x4 k0 = kb[u][0], k1 = kb[u][1], v0 = vb[u][0], v1 = vb[u][1];
            SA_LOAD(u, (i + 3 < cnt ? i + 3 : cnt - 1));
            if (i < cnt) {
                const int a = sa_row(c, i);
#pragma unroll
                for (int t = 0; t < 8; ++t) {
                    const int dist = LBUF + t - a;
                    const int w = (dist >= 0) ? ((dist <= 128 ? 1 : 0) + (((dist & 3) == 0 && dist <= 512) ? 1 : 0) + (((dist & 15) == 0 && dist <= 2048) ? 1 : 0)) : 0;
                    if (w) { const float wf = (float)w;
#pragma unroll
                        for (int hf = 0; hf < 2; ++hf) { const f32x4 kk = hf ? k1 : k0, vv = hf ? v1 : v0; const f32x4 qq = ql[(t * 2 + hf) * 64 + lane];
                            float sc = (qq.x * kk.x + qq.y * kk.y) + (qq.z * kk.z + qq.w * kk.w);
                            sc = row16_sum(sc);
                            const float mn = fmaxf(mx[t][hf], sc), al = ex2(mx[t][hf] - mn), p = wf * ex2(sc - mn);
                            ls[t][hf] = ls[t][hf] * al + p; O[t][hf] = O[t][hf] * al + vv * p; mx[t][hf] = mn; } }
                }
            } }
    }
#undef SA_LOAD
#pragma unroll
    for (int t = 0; t < 8; ++t)
#pragma unroll
        for (int hf = 0; hf < 2; ++hf) { float* pp = PART + ((((size_t)n * NCH + c) * 8 + t) * 8 + (hf * 4 + (lane >> 4))) * 68;
            *(f32x4*)(pp + 4 * (lane & 15)) = O[t][hf]; if ((lane & 15) == 0) { pp[64] = mx[t][hf]; pp[65] = ls[t][hf]; } }
    LDS_WAIT(); asm volatile("" ::: "memory");
}
__device__ __forceinline__ void copy_piece(const float* __restrict__ ck, const float* __restrict__ cv, float* out, int id, int lane) {
    asm volatile("" : "+v"(lane));
    const int seg = id >> 6, piece = id & 63, n = seg >> 1, kv = seg & 1;
    const f32x4* src = (const f32x4*)((kv ? cv : ck) + ((size_t)n * LBUF + 8) * 512) + (size_t)piece * 4096 + lane;
    f32x4* dst = (f32x4*)(out + (kv ? O_VS : O_KS) + (size_t)n * LBUF * 512) + (size_t)piece * 4096 + lane;
    const int iters = piece == 63 ? 48 : 64;
    for (int i = 0; i < iters; i += 8) { f32x4 v[8];
#pragma unroll
        for (int u = 0; u < 8; ++u) v[u] = __builtin_nontemporal_load(src + (size_t)(i + u) * 64);
#pragma unroll
        for (int u = 0; u < 8; ++u) __builtin_nontemporal_store(v[u], dst + (size_t)(i + u) * 64); }
}
__device__ __forceinline__ int dequeue(gu32* q, int lane) { unsigned v = 0; if (lane == 0) v = __hip_atomic_fetch_add(q, 1u, __ATOMIC_RELAXED, __HIP_MEMORY_SCOPE_AGENT); return (int)__builtin_amdgcn_readfirstlane(v); }
__device__ __forceinline__ int copy_dequeue(gu32* qcopy, unsigned xcc, int lane) {
    for (unsigned k = 0; k < 8; ++k) { const unsigned sh = (xcc + k) & 7u; const int id = dequeue(qcopy + 64 * sh, lane); if (id < N_COPY / 8) return (int)(sh * (N_COPY / 8)) + id; }
    return -1;
}
__device__ __forceinline__ void bg_copy(const float* __restrict__ ck, const float* __restrict__ cv, float* out, gu32* qcopy, gu32* done, unsigned G, volatile LAS unsigned* flag, unsigned xcc, bool first_wave, bool dedicated, int lane) {
    if (first_wave && lane == 0) __hip_atomic_fetch_add(done, 1u, __ATOMIC_RELAXED, __HIP_MEMORY_SCOPE_AGENT);
    if (!dedicated) return;
    for (;;) {
        if (first_wave) { unsigned d = 0; if (lane == 0) { d = __hip_atomic_load(done, __ATOMIC_RELAXED, __HIP_MEMORY_SCOPE_AGENT); if (d >= G) *flag = 1u; }
            if ((unsigned)__builtin_amdgcn_readfirstlane(d) >= G) break; }
        else if (*flag != 0u) break;
        const int id = copy_dequeue(qcopy, xcc, lane); if (id < 0) break;
        copy_piece(ck, cv, out, id, lane);
    }
}
__device__ __forceinline__ void combine_task(const float* __restrict__ PART, bf16* MIX, int n, int t, int hf, int lane) {
    const int head = hf * 4 + (lane >> 4);
    const float* p0 = PART + (((size_t)n * NCH * 8 + t) * 8 + head) * 68;
    float mc[NCH], lc[NCH]; f32x4 oc[NCH];
#pragma unroll
    for (int c = 0; c < NCH; ++c) { const float* pp = p0 + (size_t)c * 64 * 68; mc[c] = pp[64]; lc[c] = pp[65]; oc[c] = *(const f32x4*)(pp + 4 * (lane & 15)); }
    float mm = -1e30f;
#pragma unroll
    for (int c = 0; c < NCH; ++c) mm = fmaxf(mm, mc[c]);
    f32x4 num = (f32x4){0.f, 0.f, 0.f, 0.f}; float den = 0.f;
#pragma unroll
    for (int c = 0; c < NCH; ++c) { const float f = ex2(mc[c] - mm); den += f * lc[c]; num = num + oc[c] * f; }
    const float inv = 1.f / den;
    u32x2 w; w.x = pk2(num.x * inv, num.y * inv); w.y = pk2(num.z * inv, num.w * inv);
    *(u32x2*)(MIX + (size_t)(MP + n * 8 + t) * 1024 + head * 64 + 4 * (lane & 15)) = w;
}

__device__ __forceinline__ int at_kstart(int s, int tb, int r) { return s < 5 ? 16 * tb - 128 + 32 * s : (s < 11 ? 64 * tb + (r >> 2) - 128 + 32 * (s - 5) : 256 * tb + r - 128 + 32 * (s - 11)); }
__device__ __forceinline__ s16x4 vtr(const LAS unsigned char* p) { typedef short v4i16_t __attribute__((ext_vector_type(4))); return __builtin_bit_cast(s16x4, __builtin_amdgcn_ds_read_tr16_b64_v4i16((LAS v4i16_t*)p)); }
__device__ __forceinline__ void attn_tile(const bf16* __restrict__ Qb, const bf16* __restrict__ Kb, const bf16* __restrict__ Vb, bf16* MIX, LAS unsigned char* vst, int b, int h, int tb, int r, int lane) {
    asm volatile("" : "+v"(lane));
    const int fr = lane & 15, g = lane >> 4;
    const size_t rowbase = (size_t)b * SEQ;
    const bf16* qp = Qb + (rowbase + 256 * tb + r + 16 * fr) * 512 + h * 64 + 8 * g;
    bf16x8 qf[2]; qf[0] = *(const bf16x8*)qp; qf[1] = *(const bf16x8*)(qp + 32);
    f32x4 o[4];
#pragma unroll
    for (int c = 0; c < 4; ++c) o[c] = (f32x4){0.f, 0.f, 0.f, 0.f};
    float mrun = -1e30f, lsum = 0.f;
    const bf16* Kh = Kb + rowbase * 512 + h * 64; const bf16* Vh = Vb + rowbase * 512 + h * 64;
    const LAS unsigned char* trp = vst + (4 * g + (fr >> 2)) * 144 + 8 * (fr & 3);
    const int kb16 = 16 * tb - 128, kb4 = 64 * tb + (r >> 2) - 128, kb1 = 256 * tb + r - 128;
    const int m16 = kb16 < 0 ? ((-kb16) >> 5) : 0, m4 = kb4 < 0 ? ((-kb4) >> 5) : 0, m1 = kb1 < 0 ? ((-kb1) >> 5) : 0;
    const int n16 = 5 - m16, n4 = 6 - m4, cnt = n16 + n4 + 12 - m1;
#define AT_SOF(J) ((J) < n16 ? m16 + (J) : ((J) < n16 + n4 ? 5 + m4 + ((J) - n16) : ((J) < cnt ? 11 + m1 + ((J) - n16 - n4) : 23)))
    bf16x8 kreg[2][2][2]; v4u vreg[2][4];
#define AT_LOAD(B, S) do { const int s_ = (S) < 23 ? (S) : 22; const int dsh_ = s_ < 5 ? 4 : (s_ < 11 ? 2 : 0), rd_ = s_ < 5 ? r : (s_ < 11 ? (r & 3) : 0), ks_ = at_kstart(s_, tb, r); \
        _Pragma("unroll") for (int T = 0; T < 2; ++T) { int pos = rd_ + ((ks_ + 16 * T + fr) << dsh_); pos = pos < 0 ? 0 : (pos > SEQ - 1 ? SEQ - 1 : pos); const bf16* kp = Kh + (size_t)pos * 512 + 8 * g; \
            kreg[B][T][0] = *(const bf16x8*)kp; kreg[B][T][1] = *(const bf16x8*)(kp + 32); } \
        _Pragma("unroll") for (int i = 0; i < 4; ++i) { const int ci = i * 64 + lane; int pos = rd_ + ((ks_ + (ci >> 3)) << dsh_); pos = pos < 0 ? 0 : (pos > SEQ - 1 ? SEQ - 1 : pos); \
            vreg[B][i] = *(const v4u*)(Vh + (size_t)pos * 512 + 8 * (ci & 7)); } } while (0)
#define AT_STEP(B, S, SN) do { const int sx = (S); const bool null_ = sx >= 23; const int s = null_ ? 22 : sx; \
        const int c0 = s < 5 ? 16 * tb : (s < 11 ? 64 * tb + (r >> 2) : 256 * tb + r), sqsh = s < 5 ? 0 : (s < 11 ? 2 : 4), ks = at_kstart(s, tb, r); \
        _Pragma("unroll") for (int i = 0; i < 4; ++i) { const int ci = i * 64 + lane; *(LAS v4u*)(vst + (ci >> 3) * 144 + (ci & 7) * 16) = vreg[B][i]; } \
        f32x4 st[2]; \
        _Pragma("unroll") for (int T = 0; T < 2; ++T) { st[T] = __builtin_amdgcn_mfma_f32_16x16x32_bf16(kreg[B][T][0], qf[0], (f32x4){0.f, 0.f, 0.f, 0.f}, 0, 0, 0); st[T] = __builtin_amdgcn_mfma_f32_16x16x32_bf16(kreg[B][T][1], qf[1], st[T], 0, 0, 0); } \
        AT_LOAD(B, (SN)); \
        const int hi_ = null_ ? -1 : c0 + (fr << sqsh) - ks - 4 * g;       \
        const int lo_ = null_ ? 0 : ((hi_ - 128) > (-ks - 4 * g) ? (hi_ - 128) : (-ks - 4 * g)); const unsigned span_ = (unsigned)(hi_ - lo_); \
        float rm = -INFINITY; \
        _Pragma("unroll") for (int T = 0; T < 2; ++T) \
            _Pragma("unroll") for (int e = 0; e < 4; ++e) { if (hi_ < lo_ || (unsigned)(16 * T + e - lo_) > span_) st[T][e] = -INFINITY; rm = fmaxf(rm, st[T][e]); } \
        rm = pg8::xrow16_max(rm); \
        const float mn = fmaxf(mrun, rm), al = ex2(mrun - mn); mrun = mn; \
        float ps = 0.f; \
        _Pragma("unroll") for (int T = 0; T < 2; ++T) \
            _Pragma("unroll") for (int e = 0; e < 4; ++e) { st[T][e] = ex2(st[T][e] - mn); ps += st[T][e]; } \
        lsum = lsum * al + ps; \
        _Pragma("unroll") for (int c = 0; c < 4; ++c) o[c] = o[c] * al; \
        v4u pw; pw.x = pg8::cvt_pk_bf16(st[0][0], st[0][1]); pw.y = pg8::cvt_pk_bf16(st[0][2], st[0][3]); pw.z = pg8::cvt_pk_bf16(st[1][0], st[1][1]); pw.w = pg8::cvt_pk_bf16(st[1][2], st[1][3]); \
        const bf16x8 pb = __builtin_bit_cast(bf16x8, pw); \
        asm volatile("s_waitcnt lgkmcnt(0)" ::: "memory"); \
        _Pragma("unroll") for (int c = 0; c < 4; ++c) { const s16x4 lo = vtr(trp + 32 * c), hi = vtr(trp + 16 * 144 + 32 * c); \
            const bf16x8 va = (bf16x8){lo[0], lo[1], lo[2], lo[3], hi[0], hi[1], hi[2], hi[3]}; \
            o[c] = __builtin_amdgcn_mfma_f32_16x16x32_bf16(va, pb, o[c], 0, 0, 0); } \
        asm volatile("s_waitcnt lgkmcnt(0)" ::: "memory"); } while (0)
    AT_LOAD(0, AT_SOF(0)); AT_LOAD(1, AT_SOF(1));
#pragma unroll 1
    for (int j = 0; j < cnt; j += 2) {
        AT_STEP(0, AT_SOF(j), AT_SOF(j + 2));
        AT_STEP(1, AT_SOF(j + 1), AT_SOF(j + 3));
    }
#undef AT_STEP
#undef AT_LOAD
#undef AT_SOF
    lsum = pg8::xrow16_sum(lsum);
    const float inv = 1.f / lsum;
    bf16* op = MIX + (rowbase + 256 * tb + r + 16 * fr) * 1024 + h * 64 + 4 * g;
#pragma unroll
    for (int c = 0; c < 4; ++c) { u32x2 w; w.x = pg8::cvt_pk_bf16(o[c][0] * inv, o[c][1] * inv); w.y = pg8::cvt_pk_bf16(o[c][2] * inv, o[c][3] * inv); *(u32x2*)(op + 16 * c) = w; }
}

constexpr int SA_NR = 1288, SA_STEPS = 42, SA_SPLIT = 20;
__device__ __forceinline__ int sa_a_of(int j) { return j < 768 ? ((j >> 3) << 4) + (j & 7) : 768 + j; }
__device__ __forceinline__ bf16x8 pack8(const f32x4 a, const f32x4 b) { v4u w; w.x = pg8::cvt_pk_bf16(a.x, a.y); w.y = pg8::cvt_pk_bf16(a.z, a.w); w.z = pg8::cvt_pk_bf16(b.x, b.y); w.w = pg8::cvt_pk_bf16(b.z, b.w); return __builtin_bit_cast(bf16x8, w); }
__device__ __forceinline__ void sattn_mfma(const float* __restrict__ ck, const float* __restrict__ cv, const float* __restrict__ NKs, const float* __restrict__ NVs, const bf16* __restrict__ Qb, float* PART, LAS unsigned char* vst, int n, int h, int half, int lane) {
    asm volatile("" : "+v"(lane));
    const int fr = lane & 15, g = lane >> 4;
    bf16x8 qf[2]; qf[0] = (bf16x8){0, 0, 0, 0, 0, 0, 0, 0}; qf[1] = qf[0];
    if (fr < 8) { const bf16* qp = Qb + (size_t)(MP + n * 8 + fr) * 512 + h * 64 + 8 * g; qf[0] = *(const bf16x8*)qp; qf[1] = *(const bf16x8*)(qp + 32); }
    f32x4 o[4];
#pragma unroll
    for (int c = 0; c < 4; ++c) o[c] = (f32x4){0.f, 0.f, 0.f, 0.f};
    float mrun = -1e30f, lsum = 0.f;
    const float* kbase = ck + (size_t)n * LBUF * 512 + h * 64; const float* vbase = cv + (size_t)n * LBUF * 512 + h * 64;
    const float* oks = NKs + (size_t)n * 8 * 512 + h * 64; const float* ovs = NVs + (size_t)n * 8 * 512 + h * 64;
    const LAS unsigned char* trp = vst + (4 * g + (fr >> 2)) * 144 + 8 * (fr & 3);
    const int s0 = half ? SA_SPLIT : 0, s1 = half ? SA_STEPS : SA_SPLIT;
    f32x4 kreg[2][2][2][2], vreg[2][4][2];
#define SM_LOAD(B, S) do { const int sl_ = (S); const int s_ = sl_ < SA_STEPS ? (sl_ < 0 ? 0 : sl_) : SA_STEPS - 1; \
        const bool new_ = s_ >= 40;                                \
        const float* kb_ = new_ ? oks : kbase; const float* vb_ = new_ ? ovs : vbase; \
        _Pragma("unroll") for (int T = 0; T < 2; ++T) { int j_ = 32 * s_ + 16 * T + fr; j_ = j_ < SA_NR ? j_ : SA_NR - 1; const int a_ = new_ ? 768 + j_ : sa_a_of(j_); \
            const float* kp = kb_ + (size_t)(new_ ? (a_ - LBUF) : a_) * 512 + 8 * g; \
            kreg[B][T][0][0] = *(const f32x4*)kp; kreg[B][T][0][1] = *(const f32x4*)(kp + 4); kreg[B][T][1][0] = *(const f32x4*)(kp + 32); kreg[B][T][1][1] = *(const f32x4*)(kp + 36); } \
        _Pragma("unroll") for (int i = 0; i < 4; ++i) { const int ci = i * 64 + lane; int j_ = 32 * s_ + (ci >> 3); j_ = j_ < SA_NR ? j_ : SA_NR - 1; const int a_ = new_ ? 768 + j_ : sa_a_of(j_); \
            const float* vp = vb_ + (size_t)(new_ ? (a_ - LBUF) : a_) * 512 + 8 * (ci & 7); \
            vreg[B][i][0] = *(const f32x4*)vp; vreg[B][i][1] = *(const f32x4*)(vp + 4); } } while (0)
#define SM_STEP(B, S, SN) do { const int sq_ = (S), sn_ = (SN);        \
        _Pragma("unroll") for (int i = 0; i < 4; ++i) { const int ci = i * 64 + lane; *(LAS bf16x8*)(vst + (ci >> 3) * 144 + (ci & 7) * 16) = pack8(vreg[B][i][0], vreg[B][i][1]); } \
        f32x4 st[2]; \
        _Pragma("unroll") for (int T = 0; T < 2; ++T) { st[T] = __builtin_amdgcn_mfma_f32_16x16x32_bf16(pack8(kreg[B][T][0][0], kreg[B][T][0][1]), qf[0], (f32x4){0.f, 0.f, 0.f, 0.f}, 0, 0, 0); \
            st[T] = __builtin_amdgcn_mfma_f32_16x16x32_bf16(pack8(kreg[B][T][1][0], kreg[B][T][1][1]), qf[1], st[T], 0, 0, 0); } \
        SM_LOAD(B, sn_); \
        float wgt[2][4]; float rm = -INFINITY; \
        _Pragma("unroll") for (int T = 0; T < 2; ++T) \
            _Pragma("unroll") for (int e = 0; e < 4; ++e) { const int j_ = 32 * sq_ + 16 * T + 4 * g + e; const int a_ = sa_a_of(j_ < SA_NR ? j_ : SA_NR - 1); const int dist = LBUF + fr - a_; \
                int w_ = (dist <= 128 ? 1 : 0) + (((dist & 3) == 0 && dist <= 512) ? 1 : 0) + (((dist & 15) == 0 && dist <= 2048) ? 1 : 0); \
                if (dist < 0 || fr >= 8 || j_ >= SA_NR) w_ = 0; \
                wgt[T][e] = (float)w_; if (w_ == 0) st[T][e] = -INFINITY; rm = fmaxf(rm, st[T][e]); } \
        rm = pg8::xrow16_max(rm); \
        const float mn = fmaxf(mrun, rm), al = ex2(mrun - mn); mrun = mn; \
        float ps = 0.f; \
        _Pragma("unroll") for (int T = 0; T < 2; ++T) \
            _Pragma("unroll") for (int e = 0; e < 4; ++e) { st[T][e] = wgt[T][e] * ex2(st[T][e] - mn); ps += st[T][e]; } \
        lsum = lsum * al + ps; \
        _Pragma("unroll") for (int c = 0; c < 4; ++c) o[c] = o[c] * al; \
        v4u pw; pw.x = pg8::cvt_pk_bf16(st[0][0], st[0][1]); pw.y = pg8::cvt_pk_bf16(st[0][2], st[0][3]); pw.z = pg8::cvt_pk_bf16(st[1][0], st[1][1]); pw.w = pg8::cvt_pk_bf16(st[1][2], st[1][3]); \
        const bf16x8 pb = __builtin_bit_cast(bf16x8, pw); \
        asm volatile("s_waitcnt lgkmcnt(0)" ::: "memory"); \
        _Pragma("unroll") for (int c = 0; c < 4; ++c) { const s16x4 lo = vtr(trp + 32 * c), hi = vtr(trp + 16 * 144 + 32 * c); \
            const bf16x8 va = (bf16x8){lo[0], lo[1], lo[2], lo[3], hi[0], hi[1], hi[2], hi[3]}; \
            o[c] = __builtin_amdgcn_mfma_f32_16x16x32_bf16(va, pb, o[c], 0, 0, 0); } \
        asm volatile("s_waitcnt lgkmcnt(0)" ::: "memory"); } while (0)
    SM_LOAD(0, s0); SM_LOAD(1, s0 + 1);
#pragma unroll 1
    for (int s = s0; s < s1; s += 2) {
        SM_STEP(0, s, (s + 2 < s1 ? s + 2 : s1 - 1));
        SM_STEP(1, s + 1, (s + 3 < s1 ? s + 3 : s1 - 1));
    }
#undef SM_STEP
#undef SM_LOAD
    lsum = pg8::xrow16_sum(lsum);
    if (fr < 8) { float* pp = PART + ((((size_t)n * NCH + half) * 8 + fr) * 8 + h) * 68;
#pragma unroll
        for (int c = 0; c < 4; ++c) *(f32x4*)(pp + 16 * c + 4 * g) = o[c];
        if (g == 0) { pp[64] = mrun; pp[65] = lsum; } }
}

__device__ __forceinline__ void conv_task(const float* __restrict__ U, const float* __restrict__ state, const float* __restrict__ cw, const float* __restrict__ cb, const float* __restrict__ lng, const float* __restrict__ lnb,
                                          bf16* MIX, float* out, LAS float* cl, int task, int lane) {
    asm volatile("" : "+v"(lane));
    const bool samp = task >= 2048; const int n = task - 2048, b = task >> 8, t0 = (task & 255) * 8;
    const size_t row0 = samp ? (size_t)MP + (size_t)n * 8 : (size_t)b * SEQ + t0;
    float sum[8];
#pragma unroll
    for (int t = 0; t < 8; ++t) sum[t] = 0.f;
#pragma unroll 1
    for (int cg = 0; cg < 8; ++cg) { const int ch = 64 * cg + lane;
        float win[38];
        if (samp) {
#pragma unroll
            for (int j = 0; j < 30; ++j) win[j] = state[((size_t)n * 30 + j) * 512 + ch];
#pragma unroll
            for (int j = 30; j < 38; ++j) win[j] = U[(row0 + (j - 30)) * 512 + ch];
        } else {
#pragma unroll
            for (int j = 0; j < 38; ++j) { const int tt = t0 - 30 + j; const float v = U[((size_t)b * SEQ + (tt < 0 ? 0 : tt)) * 512 + ch]; win[j] = (tt >= 0) ? v : 0.f; }
        }
        float wv[31];
#pragma unroll
        for (int j = 0; j < 31; ++j) wv[j] = cw[j * 512 + ch];
        const float bias = cb[ch];
#pragma unroll
        for (int t = 0; t < 8; ++t) { float a = bias;
#pragma unroll
            for (int j = 0; j < 31; ++j) a += wv[j] * win[t + j];
            cl[t * 512 + ch] = a; sum[t] += a; }
        if (samp) {
#pragma unroll
            for (int i = 0; i < 30; ++i) out[O_CS + ((size_t)n * 30 + i) * 512 + ch] = win[8 + i];
        } else if (t0 >= 2016) {
#pragma unroll
            for (int j = 30; j < 38; ++j) { const int tt = t0 - 30 + j; if (tt >= 2018) out[O_CP + ((size_t)b * 30 + (tt - 2018)) * 512 + ch] = win[j]; }
        }
    }
    LDS_WAIT(); asm volatile("" ::: "memory");
    float mean[8], rstd[8], s2[8];
#pragma unroll
    for (int t = 0; t < 8; ++t) { mean[t] = wave_sum(sum[t]) * (1.f / 512.f); s2[t] = 0.f; }
#pragma unroll 1
    for (int cg = 0; cg < 8; ++cg) { const int ch = 64 * cg + lane;
#pragma unroll
        for (int t = 0; t < 8; ++t) { const float d = cl[t * 512 + ch] - mean[t]; s2[t] += d * d; } }
#pragma unroll
    for (int t = 0; t < 8; ++t) rstd[t] = 1.f / sqrtf(wave_sum(s2[t]) * (1.f / 512.f) + 1e-5f);
#pragma unroll 1
    for (int cg = 0; cg < 8; ++cg) { const int ch = 64 * cg + lane; const float gg = lng[ch], bb = lnb[ch];
#pragma unroll
        for (int t = 0; t < 8; ++t) { const float y = (cl[t * 512 + ch] - mean[t]) * rstd[t] * gg + bb; const float sw = y * pg8::sigmoidf_fast(y);
            MIX[(row0 + t) * 1024 + 512 + ch] = (bf16)f2bf(sw); } }
    LDS_WAIT(); asm volatile("" ::: "memory");
}

#ifndef PH_MASK
#define PH_MASK 0xFFFF
#endif
#ifndef NC_P1
#define NC_P1 232
#endif
#ifndef NC_P3
#define NC_P3 136
#endif
#ifndef NC_P4
#define NC_P4 216
#endif
#ifndef NC_P5
#define NC_P5 136
#endif
#ifndef REP_P5
#define REP_P5 1
#endif
#ifndef REP_P0
#define REP_P0 1
#endif
#ifndef REP_P1
#define REP_P1 1
#endif
#ifndef REP_P2
#define REP_P2 1
#endif
#ifndef REP_P3
#define REP_P3 1
#endif
#ifndef REP_P4
#define REP_P4 1
#endif
struct Args { const float* in[18]; float* out; unsigned char* ws; };
__global__ void __launch_bounds__(NWAVES * 64, 2) hymba_fwd(Args args) {
    extern __shared__ __attribute__((aligned(16))) unsigned char lds[];
    LAS unsigned char* L = (LAS unsigned char*)lds;
    volatile LAS unsigned* MISC = (volatile LAS unsigned*)(L + MISC_OFF);
    const int tid = threadIdx.x, lane = tid & 63, wave = __builtin_amdgcn_readfirstlane(tid >> 6);
    const int G = gridDim.x; const int bx = blockIdx.x; const int vcu = (G % 8 == 0) ? (bx % 8) * (G / 8) + bx / 8 : bx;
    unsigned char* ws = args.ws; float* out = args.out;
    gu32* ctl = (gu32*)(ws + WS_CTL);
    const float* x_p = args.in[0]; const float* x_s = args.in[1]; const float* cache_k = args.in[2]; const float* cache_v = args.in[3]; const float* state_conv = args.in[4];
    const float* g_attn = args.in[5]; const float* w_in = args.in[6]; const float* g_q = args.in[7]; const float* g_k = args.in[8]; const float* conv_w = args.in[9]; const float* conv_b = args.in[10];
    const float* ln_g = args.in[11]; const float* ln_b = args.in[12]; const float* w_out = args.in[13]; const float* g_ffn = args.in[14]; const float* w_gate = args.in[15]; const float* w_up = args.in[16]; const float* w_down = args.in[17];
    bf16* W1t = (bf16*)(ws + WS_W1); bf16* W2t = (bf16*)(ws + WS_W2); bf16* W3t = (bf16*)(ws + WS_W3); bf16* W4t = (bf16*)(ws + WS_W4);
    bf16* H1 = (bf16*)(ws + WS_H1); bf16* Qb = (bf16*)(ws + WS_QB); bf16* Kb = (bf16*)(ws + WS_KB); bf16* Vb = (bf16*)(ws + WS_VB);
    float* Qs = (float*)(ws + WS_QS); float* U = (float*)(ws + WS_U); bf16* MIX = (bf16*)(ws + WS_MIX); bf16* X1b = (bf16*)(ws + WS_X1B); float* SSQ = (float*)(ws + WS_SSQ);
    bf16* HID = (bf16*)(ws + WS_HID); float* PART = (float*)(ws + WS_PART); float* X1F = (float*)(ws + WS_X1F); float* NKs = (float*)(ws + WS_NKS); float* NVs = (float*)(ws + WS_NVS);

    for (int u = tid; u < (LDS_BYTES - LDSCTL_OFF) / 4; u += NWAVES * 64) ((LAS unsigned*)(L + LDSCTL_OFF))[u] = 0u;
    __syncthreads();
    XcdBarrier bar = xcd_barrier_post((unsigned*)(ctl + CW_BAR), MISC + 8);
#ifdef PROBE_A
#define STAMP(k) do { if (tid == 0) MISC[16 + (k)] = (unsigned)rt(); } while (0)
#else
#define STAMP(k) do { } while (0)
#endif
    STAMP(0);
    const int gw = vcu * NWAVES + wave, NGW = G * NWAVES;

_Pragma("unroll 1") for (int rep = 0; rep < REP_P0; ++rep)
    if (PH_MASK & 1) {
        LAS float* scr = (LAS float*)(L + RING_OFF + wave * 16384);
        constexpr int I_1 = (DM / 32) * (DIN / 64), I_2 = (DM / 32) * (DM / 64), I_3 = (DM / 32) * (DFF / 64), I_4 = (DFF / 32) * (DM / 64);
        constexpr int NITEMS = I_1 + I_2 + 2 * I_3 + I_4;
        for (int it = gw; it < NITEMS; it += NGW) {
            int r = it;
            if (r < I_1) { p0_item<1>(w_in, DM, DIN, W1t, nullptr, scr, r, lane); continue; } r -= I_1;
            if (r < I_2) { p0_item<0>(w_out, DM, DM, W2t, nullptr, scr, r, lane); continue; } r -= I_2;
            if (r < I_3) { p0_item<2>(w_gate, DM, DFF, W3t, g_ffn, scr, r, lane); continue; } r -= I_3;
            if (r < I_3) { p0_item<3>(w_up, DM, DFF, W3t, g_ffn, scr, r, lane); continue; } r -= I_3;
            p0_item<0>(w_down, DFF, DM, W4t, nullptr, scr, r, lane);
        }
        f32x4 gv[4];
#pragma unroll
        for (int j = 0; j < 4; ++j) gv[j] = *((const f32x4*)g_attn + lane + 64 * j);
        for (int m = gw; m < M; m += 2 * NGW) { const int m2 = m + NGW;
            rms_row2_to_bf16(m < MP ? x_p + (size_t)m * DM : x_s + (size_t)(m - MP) * DM, m2 < M ? (m2 < MP ? x_p + (size_t)m2 * DM : x_s + (size_t)(m2 - MP) * DM) : nullptr, gv, H1 + (size_t)m * DM, H1 + (size_t)(m2 < M ? m2 : m) * DM, lane); }
    }
    xcd_barrier(bar);
    if (tid == 0) MISC[12] = 0u;
    STAMP(1);

_Pragma("unroll 1") for (int rep = 0; rep < REP_P1; ++rep)
    if (bx < (G == 256 ? NC_P1 : G)) {
        const int nc = (G == 256 ? NC_P1 : G);
        pg8::Gemm g{H1, W1t, M, DIN, DM}; pg8::StaticOrder S; S.init(M, DIN, nc, bx);
        pg8::EpiIn E{Qb, Kb, Vb, Qs, U, out, g_q, g_k, NKs, NVs};
        pg8::gemm_phase<pg8::EpiIn, pg8::StaticOrder, true, true>(L + RING_OFF, g, S, E);
    }
    bg_copy(cache_k, cache_v, out, ctl + CW_QCOPY, ctl + CW_DONE + 64 * 1, (unsigned)G, MISC + 12, bar.x, wave == 0, bx >= (G == 256 ? NC_P1 : G), lane);
    xcd_barrier(bar);
    if (tid == 0) MISC[12] = 0u;
    STAMP(2);

    {
        LAS unsigned char* vst = L + RING_OFF + wave * 16384;
        for (int it = gw; it < NSMP * NH * 2; it += NGW) sattn_mfma(cache_k, cache_v, NKs, NVs, Qb, PART, vst, it >> 4, (it >> 1) & 7, it & 1, lane);
        for (int it = gw; it < NSMP; it += NGW) conv_task(U, state_conv, conv_w, conv_b, ln_g, ln_b, MIX, out, (LAS float*)vst, 2048 + it, lane);
    }
    STAMP(9);
    xcd_barrier(bar);
    if (tid == 0) MISC[12] = 0u;
    STAMP(3);
    {
        LAS unsigned char* vst = L + RING_OFF + wave * 16384;
        for (int it = gw; it < N_ATT; it += NGW) attn_tile(Qb, Kb, Vb, MIX, vst, it >> 10, (it >> 7) & 7, ((it >> 4) + 2 * (it >> 11)) & 7, it & 15, lane);
        STAMP(10);
        for (int it = gw; it < 2048; it += NGW) conv_task(U, state_conv, conv_w, conv_b, ln_g, ln_b, MIX, out, (LAS float*)vst, it, lane);
        for (int it = gw; it < 2 * MS; it += NGW) combine_task(PART, MIX, it >> 4, (it >> 1) & 7, it & 1, lane);
    }
    STAMP(11);
    xcd_barrier(bar);
    if (tid == 0) MISC[12] = 0u;
    STAMP(4);

_Pragma("unroll 1") for (int rep = 0; rep < REP_P3; ++rep)
    if (bx < (G == 256 ? NC_P3 : G)) {
        const int nc = (G == 256 ? NC_P3 : G);
        pg8::Gemm g{MIX, W2t, M, DM, DM}; pg8::StaticOrder S; S.init(M, DM, nc, bx);
        pg8::EpiOut E{x_p, x_s, X1F, X1b, SSQ};
        pg8::gemm_phase<pg8::EpiOut, pg8::StaticOrder, true, true>(L + RING_OFF, g, S, E);
    }
    bg_copy(cache_k, cache_v, out, ctl + CW_QCOPY, ctl + CW_DONE + 64 * 4, (unsigned)G, MISC + 12, bar.x, wave == 0, bx >= (G == 256 ? NC_P3 : G), lane);
    xcd_barrier(bar);
    if (tid == 0) MISC[12] = 0u;
    STAMP(5);
_Pragma("unroll 1") for (int rep = 0; rep < REP_P4; ++rep)
    if (bx < (G == 256 ? NC_P4 : G)) {
        const int nc = (G == 256 ? NC_P4 : G);
        pg8::Gemm g{X1b, W3t, M, 2 * DFF, DM}; pg8::StaticOrder S; S.init(M, 2 * DFF, nc, bx);
        pg8::EpiGateUp E{SSQ, HID, (LAS float*)(L + RSTAB_OFF)};
        pg8::gemm_phase<pg8::EpiGateUp, pg8::StaticOrder, true, true>(L + RING_OFF, g, S, E);
    }
    bg_copy(cache_k, cache_v, out, ctl + CW_QCOPY, ctl + CW_DONE + 64 * 5, (unsigned)G, MISC + 12, bar.x, wave == 0, bx >= (G == 256 ? NC_P4 : G), lane);
    xcd_barrier(bar);
    if (tid == 0) MISC[12] = 0u;
    STAMP(6);
_Pragma("unroll 1") for (int rep = 0; rep < REP_P5; ++rep)
    if (bx < (G == 256 ? NC_P5 : G)) {
        const int nc = (G == 256 ? NC_P5 : G);
        pg8::Gemm g{HID, W4t, M, DM, DFF}; pg8::StaticOrder S; S.init(M, DM, nc, bx);
        pg8::EpiDown E{X1F, out};
        pg8::gemm_phase<pg8::EpiDown, pg8::StaticOrder, true, true>(L + RING_OFF, g, S, E);
    }
    STAMP(7);
    for (;;) { const int id = copy_dequeue(ctl + CW_QCOPY, bar.x, lane); if (id < 0) break; copy_piece(cache_k, cache_v, out, id, lane); }
#ifdef PROBE_A
    __syncthreads(); STAMP(8);
    if (bx == 0 && tid == 0) {
        const unsigned ta = MISC[16 + PROBE_A1] - MISC[16 + PROBE_A], tb = MISC[16 + PROBE_B1] - MISC[16 + PROBE_B];
        #ifdef PROBE_MUL
        const unsigned long long delay = (unsigned long long)PROBE_MUL * ta + 0ull * tb;
#else
        const unsigned long long delay = (unsigned long long)ta + 102400ull * ((tb + 200u) / 400u);
#endif
        const unsigned long long t_end = rt(); while (rt() - t_end < delay) __builtin_amdgcn_s_sleep(8);
    }
#endif
}

extern "C" void kernel_launch(void* const* d_in, const int* in_sizes, int n_in, void* d_out, int out_size, void* d_ws, size_t ws_size, hipStream_t stream) {
    static int grid = 0;
    if (grid == 0) {
        if (n_in != 18 || (size_t)out_size != O_END || ws_size < WS_END) { fprintf(stderr, "kernel_launch: unexpected shapes (n_in %d, out %d, ws %zu); nothing launched\n", n_in, out_size, ws_size); grid = -1; return; }
        int dev = 0, cus = 0, per_cu = 0;
        if (hipGetDevice(&dev) != hipSuccess || hipDeviceGetAttribute(&cus, hipDeviceAttributeMultiprocessorCount, dev) != hipSuccess) { grid = -1; return; }
        if (hipFuncSetAttribute((const void*)hymba_fwd, hipFuncAttributeMaxDynamicSharedMemorySize, LDS_BYTES) != hipSuccess) { fprintf(stderr, "kernel_launch: hipFuncSetAttribute failed\n"); grid = -1; return; }
        if (hipOccupancyMaxActiveBlocksPerMultiprocessor(&per_cu, (const void*)hymba_fwd, NWAVES * 64, LDS_BYTES) != hipSuccess || per_cu < 1)
            fprintf(stderr, "kernel_launch: note: occupancy query reports %d workgroups per CU\n", per_cu);
        (void)hipGetLastError();
        grid = cus;
    }
    if (grid < 0) return;
    if (hipMemsetAsync((char*)d_ws + WS_CTL, 0, CTL_ZERO_BYTES, stream) != hipSuccess) return;
    Args a{};
    for (int i = 0; i < 18; ++i) a.in[i] = (const float*)d_in[i];
    a.out = (float*)d_out; a.ws = (unsigned char*)d_ws;
    hipLaunchKernelGGL(hymba_fwd, dim3(grid), dim3(NWAVES * 64), LDS_BYTES, stream, a);
}
```

```cpp
#include <hip/hip_runtime.h>
#include <cstdio>
#include <cstdint>
#include <cmath>
namespace pg8 {
#define PG8_LAS __attribute__((address_space(3)))
typedef unsigned short bf16_t;
typedef short bf16x8 __attribute__((ext_vector_type(8)));
typedef float f32x4 __attribute__((ext_vector_type(4)));
typedef unsigned u32x4 __attribute__((ext_vector_type(4)));
constexpr int BM = 256, BK = 64, HALF = 128, HTB = HALF * BK * 2  , STAGE_BYTES = 8 * HTB, NXCD = 8, WGM = 8;

__host__ __device__ __forceinline__ int lds_byte(int r, int c) { const int st = (r >> 4) * 2 + (c >> 5), rr = r & 15, cc = c & 31, ob = rr * 64 + cc * 2; return st * 1024 + (ob ^ (((ob >> 9) & 1) << 5)); }
__host__ __device__ __forceinline__ void stage_rc(int b, int& R, int& C) { const int st = b / 1024, sb = b % 1024, swz = sb ^ (((sb >> 9) & 1) << 5); R = (st >> 1) * 16 + swz / 64; C = (st & 1) * 32 + (swz % 64) / 2; }
__host__ __device__ __forceinline__ int perm32(int rho) { const int n = rho >> 4, i = rho & 15; return 8 * (i >> 2) + 4 * n + (i & 3); }

struct Unit { int pm, pn; };
struct Gemm { const bf16_t* A; const bf16_t* Bt; int M, N, K; };

struct StaticOrder {
    int nM, nN, nwg, G, c;
    __host__ __device__ void init(int M, int N, int G_, int c_) { nM = M / BM; nN = N / BM; nwg = nM * nN; G = G_; c = c_; }
    __host__ __device__ bool next(int i, Unit& u) const {
        const long L = (long)i * G + c; if (L >= nwg) return false;
        int wgid = (int)L; { const int q = nwg / NXCD, r = nwg % NXCD, xcd = wgid % NXCD, off = wgid / NXCD; wgid = (xcd < r ? xcd * (q + 1) : r * (q + 1) + (xcd - r) * q) + off; }
        const int nig = WGM * nN, gid = wgid / nig, fm = gid * WGM, gsz = (nM - fm) < WGM ? (nM - fm) : WGM;
        u.pm = fm + ((wgid % nig) % gsz); u.pn = (wgid % nig) / gsz; return true;
    }
    __device__ __forceinline__ void a_ready(const Unit&) const {}
    __device__ __forceinline__ void done(const Unit&) const {}
};

__device__ __forceinline__ unsigned cvt_pk_bf16(float lo, float hi) { unsigned r; asm volatile("v_cvt_pk_bf16_f32 %0, %1, %2" : "=v"(r) : "v"(lo), "v"(hi)); return r; }
constexpr int E_MP = 16384;
constexpr size_t EO_KP = 17825792, EO_VP = 26214400, EO_KS = 34725888, EO_VS = 168943616;
constexpr float E_C2 = 0.125f * 1.4426950408889634f;
__device__ __forceinline__ float xrow16_sum(float x) {
    auto s = __builtin_amdgcn_permlane16_swap(__float_as_uint(x), __float_as_uint(x), false, false);
    x = __uint_as_float(s[0]) + __uint_as_float(s[1]);
    auto t = __builtin_amdgcn_permlane32_swap(__float_as_uint(x), __float_as_uint(x), false, false);
    return __uint_as_float(t[0]) + __uint_as_float(t[1]);
}
__device__ __forceinline__ float xrow16_max(float x) {
    auto s = __builtin_amdgcn_permlane16_swap(__float_as_uint(x), __float_as_uint(x), false, false);
    x = fmaxf(__uint_as_float(s[0]), __uint_as_float(s[1]));
    auto t = __builtin_amdgcn_permlane32_swap(__float_as_uint(x), __float_as_uint(x), false, false);
    return fmaxf(__uint_as_float(t[0]), __uint_as_float(t[1]));
}
__device__ __forceinline__ float sigmoidf_fast(float g) { return __builtin_amdgcn_rcpf(1.f + __builtin_amdgcn_exp2f(-1.4426950408889634f * g)); }

struct EpiIn {
    static constexpr bool PERM = true, AFTER_DRAIN = false;
    bf16_t *Qb, *Kb, *Vb; float *Qs, *U, *out; const float *gq, *gk; float *NKs, *NVs;
    __device__ __forceinline__ void init(f32x4 (&acc)[2][2][4][2], const Unit&, int, int, int, int) const {
#pragma unroll
        for (int a = 0; a < 2; ++a)
#pragma unroll
            for (int b = 0; b < 2; ++b)
#pragma unroll
                for (int m = 0; m < 4; ++m)
#pragma unroll
                    for (int n = 0; n < 2; ++n) acc[a][b][m][n] = (f32x4){0.f, 0.f, 0.f, 0.f};
    }
    template <int SEC, bool SAMP> __device__ __forceinline__ void qkv(const f32x4 (&acc)[2][2][4][2], const Unit& u, int wr, int wc, int fr, int fq) const {
        const int row0 = u.pm * BM + wr * 64 + fr;
        const int head = (u.pn & 1) * 4 + wc, cb = head * 64 + 8 * fq;
        f32x4 gv[2][2];
#pragma unroll
        for (int bj = 0; bj < 2; ++bj)
#pragma unroll
            for (int n = 0; n < 2; ++n) { gv[bj][n] = (f32x4){1.f, 1.f, 1.f, 1.f};
                if (SEC == 0) gv[bj][n] = *(const f32x4*)(gq + 32 * bj + 8 * fq + 4 * n) * E_C2;
                if (SEC == 1) gv[bj][n] = *(const f32x4*)(gk + 32 * bj + 8 * fq + 4 * n); }
#pragma unroll
        for (int ai = 0; ai < 2; ++ai)
#pragma unroll
            for (int m = 0; m < 4; ++m) { const int row = row0 + ai * HALF + m * 16;
                f32x4 v[2][2];
#pragma unroll
                for (int bj = 0; bj < 2; ++bj)
#pragma unroll
                    for (int n = 0; n < 2; ++n) v[bj][n] = acc[ai][bj][m][n];
                if (SEC < 2) { float ss = 0.f;
#pragma unroll
                    for (int bj = 0; bj < 2; ++bj)
#pragma unroll
                        for (int n = 0; n < 2; ++n) ss += (v[bj][n][0] * v[bj][n][0] + v[bj][n][1] * v[bj][n][1]) + (v[bj][n][2] * v[bj][n][2] + v[bj][n][3] * v[bj][n][3]);
                    ss = xrow16_sum(ss);
                    const float rinv = 1.0f / sqrtf(ss * (1.f / 64.f) + 1e-6f);
#pragma unroll
                    for (int bj = 0; bj < 2; ++bj)
#pragma unroll
                        for (int n = 0; n < 2; ++n) v[bj][n] = v[bj][n] * rinv * gv[bj][n]; }
                bf16_t* dstb = (SEC == 0 ? Qb : (SEC == 1 ? Kb : Vb)) + (size_t)row * 512 + cb;
#pragma unroll
                for (int bj = 0; bj < 2; ++bj) { u32x4 w; w.x = cvt_pk_bf16(v[bj][0][0], v[bj][0][1]); w.y = cvt_pk_bf16(v[bj][0][2], v[bj][0][3]); w.z = cvt_pk_bf16(v[bj][1][0], v[bj][1][1]); w.w = cvt_pk_bf16(v[bj][1][2], v[bj][1][3]);
                    *(u32x4*)(dstb + 32 * bj) = w; }
                if (SEC == 0 && !SAMP) { asm volatile("" ::: "memory"); continue; }
                float* o;
                if (SEC == 0) o = Qs + (size_t)(row - E_MP) * 512 + cb;
                else if (!SAMP) o = out + (SEC == 1 ? EO_KP : EO_VP) + (size_t)row * 512 + cb;
                else { const int ms = row - E_MP; o = out + (SEC == 1 ? EO_KS : EO_VS) + ((size_t)(ms >> 3) * 2048 + 2040 + (ms & 7)) * 512 + cb; }
#pragma unroll
                for (int bj = 0; bj < 2; ++bj)
#pragma unroll
                    for (int n = 0; n < 2; ++n) *(f32x4*)(o + 32 * bj + 4 * n) = v[bj][n];
                if (SEC != 0 && SAMP) { float* o2 = (SEC == 1 ? NKs : NVs) + (size_t)(row - E_MP) * 512 + cb;
#pragma unroll
                    for (int bj = 0; bj < 2; ++bj)
#pragma unroll
                        for (int n = 0; n < 2; ++n) *(f32x4*)(o2 + 32 * bj + 4 * n) = v[bj][n]; }
                asm volatile("" ::: "memory");
            }
    }
    __device__ __forceinline__ void operator()(const f32x4 (&acc)[2][2][4][2], const Unit& u, int wr, int wc, int fr, int fq) const {
        const bool samp = u.pm >= E_MP / BM; const int sec = u.pn >> 1;
        if (u.pn < 6) {
            if (sec == 0) { if (samp) qkv<0, true>(acc, u, wr, wc, fr, fq); else qkv<0, false>(acc, u, wr, wc, fr, fq); }
            else if (sec == 1) { if (samp) qkv<1, true>(acc, u, wr, wc, fr, fq); else qkv<1, false>(acc, u, wr, wc, fr, fq); }
            else { if (samp) qkv<2, true>(acc, u, wr, wc, fr, fq); else qkv<2, false>(acc, u, wr, wc, fr, fq); }
        } else {
            const int row0 = u.pm * BM + wr * 64 + fr, cb = 128 * (u.pn - 6) + 32 * wc + 8 * fq;
#pragma unroll
            for (int ai = 0; ai < 2; ++ai)
#pragma unroll
                for (int m = 0; m < 4; ++m) { float* o = U + (size_t)(row0 + ai * HALF + m * 16) * 512 + cb;
#pragma unroll
                    for (int n = 0; n < 2; ++n) { const f32x4 a = acc[ai][0][m][n], g = acc[ai][1][m][n]; f32x4 r;
#pragma unroll
                        for (int e = 0; e < 4; ++e) r[e] = a[e] * sigmoidf_fast(g[e]);
                        *(f32x4*)(o + 4 * n) = r; } }
        }
    }
};

struct EpiOut {
    static constexpr bool PERM = true, AFTER_DRAIN = false;
    const float *xp, *xs; float* y; bf16_t* X1b; float* ssq;
    __device__ __forceinline__ void init(f32x4 (&acc)[2][2][4][2], const Unit& u, int wr, int wc, int fr, int fq) const {
        const int row0 = u.pm * BM + wr * 64 + fr, col = u.pn * BM + 32 * wc + 8 * fq; const bool samp = u.pm >= E_MP / BM;
#pragma unroll
        for (int ai = 0; ai < 2; ++ai)
#pragma unroll
            for (int m = 0; m < 4; ++m) { const int row = row0 + ai * HALF + m * 16;
                const float* xr = (samp ? xs + (size_t)(row - E_MP) * 1024 : xp + (size_t)row * 1024) + col;
#pragma unroll
                for (int bj = 0; bj < 2; ++bj)
#pragma unroll
                    for (int n = 0; n < 2; ++n) acc[ai][bj][m][n] = *(const f32x4*)(xr + bj * HALF + 4 * n); }
    }
    __device__ __forceinline__ void operator()(const f32x4 (&acc)[2][2][4][2], const Unit& u, int wr, int wc, int fr, int fq) const {
        const int row0 = u.pm * BM + wr * 64 + fr, col = u.pn * BM + 32 * wc + 8 * fq;
#pragma unroll
        for (int ai = 0; ai < 2; ++ai)
#pragma unroll
            for (int m = 0; m < 4; ++m) { const int row = row0 + ai * HALF + m * 16;
                float* yr = y + (size_t)row * 1024 + col; bf16_t* br = X1b + (size_t)row * 1024 + col; float ss = 0.f;
#pragma unroll
                for (int bj = 0; bj < 2; ++bj) { const f32x4 v0 = acc[ai][bj][m][0], v1 = acc[ai][bj][m][1];
                    *(f32x4*)(yr + bj * HALF) = v0; *(f32x4*)(yr + bj * HALF + 4) = v1;
                    u32x4 w; w.x = cvt_pk_bf16(v0[0], v0[1]); w.y = cvt_pk_bf16(v0[2], v0[3]); w.z = cvt_pk_bf16(v1[0], v1[1]); w.w = cvt_pk_bf16(v1[2], v1[3]);
                    *(u32x4*)(br + bj * HALF) = w;
                    ss += (v0[0] * v0[0] + v0[1] * v0[1]) + (v0[2] * v0[2] + v0[3] * v0[3]) + (v1[0] * v1[0] + v1[1] * v1[1]) + (v1[2] * v1[2] + v1[3] * v1[3]); }
                ss = xrow16_sum(ss);
                if (fq == 0) ssq[(size_t)row * 16 + u.pn * 4 + wc] = ss; }
    }
};

struct EpiGateUp {
    static constexpr bool PERM = true, AFTER_DRAIN = false;
    const float* ssq; bf16_t* HID; PG8_LAS float* rstab;
    __device__ __forceinline__ void init(f32x4 (&acc)[2][2][4][2], const Unit&, int, int, int, int) const {
#pragma unroll
        for (int a = 0; a < 2; ++a)
#pragma unroll
            for (int b = 0; b < 2; ++b)
#pragma unroll
                for (int m = 0; m < 4; ++m)
#pragma unroll
                    for (int n = 0; n < 2; ++n) acc[a][b][m][n] = (f32x4){0.f, 0.f, 0.f, 0.f};
    }
    __device__ __forceinline__ void operator()(const f32x4 (&acc)[2][2][4][2], const Unit& u, int wr, int wc, int fr, int fq) const {
        const int row0 = u.pm * BM + wr * 64 + fr, col = u.pn * HALF + 32 * wc + 8 * fq, lane = fr + 16 * fq;
        PG8_LAS float* tab = rstab + (wr * 4 + wc) * 128;
#pragma unroll
        for (int k = 0; k < 2; ++k) { const int j = lane + 64 * k, row = u.pm * BM + (j >> 6) * HALF + wr * 64 + ((j >> 4) & 3) * 16 + (j & 15);
            const f32x4* sp = (const f32x4*)(ssq + (size_t)row * 16); const f32x4 s0 = sp[0], s1 = sp[1], s2 = sp[2], s3 = sp[3];
            const float tot = ((s0[0] + s0[1]) + (s0[2] + s0[3])) + ((s1[0] + s1[1]) + (s1[2] + s1[3])) + ((s2[0] + s2[1]) + (s2[2] + s2[3])) + ((s3[0] + s3[1]) + (s3[2] + s3[3]));
            tab[j] = 1.0f / sqrtf(tot * (1.f / 1024.f) + 1e-6f); }
        asm volatile("s_waitcnt lgkmcnt(0)" ::: "memory");
#pragma unroll
        for (int ai = 0; ai < 2; ++ai)
#pragma unroll
            for (int m = 0; m < 4; ++m) { const int row = row0 + ai * HALF + m * 16;
                const float rs = tab[(ai * 4 + m) * 16 + fr];
                float h[8];
#pragma unroll
                for (int n = 0; n < 2; ++n)
#pragma unroll
                    for (int e = 0; e < 4; ++e) { const float g = acc[ai][0][m][n][e] * rs, up = acc[ai][1][m][n][e] * rs; h[4 * n + e] = g * sigmoidf_fast(g) * up; }
                u32x4 w; w.x = cvt_pk_bf16(h[0], h[1]); w.y = cvt_pk_bf16(h[2], h[3]); w.z = cvt_pk_bf16(h[4], h[5]); w.w = cvt_pk_bf16(h[6], h[7]);
                *(u32x4*)(HID + (size_t)row * 2816 + col) = w; }
        asm volatile("s_waitcnt lgkmcnt(0)" ::: "memory");
    }
};

struct EpiDown {
    static constexpr bool PERM = true, AFTER_DRAIN = false;
    const float* x1; float* y;
    __device__ __forceinline__ void init(f32x4 (&acc)[2][2][4][2], const Unit& u, int wr, int wc, int fr, int fq) const {
        const int row0 = u.pm * BM + wr * 64 + fr, col = u.pn * BM + 32 * wc + 8 * fq;
#pragma unroll
        for (int ai = 0; ai < 2; ++ai)
#pragma unroll
            for (int m = 0; m < 4; ++m) { const float* yr = x1 + (size_t)(row0 + ai * HALF + m * 16) * 1024 + col;
#pragma unroll
                for (int bj = 0; bj < 2; ++bj)
#pragma unroll
                    for (int n = 0; n < 2; ++n) acc[ai][bj][m][n] = *(const f32x4*)(yr + bj * HALF + 4 * n); }
    }
    __device__ __forceinline__ void operator()(const f32x4 (&acc)[2][2][4][2], const Unit& u, int wr, int wc, int fr, int fq) const {
        const int row0 = u.pm * BM + wr * 64 + fr, col = u.pn * BM + 32 * wc + 8 * fq;
#pragma unroll
        for (int ai = 0; ai < 2; ++ai)
#pragma unroll
            for (int m = 0; m < 4; ++m) { float* yr = y + (size_t)(row0 + ai * HALF + m * 16) * 1024 + col;
#pragma unroll
                for (int bj = 0; bj < 2; ++bj)
#pragma unroll
                    for (int n = 0; n < 2; ++n) *(f32x4*)(yr + bj * HALF + 4 * n) = acc[ai][bj][m][n]; }
    }
};

template <class Epi, class Sched, bool ALIGN_EPI = false, bool SP2 = false>
__device__ __forceinline__ void gemm_phase(PG8_LAS unsigned char* lds, const Gemm g, const Sched& S, const Epi& E) {
    int tid_ = threadIdx.x; asm volatile("" : "+v"(tid_));
    const int tid = tid_, wid = __builtin_amdgcn_readfirstlane(tid >> 6), lane = tid & 63, wr = wid >> 2, wc = wid & 3, fr = lane & 15, fq = lane >> 4;
    const int K = g.K, nt = K / BK;
    unsigned voffA[2], voffB[2];
#pragma unroll
    for (int i = 0; i < 2; ++i) { int R, C; stage_rc(tid * 16 + i * 8192, R, C); const int Rb = Epi::PERM ? ((R & ~31) + perm32(R & 31)) : R;
        voffA[i] = (unsigned)(R * K + C) * 2u; voffB[i] = (unsigned)(Rb * K + C) * 2u; }
    const size_t kstep = (size_t)(BK * 2);
    const size_t hstep = (size_t)HALF * K * 2;
    const size_t tstep = 2 * hstep;
    const unsigned ldsw = (unsigned)wid * 1024u;
    const int aoff = lds_byte(wr * 64 + fr, fq * 8), boff = lds_byte(wc * 32 + fr, fq * 8);
#define PG8_SA(b, h) (((b) * 2 + (h)) * HTB)
#define PG8_SB(b, h) ((4 + (b) * 2 + (h)) * HTB)
#define PG8_STAGE(bufoff, gbase, voff) do { _Pragma("unroll") for (int _i = 0; _i < 2; ++_i) \
        __builtin_amdgcn_global_load_lds((const unsigned*)((const char*)(gbase) + (voff)[_i]), (PG8_LAS unsigned*)(lds + (bufoff) + ldsw + _i * 8192), 16, 0, 0); } while (0)
#define PG8_LDA(dst, b, h) do { _Pragma("unroll") for (int m = 0; m < 4; ++m) _Pragma("unroll") for (int k = 0; k < 2; ++k) dst[m][k] = *(const PG8_LAS bf16x8*)(lds + PG8_SA(b, h) + aoff + m * 2048 + k * 1024); } while (0)
#define PG8_LDB(dst, b, h) do { _Pragma("unroll") for (int n = 0; n < 2; ++n) _Pragma("unroll") for (int k = 0; k < 2; ++k) dst[n][k] = *(const PG8_LAS bf16x8*)(lds + PG8_SB(b, h) + boff + n * 2048 + k * 1024); } while (0)
#define PG8_MMA(ai, bj, At, Bt) do { __builtin_amdgcn_s_setprio(1); _Pragma("unroll") for (int m = 0; m < 4; ++m) _Pragma("unroll") for (int n = 0; n < 2; ++n) _Pragma("unroll") for (int k = 0; k < 2; ++k) \
        acc[ai][bj][m][n] = __builtin_amdgcn_mfma_f32_16x16x32_bf16(Bt[n][k], At[m][k], acc[ai][bj][m][n], 0, 0, 0); __builtin_amdgcn_s_setprio(0); } while (0)
#define PG8_WAIT_V(n) asm volatile("s_waitcnt vmcnt(" #n ")" ::: "memory")
#define PG8_WAIT_L(n) asm volatile("s_waitcnt lgkmcnt(" #n ")" ::: "memory")
#define PG8_BAR __builtin_amdgcn_s_barrier()
#define PG8_SCHED __builtin_amdgcn_sched_barrier(0)
    Unit cur, nxt; int ui = 0;
    if (!S.next(0, cur)) return;
    f32x4 acc[2][2][4][2];
    E.init(acc, cur, wr, wc, fr, fq);
    bf16x8 At[4][2], B0[2][2], B1[2][2];
    const char* cA = (const char*)g.A + (size_t)cur.pm * tstep; const char* cB = (const char*)g.Bt + (size_t)cur.pn * tstep;
    S.a_ready(cur);
    if constexpr (SP2) {
        PG8_STAGE(PG8_SB(0, 0), cB, voffB); PG8_STAGE(PG8_SB(0, 1), cB + hstep, voffB); PG8_STAGE(PG8_SA(0, 0), cA, voffA); PG8_STAGE(PG8_SA(0, 1), cA + hstep, voffA);
        if (wr == 1) PG8_BAR;
        PG8_WAIT_V(2); PG8_BAR;
        PG8_STAGE(PG8_SB(1, 0), cB + kstep, voffB); PG8_STAGE(PG8_SA(1, 0), cA + kstep, voffA); PG8_STAGE(PG8_SB(1, 1), cB + hstep + kstep, voffB);
        PG8_WAIT_V(6); PG8_BAR;
    } else {
        PG8_STAGE(PG8_SB(0, 0), cB, voffB); PG8_STAGE(PG8_SA(0, 0), cA, voffA); PG8_STAGE(PG8_SB(0, 1), cB + hstep, voffB); PG8_STAGE(PG8_SA(0, 1), cA + hstep, voffA);
        if (wr == 1) PG8_BAR;
        PG8_WAIT_V(4); PG8_BAR;
        PG8_STAGE(PG8_SB(1, 0), cB + kstep, voffB); PG8_STAGE(PG8_SA(1, 0), cA + kstep, voffA); PG8_STAGE(PG8_SB(1, 1), cB + hstep + kstep, voffB);
        PG8_WAIT_V(6); PG8_BAR;
    }
    for (;;) {
        const bool has_next = S.next(ui + 1, nxt);
        const char* nA = has_next ? (const char*)g.A + (size_t)nxt.pm * tstep : cA; const char* nB = has_next ? (const char*)g.Bt + (size_t)nxt.pn * tstep : cB;
        for (int t = 0; t < nt; t += 2) {
            const bool last = (t == nt - 2);
            const char* a1 = cA + (size_t)(t + 1) * kstep;
            const char* a2 = last ? nA : cA + (size_t)(t + 2) * kstep; const char* b2 = last ? nB : cB + (size_t)(t + 2) * kstep;
            const char* a3 = a2 + kstep; const char* b3 = b2 + kstep;
            if (last && has_next) S.a_ready(nxt);
            if constexpr (SP2) {
            PG8_LDB(B0, 0, 0); PG8_LDB(B1, 0, 1); PG8_SCHED; PG8_LDA(At, 0, 0); PG8_STAGE(PG8_SA(1, 1), a1 + hstep, voffA);
            PG8_WAIT_V(8); PG8_WAIT_L(0); PG8_BAR; PG8_MMA(0, 0, At, B0); PG8_MMA(0, 1, At, B1); PG8_BAR; PG8_SCHED;
            PG8_LDA(At, 0, 1); PG8_STAGE(PG8_SB(0, 0), b2, voffB); PG8_STAGE(PG8_SB(0, 1), b2 + hstep, voffB); PG8_STAGE(PG8_SA(0, 0), a2, voffA);
            PG8_WAIT_V(8); PG8_WAIT_L(0); PG8_BAR; PG8_MMA(1, 0, At, B0); PG8_MMA(1, 1, At, B1); PG8_BAR; PG8_SCHED;
            PG8_LDB(B0, 1, 0); PG8_LDB(B1, 1, 1); PG8_SCHED; PG8_LDA(At, 1, 0); PG8_STAGE(PG8_SA(0, 1), a2 + hstep, voffA);
            PG8_WAIT_V(8); PG8_WAIT_L(0); PG8_BAR; PG8_MMA(0, 0, At, B0); PG8_MMA(0, 1, At, B1); PG8_BAR; PG8_SCHED;
            PG8_LDA(At, 1, 1); PG8_STAGE(PG8_SB(1, 0), b3, voffB); PG8_STAGE(PG8_SB(1, 1), b3 + hstep, voffB); PG8_STAGE(PG8_SA(1, 0), a3, voffA);
            PG8_WAIT_V(8); PG8_WAIT_L(0); PG8_BAR; PG8_MMA(1, 0, At, B0); PG8_MMA(1, 1, At, B1); PG8_BAR; PG8_SCHED;
            } else {
            PG8_LDB(B0, 0, 0); PG8_SCHED; PG8_LDA(At, 0, 0); PG8_STAGE(PG8_SA(1, 1), a1 + hstep, voffA);
            PG8_WAIT_L(8); PG8_BAR; PG8_WAIT_L(0); PG8_MMA(0, 0, At, B0); PG8_BAR; PG8_SCHED;
            PG8_LDB(B1, 0, 1); PG8_STAGE(PG8_SB(0, 0), b2, voffB);
            PG8_BAR; PG8_WAIT_L(0); PG8_MMA(0, 1, At, B1); PG8_BAR;
            PG8_LDA(At, 0, 1); PG8_STAGE(PG8_SA(0, 0), a2, voffA);
            PG8_BAR; PG8_WAIT_L(0); PG8_MMA(1, 0, At, B0); PG8_BAR; PG8_SCHED;
            PG8_STAGE(PG8_SB(0, 1), b2 + hstep, voffB);
            PG8_WAIT_V(6); PG8_BAR; PG8_MMA(1, 1, At, B1); PG8_BAR;
            PG8_LDB(B0, 1, 0); PG8_SCHED; PG8_LDA(At, 1, 0); PG8_STAGE(PG8_SA(0, 1), a2 + hstep, voffA);
            PG8_WAIT_L(8); PG8_BAR; PG8_WAIT_L(0); PG8_MMA(0, 0, At, B0); PG8_BAR; PG8_SCHED;
            PG8_LDB(B1, 1, 1); PG8_STAGE(PG8_SB(1, 0), b3, voffB);
            PG8_BAR; PG8_WAIT_L(0); PG8_MMA(0, 1, At, B1); PG8_BAR;
            PG8_LDA(At, 1, 1); PG8_STAGE(PG8_SA(1, 0), a3, voffA);
            PG8_BAR; PG8_WAIT_L(0); PG8_MMA(1, 0, At, B0); PG8_BAR; PG8_SCHED;
            PG8_STAGE(PG8_SB(1, 1), b3 + hstep, voffB);
            PG8_WAIT_V(6); PG8_BAR; PG8_MMA(1, 1, At, B1); PG8_BAR;
            }
        }
        if constexpr (ALIGN_EPI) { if (wr == 0) PG8_BAR; }
        if constexpr (!Epi::AFTER_DRAIN) { E(acc, cur, wr, wc, fr, fq); S.done(cur); }
        if (!has_next) break;
        E.init(acc, nxt, wr, wc, fr, fq);
        cur = nxt; cA = nA; cB = nB; ++ui;
        if constexpr (ALIGN_EPI) { if (wr == 1) PG8_BAR; }
    }
    PG8_WAIT_V(0);
    if constexpr (!ALIGN_EPI) { if (wr == 0) PG8_BAR; }
    PG8_BAR;
    if constexpr (Epi::AFTER_DRAIN) { E.fused(acc, cur, wr, wc, fr, fq, lds, wid, lane); S.done(cur); }
#undef PG8_SA
#undef PG8_SB
#undef PG8_STAGE
#undef PG8_LDA
#undef PG8_LDB
#undef PG8_MMA
#undef PG8_WAIT_V
#undef PG8_WAIT_L
#undef PG8_BAR
#undef PG8_SCHED
}
}

constexpr int NWAVES = 8;
constexpr int DM = 1024, NB = 8, SEQ = 2048, MP = NB * SEQ, NSMP = 128, TS = 8, MS = NSMP * TS, M = MP + MS;
constexpr int NH = 8, HD = 64, DA = 512, DC = 512, DIN = 2560, DFF = 2816, CW = 31, LBUF = 2048;
constexpr int NCH = 2;
constexpr int N_SATTN = NSMP * NCH, N_COPY = 256 * 64, N_ATT = NB * NH * 8 * 16, N_CONV = 2048 + NSMP;
constexpr size_t O_YP = 0, O_KP = 17825792, O_VP = 26214400, O_CP = 34603008, O_KS = 34725888, O_VS = 168943616, O_CS = 303161344, O_END = 305127424;
static_assert(O_KP == pg8::EO_KP && O_VP == pg8::EO_VP && O_KS == pg8::EO_KS && O_VS == pg8::EO_VS, "output map");
constexpr size_t MiB = 1u << 20;
constexpr size_t WS_CTL = 0, CTL_ZERO_BYTES = 1 * MiB;
constexpr size_t WS_W1 = 2 * MiB, WS_W2 = 8 * MiB, WS_W3 = 10 * MiB, WS_W4 = 22 * MiB;
constexpr size_t WS_H1 = 32 * MiB;
constexpr size_t WS_QB = 66 * MiB, WS_KB = 84 * MiB, WS_VB = 102 * MiB;
constexpr size_t WS_QS = 120 * MiB;
constexpr size_t WS_U = 122 * MiB;
constexpr size_t WS_MIX = 156 * MiB;
constexpr size_t WS_X1B = 190 * MiB;
constexpr size_t WS_SSQ = 224 * MiB;
constexpr size_t WS_HID = 226 * MiB;
constexpr size_t WS_PART = 320 * MiB;
constexpr size_t WS_X1F = 360 * MiB;
constexpr size_t WS_NKS = 432 * MiB, WS_NVS = 434 * MiB;
constexpr size_t WS_END = 436 * MiB;
static_assert(WS_W1 + (size_t)DIN * DM * 2 <= WS_W2 && WS_W2 + (size_t)DM * DM * 2 <= WS_W3 && WS_W3 + (size_t)2 * DFF * DM * 2 <= WS_W4 && WS_W4 + (size_t)DM * DFF * 2 <= WS_H1, "ws map 1");
static_assert(WS_H1 + (size_t)M * DM * 2 <= WS_QB && WS_QB + (size_t)M * 512 * 2 <= WS_KB && WS_KB + (size_t)M * 512 * 2 <= WS_VB && WS_VB + (size_t)M * 512 * 2 <= WS_QS, "ws map 2");
static_assert(WS_QS + (size_t)MS * 512 * 4 <= WS_U && WS_U + (size_t)M * 512 * 4 <= WS_MIX && WS_MIX + (size_t)M * DM * 2 <= WS_X1B && WS_X1B + (size_t)M * DM * 2 <= WS_SSQ, "ws map 3");
static_assert(WS_SSQ + (size_t)M * 16 * 4 <= WS_HID && WS_HID + (size_t)M * DFF * 2 <= WS_PART && WS_PART + (size_t)NSMP * NCH * 64 * 68 * 4 <= WS_X1F && WS_X1F + (size_t)M * DM * 4 <= WS_END, "ws map 4");
constexpr int CW_TMO = 0, CW_CODE = 1, CW_BAR = 4096, CW_QS = 8192, CW_QC = 8192 + 64, CW_QCOPY = 8192 + 512, CW_DONE = 8192 + 1024;
constexpr int RING_OFF = 0, RING_BYTES = 131072;
constexpr int LDSCTL_OFF = RING_BYTES, MISC_OFF = LDSCTL_OFF + 320;
constexpr int RSTAB_OFF = RING_BYTES + 1024;
constexpr int LDS_BYTES = 147456;
static_assert(MISC_OFF + 128 <= RSTAB_OFF && RSTAB_OFF + 4096 <= LDS_BYTES, "LDS map");

#define GAS __attribute__((address_space(1)))
#define LAS __attribute__((address_space(3)))
typedef unsigned short bf16;
typedef unsigned v4u __attribute__((ext_vector_type(4)));
typedef float f32x4 __attribute__((ext_vector_type(4)));
typedef short bf16x8 __attribute__((ext_vector_type(8)));
typedef GAS unsigned gu32;
typedef GAS unsigned long long gu64;
#define RLX_AGENT __ATOMIC_RELAXED, __HIP_MEMORY_SCOPE_AGENT
#define LDS_WAIT() asm volatile("s_waitcnt lgkmcnt(0)" ::: "memory")
#define VM_WAIT() asm volatile("s_waitcnt vmcnt(0)" ::: "memory")
__device__ __forceinline__ unsigned long long rt() { return __builtin_amdgcn_s_memrealtime(); }
__device__ __forceinline__ unsigned f2bf(float f) { unsigned u = __builtin_bit_cast(unsigned, f); return (u + 0x7fffu + ((u >> 16) & 1u)) >> 16; }
__device__ __forceinline__ unsigned pk2(float lo, float hi) { return f2bf(lo) | (f2bf(hi) << 16); }
#define XB_TMO      128
#define XB_XCNT(j)  (256  + 64 * (j))
#define XB_XSUB(j)  (1280 + 64 * (j))
#define XB_XGEN(j)  (2304 + 64 * (j))
#define XB_TOP      3328
#define XB_TOPGEN   3392
#define XCD_BAR_WORDS 3456
#define XB_SPIN_CAP (1u << 18)

__device__ __forceinline__ unsigned xb_ld(unsigned* p)              { return __hip_atomic_load(p, __ATOMIC_RELAXED, __HIP_MEMORY_SCOPE_AGENT); }
__device__ __forceinline__ unsigned xb_add(unsigned* p, unsigned v) { return __hip_atomic_fetch_add(p, v, __ATOMIC_RELAXED, __HIP_MEMORY_SCOPE_AGENT); }
__device__ __forceinline__ unsigned xb_xcc_id() { return (unsigned)__builtin_amdgcn_s_getreg((3 << 11) | 20) & 0xFu; }
#define XB_SPIN(cond, bar) do { unsigned _sp = 0; while (cond) { __builtin_amdgcn_s_sleep(1); \
    if ((++_sp & 255u) == 0u) { if (xb_ld(&(bar)[XB_TMO])) break; if (_sp > XB_SPIN_CAP) { atomicAdd(&(bar)[XB_TMO], 1u); break; } } } } while (0)

struct XcdBarrier {
    unsigned* bar; unsigned x;
    volatile LAS unsigned* st;
};

__device__ __forceinline__ XcdBarrier xcd_barrier_post(unsigned* bar, volatile LAS unsigned* st) {
    XcdBarrier b; b.bar = bar; b.x = xb_xcc_id(); b.st = st;
    if (threadIdx.x == 0) (void)xb_add(&bar[XB_XCNT(b.x)], 1u);
    return b;
}
__device__ __forceinline__ void xcd_barrier_complete(unsigned* bar, unsigned x, unsigned& nloc, unsigned& nx) {
    const unsigned G = gridDim.x * gridDim.y * gridDim.z;
    unsigned sum, cnt, mine, sp = 0u;
    for (;;) {
        sum = 0u; cnt = 0u; mine = 0u;
#pragma unroll
        for (unsigned j = 0; j < 16; ++j) { const unsigned c = xb_ld(&bar[XB_XCNT(j)]); sum += c; cnt += (c > 0u) ? 1u : 0u; mine = (j == x) ? c : mine; }
        if (sum == G) break;
        __builtin_amdgcn_s_sleep(1);
        if ((++sp & 255u) == 0u) { if (xb_ld(&bar[XB_TMO])) break; if (sp > XB_SPIN_CAP) { atomicAdd(&bar[XB_TMO], 1u); break; } }
    }
    nloc = mine > 0u ? mine : 1u; nx = cnt > 0u ? cnt : 1u;
}

__device__ __forceinline__ void xcd_barrier(const XcdBarrier& b) {
    asm volatile("s_waitcnt vmcnt(0)" ::: "memory");
    __syncthreads();
    if (threadIdx.x == 0) {
        unsigned* bar = b.bar;
        __builtin_amdgcn_s_waitcnt(0);
        unsigned nloc = b.st[0], nx = b.st[1];
        if (nloc == 0u) { xcd_barrier_complete(bar, b.x, nloc, nx); b.st[0] = nloc; b.st[1] = nx; }
        const unsigned old = xb_add(&bar[XB_XSUB(b.x)], 1u);
        const unsigned gen = old / nloc;
        if (old + 1u == (gen + 1u) * nloc) {
            __builtin_amdgcn_fence(__ATOMIC_RELEASE, "agent");
            asm volatile("s_waitcnt vmcnt(0)" ::: "memory");
            const unsigned og = xb_add(&bar[XB_TOP], 1u);
            const unsigned tg = og / nx;
            if (og + 1u == (tg + 1u) * nx) xb_add(&bar[XB_TOPGEN], 1u);
            else XB_SPIN(xb_ld(&bar[XB_TOPGEN]) == tg, bar);
            __builtin_amdgcn_fence(__ATOMIC_ACQUIRE, "agent");
            xb_add(&bar[XB_XGEN(b.x)], 1u);
            asm volatile("s_waitcnt vmcnt(0)" ::: "memory");
        } else {
            XB_SPIN(xb_ld(&bar[XB_XGEN(b.x)]) == gen, bar);
            __builtin_amdgcn_fence(__ATOMIC_ACQUIRE, "agent");
            asm volatile("s_waitcnt vmcnt(0)" ::: "memory");
        }
    }
    __syncthreads();
}

typedef short s16x4 __attribute__((ext_vector_type(4)));
typedef unsigned u32x2 __attribute__((ext_vector_type(2)));
__device__ __forceinline__ float wave_sum(float v) {
#pragma unroll
    for (int o = 1; o < 64; o <<= 1) v += __shfl_xor(v, o);
    return v;
}
template <int CTRL> __device__ __forceinline__ float dppf(float x) { return __builtin_bit_cast(float, __builtin_amdgcn_mov_dpp(__builtin_bit_cast(int, x), CTRL, 0xf, 0xf, true)); }
__device__ __forceinline__ float row16_sum(float x) {
    x += dppf<0xB1>(x); x += dppf<0x4E>(x); x += dppf<0x141>(x); x += dppf<0x128>(x); return x;
}
__device__ __forceinline__ float ex2(float x) { return __builtin_amdgcn_exp2f(x); }

template <int MAP> __device__ __forceinline__ int p0_dst_row(int n0) {
    if (MAP == 1) {
        if (n0 < 1536) { const int sec = n0 >> 9, hh = (n0 & 511) >> 6, d = n0 & 63; return 256 * (2 * sec + (hh >> 2)) + 128 * (d >> 5) + 32 * (hh & 3) + (d & 31); }
        if (n0 < 2048) { const int c = n0 - 1536; return 256 * (6 + (c >> 7)) + (c & 127); }
        const int c = n0 - 2048; return 256 * (6 + (c >> 7)) + 128 + (c & 127);
    }
    if (MAP == 2) return 256 * (n0 >> 7) + (n0 & 127);
    if (MAP == 3) return 256 * (n0 >> 7) + 128 + (n0 & 127);
    return n0;
}
template <int MAP> __device__ __forceinline__ void p0_item(const float* W, int K, int N, bf16* WT, const float* g, LAS float* scr, int item, int lane) {
    const int nblk = N / 64, kb = item / nblk, nb = item % nblk, k0 = 32 * kb, n0 = 64 * nb;
    f32x4 v[8];
#pragma unroll
    for (int i = 0; i < 8; ++i) v[i] = *(const f32x4*)(W + (size_t)(k0 + 4 * i + (lane >> 4)) * N + n0 + 4 * (lane & 15));
#pragma unroll
    for (int i = 0; i < 8; ++i) { const int kk = 4 * i + (lane >> 4); f32x4 w = v[i]; if (g) w = w * g[k0 + kk];
        LAS float* d = scr + kk * 65 + 4 * (lane & 15); d[0] = w.x; d[1] = w.y; d[2] = w.z; d[3] = w.w; }
    LDS_WAIT(); asm volatile("" ::: "memory");
#pragma unroll
    for (int j = 0; j < 4; ++j) { const int id = j * 64 + lane, n = id >> 2, c = id & 3; const LAS float* sp = scr + (8 * c) * 65 + n;
        v4u o; o.x = pk2(sp[0 * 65], sp[1 * 65]); o.y = pk2(sp[2 * 65], sp[3 * 65]); o.z = pk2(sp[4 * 65], sp[5 * 65]); o.w = pk2(sp[6 * 65], sp[7 * 65]);
        const int drow = p0_dst_row<MAP>(n0 + (n & 32)) + (n & 31);
        *(GAS v4u*)(WT + (size_t)drow * K + k0 + 8 * c) = o; }
    LDS_WAIT(); asm volatile("" ::: "memory");
}
__device__ __forceinline__ void rms_row_to_bf16(const float* xrow, const f32x4 (&gv)[4], bf16* orow, int lane) {
    const GAS f32x4* xr = (const GAS f32x4*)xrow + lane;
    f32x4 v[4]; float s = 0.f;
#pragma unroll
    for (int j = 0; j < 4; ++j) { v[j] = xr[64 * j]; s += (v[j].x * v[j].x + v[j].y * v[j].y) + (v[j].z * v[j].z + v[j].w * v[j].w); }
    const float rs = 1.f / sqrtf(wave_sum(s) * (1.f / 1024.f) + 1e-6f);
    GAS unsigned long long* o8 = (GAS unsigned long long*)orow + lane;
#pragma unroll
    for (int j = 0; j < 4; ++j) { const f32x4 y = v[j] * rs * gv[j]; o8[64 * j] = (unsigned long long)pk2(y.x, y.y) | ((unsigned long long)pk2(y.z, y.w) << 32); }
}

__device__ __forceinline__ void rms_row2_to_bf16(const float* xa, const float* xb, const f32x4 (&gv)[4], bf16* oa, bf16* ob, int lane) {
    const GAS f32x4* pa = (const GAS f32x4*)xa + lane; const GAS f32x4* pb = (const GAS f32x4*)(xb ? xb : xa) + lane;
    f32x4 va[4], vb[4]; float sa = 0.f, sb = 0.f;
#pragma unroll
    for (int j = 0; j < 4; ++j) { va[j] = pa[64 * j]; vb[j] = pb[64 * j]; }
#pragma unroll
    for (int j = 0; j < 4; ++j) { sa += (va[j].x * va[j].x + va[j].y * va[j].y) + (va[j].z * va[j].z + va[j].w * va[j].w); sb += (vb[j].x * vb[j].x + vb[j].y * vb[j].y) + (vb[j].z * vb[j].z + vb[j].w * vb[j].w); }
    const float ra = 1.f / sqrtf(wave_sum(sa) * (1.f / 1024.f) + 1e-6f), rb = 1.f / sqrtf(wave_sum(sb) * (1.f / 1024.f) + 1e-6f);
    GAS unsigned long long* qa = (GAS unsigned long long*)oa + lane; GAS unsigned long long* qb = (GAS unsigned long long*)ob + lane;
#pragma unroll
    for (int j = 0; j < 4; ++j) { const f32x4 y = va[j] * ra * gv[j]; qa[64 * j] = (unsigned long long)pk2(y.x, y.y) | ((unsigned long long)pk2(y.z, y.w) << 32); }
    if (xb) {
#pragma unroll
        for (int j = 0; j < 4; ++j) { const f32x4 y = vb[j] * rb * gv[j]; qb[64 * j] = (unsigned long long)pk2(y.x, y.y) | ((unsigned long long)pk2(y.z, y.w) << 32); } }
}

__device__ __forceinline__ int sa_count(int c) { return c < 6 ? 128 : (c < 12 ? 64 : (c < 15 ? 36 : 28)); }
__device__ __forceinline__ int sa_row(int c, int i) { if (c < 6) { const int j = 128 * c + i; return ((j >> 3) << 4) + (j & 7); } return (c < 12 ? 1536 + 64 * (c - 6) : 1920 + 36 * (c - 12)) + i; }
__device__ __forceinline__ void sattn_task(const float* __restrict__ ck, const float* __restrict__ cv, const float* __restrict__ out, const float* __restrict__ Qs, float* PART, LAS f32x4* ql, int n, int c, int lane) {
    asm volatile("" : "+v"(lane));
    f32x4 O[8][2]; float mx[8][2], ls[8][2];
#pragma unroll
    for (int t = 0; t < 8; ++t) { const float* qp = Qs + (size_t)(n * 8 + t) * 512 + 4 * lane; ql[(t * 2 + 0) * 64 + lane] = *(const f32x4*)qp; ql[(t * 2 + 1) * 64 + lane] = *(const f32x4*)(qp + 256);
#pragma unroll
        for (int hf = 0; hf < 2; ++hf) { O[t][hf] = (f32x4){0.f, 0.f, 0.f, 0.f}; mx[t][hf] = -1e30f; ls[t][hf] = 0.f; } }
    const int cnt = sa_count(c);
    const float* kbase = ck + (size_t)n * LBUF * 512; const float* vbase = cv + (size_t)n * LBUF * 512;
    const float* oks = out + O_KS + (size_t)n * LBUF * 512; const float* ovs = out + O_VS + (size_t)n * LBUF * 512;
    f32x4 kb[3][2], vb[3][2];
#define SA_LOAD(U, I) do { const int a_ = sa_row(c, (I)); const float* kp_ = (a_ < LBUF) ? kbase + (size_t)a_ * 512 : oks + (size_t)(a_ - 8) * 512; const float* vp_ = (a_ < LBUF) ? vbase + (size_t)a_ * 512 : ovs + (size_t)(a_ - 8) * 512; \
        kb[U][0] = *(const f32x4*)(kp_ + 4 * lane); kb[U][1] = *(const f32x4*)(kp_ + 256 + 4 * lane); vb[U][0] = *(const f32x4*)(vp_ + 4 * lane); vb[U][1] = *(const f32x4*)(vp_ + 256 + 4 * lane); } while (0)
#pragma unroll
    for (int u = 0; u < 3; ++u) SA_LOAD(u, u);
#pragma unroll 1
    for (int i0 = 0; i0 < cnt; i0 += 3) {
#pragma unroll
        for (int u = 0; u < 3; ++u) { const int i = i0 + u;
            const f32x4 k0 = kb[u][0], k1 = kb[u][1], v0 = vb[u][0], v1 = vb[u][1];
            SA_LOAD(u, (i + 3 < cnt ? i + 3 : cnt - 1));
            if (i < cnt) {
                const int a = sa_row(c, i);
#pragma unroll
                for (int t = 0; t < 8; ++t) {
                    const int dist = LBUF + t - a;
                    const int w = (dist >= 0) ? ((dist <= 128 ? 1 : 0) + (((dist & 3) == 0 && dist <= 512) ? 1 : 0) + (((dist & 15) == 0 && dist <= 2048) ? 1 : 0)) : 0;
                    if (w) { const float wf = (float)w;
#pragma unroll
                        for (int hf = 0; hf < 2; ++hf) { const f32x4 kk = hf ? k1 : k0, vv = hf ? v1 : v0; const f32x4 qq = ql[(t * 2 + hf) * 64 + lane];
                            float sc = (qq.x * kk.x + qq.y * kk.y) + (qq.z * kk.z + qq.w * kk.w);
                            sc = row16_sum(sc);
                            const float mn = fmaxf(mx[t][hf], sc), al = ex2(mx[t][hf] - mn), p = wf * ex2(sc - mn);
                            ls[t][hf] = ls[t][hf] * al + p; O[t][hf] = O[t][hf] * al + vv * p; mx[t][hf] = mn; } }
                }
            } }
    }
#undef SA_LOAD
#pragma unroll
    for (int t = 0; t < 8; ++t)
#pragma unroll
        for (int hf = 0; hf < 2; ++hf) { float* pp = PART + ((((size_t)n * NCH + c) * 8 + t) * 8 + (hf * 4 + (lane >> 4))) * 68;
            *(f32x4*)(pp + 4 * (lane & 15)) = O[t][hf]; if ((lane & 15) == 0) { pp[64] = mx[t][hf]; pp[65] = ls[t][hf]; } }
    LDS_WAIT(); asm volatile("" ::: "memory");
}
__device__ __forceinline__ void copy_piece(const float* __restrict__ ck, const float* __restrict__ cv, float* out, int id, int lane) {
    asm volatile("" : "+v"(lane));
    const int seg = id >> 6, piece = id & 63, n = seg >> 1, kv = seg & 1;
    const f32x4* src = (const f32x4*)((kv ? cv : ck) + ((size_t)n * LBUF + 8) * 512) + (size_t)piece * 4096 + lane;
    f32x4* dst = (f32x4*)(out + (kv ? O_VS : O_KS) + (size_t)n * LBUF * 512) + (size_t)piece * 4096 + lane;
    const int iters = piece == 63 ? 48 : 64;
    for (int i = 0; i < iters; i += 8) { f32x4 v[8];
#pragma unroll
        for (int u = 0; u < 8; ++u) v[u] = __builtin_nontemporal_load(src + (size_t)(i + u) * 64);
#pragma unroll
        for (int u = 0; u < 8; ++u) __builtin_nontemporal_store(v[u], dst + (size_t)(i + u) * 64); }
}
__device__ __forceinline__ int dequeue(gu32* q, int lane) { unsigned v = 0; if (lane == 0) v = __hip_atomic_fetch_add(q, 1u, __ATOMIC_RELAXED, __HIP_MEMORY_SCOPE_AGENT); return (int)__builtin_amdgcn_readfirstlane(v); }
__device__ __forceinline__ int copy_dequeue(gu32* qcopy, unsigned xcc, int lane) {
    for (unsigned k = 0; k < 8; ++k) { const unsigned sh = (xcc + k) & 7u; const int id = dequeue(qcopy + 64 * sh, lane); if (id < N_COPY / 8) return (int)(sh * (N_COPY / 8)) + id; }
    return -1;
}
__device__ __forceinline__ void bg_copy(const float* __restrict__ ck, const float* __restrict__ cv, float* out, gu32* qcopy, gu32* done, unsigned G, volatile LAS unsigned* flag, unsigned xcc, bool first_wave, bool dedicated, int lane) {
    if (first_wave && lane == 0) __hip_atomic_fetch_add(done, 1u, __ATOMIC_RELAXED, __HIP_MEMORY_SCOPE_AGENT);
    if (!dedicated) return;
    for (;;) {
        if (first_wave) { unsigned d = 0; if (lane == 0) { d = __hip_atomic_load(done, __ATOMIC_RELAXED, __HIP_MEMORY_SCOPE_AGENT); if (d >= G) *flag = 1u; }
            if ((unsigned)__builtin_amdgcn_readfirstlane(d) >= G) break; }
        else if (*flag != 0u) break;
        const int id = copy_dequeue(qcopy, xcc, lane); if (id < 0) break;
        copy_piece(ck, cv, out, id, lane);
    }
}
__device__ __forceinline__ void combine_task(const float* __restrict__ PART, bf16* MIX, int n, int t, int hf, int lane) {
    const int head = hf * 4 + (lane >> 4);
    const float* p0 = PART + (((size_t)n * NCH * 8 + t) * 8 + head) * 68;
    float mc[NCH], lc[NCH]; f32x4 oc[NCH];
#pragma unroll
    for (int c = 0; c < NCH; ++c) { const float* pp = p0 + (size_t)c * 64 * 68; mc[c] = pp[64]; lc[c] = pp[65]; oc[c] = *(const f32x4*)(pp + 4 * (lane & 15)); }
    float mm = -1e30f;
#pragma unroll
    for (int c = 0; c < NCH; ++c) mm = fmaxf(mm, mc[c]);
    f32x4 num = (f32x4){0.f, 0.f, 0.f, 0.f}; float den = 0.f;
#pragma unroll
    for (int c = 0; c < NCH; ++c) { const float f = ex2(mc[c] - mm); den += f * lc[c]; num = num + oc[c] * f; }
    const float inv = 1.f / den;
    u32x2 w; w.x = pk2(num.x * inv, num.y * inv); w.y = pk2(num.z * inv, num.w * inv);
    *(u32x2*)(MIX + (size_t)(MP + n * 8 + t) * 1024 + head * 64 + 4 * (lane & 15)) = w;
}

__device__ __forceinline__ int at_kstart(int s, int tb, int r) { return s < 5 ? 16 * tb - 128 + 32 * s : (s < 11 ? 64 * tb + (r >> 2) - 128 + 32 * (s - 5) : 256 * tb + r - 128 + 32 * (s - 11)); }
__device__ __forceinline__ s16x4 vtr(const LAS unsigned char* p) { typedef short v4i16_t __attribute__((ext_vector_type(4))); return __builtin_bit_cast(s16x4, __builtin_amdgcn_ds_read_tr16_b64_v4i16((LAS v4i16_t*)p)); }
__device__ __forceinline__ void attn_tile(const bf16* __restrict__ Qb, const bf16* __restrict__ Kb, const bf16* __restrict__ Vb, bf16* MIX, LAS unsigned char* vst, int b, int h, int tb, int r, int lane) {
    asm volatile("" : "+v"(lane));
    const int fr = lane & 15, g = lane >> 4;
    const size_t rowbase = (size_t)b * SEQ;
    const bf16* qp = Qb + (rowbase + 256 * tb + r + 16 * fr) * 512 + h * 64 + 8 * g;
    bf16x8 qf[2]; qf[0] = *(const bf16x8*)qp; qf[1] = *(const bf16x8*)(qp + 32);
    f32x4 o[4];
#pragma unroll
    for (int c = 0; c < 4; ++c) o[c] = (f32x4){0.f, 0.f, 0.f, 0.f};
    float mrun = -1e30f, lsum = 0.f;
    const bf16* Kh = Kb + rowbase * 512 + h * 64; const bf16* Vh = Vb + rowbase * 512 + h * 64;
    const LAS unsigned char* trp = vst + (4 * g + (fr >> 2)) * 144 + 8 * (fr & 3);
    const int kb16 = 16 * tb - 128, kb4 = 64 * tb + (r >> 2) - 128, kb1 = 256 * tb + r - 128;
    const int m16 = kb16 < 0 ? ((-kb16) >> 5) : 0, m4 = kb4 < 0 ? ((-kb4) >> 5) : 0, m1 = kb1 < 0 ? ((-kb1) >> 5) : 0;
    const int n16 = 5 - m16, n4 = 6 - m4, cnt = n16 + n4 + 12 - m1;
#define AT_SOF(J) ((J) < n16 ? m16 + (J) : ((J) < n16 + n4 ? 5 + m4 + ((J) - n16) : ((J) < cnt ? 11 + m1 + ((J) - n16 - n4) : 23)))
    bf16x8 kreg[2][2][2]; v4u vreg[2][4];
#define AT_LOAD(B, S) do { const int s_ = (S) < 23 ? (S) : 22; const int dsh_ = s_ < 5 ? 4 : (s_ < 11 ? 2 : 0), rd_ = s_ < 5 ? r : (s_ < 11 ? (r & 3) : 0), ks_ = at_kstart(s_, tb, r); \
        _Pragma("unroll") for (int T = 0; T < 2; ++T) { int pos = rd_ + ((ks_ + 16 * T + fr) << dsh_); pos = pos < 0 ? 0 : (pos > SEQ - 1 ? SEQ - 1 : pos); const bf16* kp = Kh + (size_t)pos * 512 + 8 * g; \
            kreg[B][T][0] = *(const bf16x8*)kp; kreg[B][T][1] = *(const bf16x8*)(kp + 32); } \
        _Pragma("unroll") for (int i = 0; i < 4; ++i) { const int ci = i * 64 + lane; int pos = rd_ + ((ks_ + (ci >> 3)) << dsh_); pos = pos < 0 ? 0 : (pos > SEQ - 1 ? SEQ - 1 : pos); \
            vreg[B][i] = *(const v4u*)(Vh + (size_t)pos * 512 + 8 * (ci & 7)); } } while (0)
#define AT_STEP(B, S, SN) do { const int sx = (S); const bool null_ = sx >= 23; const int s = null_ ? 22 : sx; \
        const int c0 = s < 5 ? 16 * tb : (s < 11 ? 64 * tb + (r >> 2) : 256 * tb + r), sqsh = s < 5 ? 0 : (s < 11 ? 2 : 4), ks = at_kstart(s, tb, r); \
        _Pragma("unroll") for (int i = 0; i < 4; ++i) { const int ci = i * 64 + lane; *(LAS v4u*)(vst + (ci >> 3) * 144 + (ci & 7) * 16) = vreg[B][i]; } \
        f32x4 st[2]; \
        _Pragma("unroll") for (int T = 0; T < 2; ++T) { st[T] = __builtin_amdgcn_mfma_f32_16x16x32_bf16(kreg[B][T][0], qf[0], (f32x4){0.f, 0.f, 0.f, 0.f}, 0, 0, 0); st[T] = __builtin_amdgcn_mfma_f32_16x16x32_bf16(kreg[B][T][1], qf[1], st[T], 0, 0, 0); } \
        AT_LOAD(B, (SN)); \
        const int hi_ = null_ ? -1 : c0 + (fr << sqsh) - ks - 4 * g;       \
        const int lo_ = null_ ? 0 : ((hi_ - 128) > (-ks - 4 * g) ? (hi_ - 128) : (-ks - 4 * g)); const unsigned span_ = (unsigned)(hi_ - lo_); \
        float rm = -INFINITY; \
        _Pragma("unroll") for (int T = 0; T < 2; ++T) \
            _Pragma("unroll") for (int e = 0; e < 4; ++e) { if (hi_ < lo_ || (unsigned)(16 * T + e - lo_) > span_) st[T][e] = -INFINITY; rm = fmaxf(rm, st[T][e]); } \
        rm = pg8::xrow16_max(rm); \
        const float mn = fmaxf(mrun, rm), al = ex2(mrun - mn); mrun = mn; \
        float ps = 0.f; \
        _Pragma("unroll") for (int T = 0; T < 2; ++T) \
            _Pragma("unroll") for (int e = 0; e < 4; ++e) { st[T][e] = ex2(st[T][e] - mn); ps += st[T][e]; } \
        lsum = lsum * al + ps; \
        _Pragma("unroll") for (int c = 0; c < 4; ++c) o[c] = o[c] * al; \
        v4u pw; pw.x = pg8::cvt_pk_bf16(st[0][0], st[0][1]); pw.y = pg8::cvt_pk_bf16(st[0][2], st[0][3]); pw.z = pg8::cvt_pk_bf16(st[1][0], st[1][1]); pw.w = pg8::cvt_pk_bf16(st[1][2], st[1][3]); \
        const bf16x8 pb = __builtin_bit_cast(bf16x8, pw); \
        asm volatile("s_waitcnt lgkmcnt(0)" ::: "memory"); \
        _Pragma("unroll") for (int c = 0; c < 4; ++c) { const s16x4 lo = vtr(trp + 32 * c), hi = vtr(trp + 16 * 144 + 32 * c); \
            const bf16x8 va = (bf16x8){lo[0], lo[1], lo[2], lo[3], hi[0], hi[1], hi[2], hi[3]}; \
            o[c] = __builtin_amdgcn_mfma_f32_16x16x32_bf16(va, pb, o[c], 0, 0, 0); } \
        asm volatile("s_waitcnt lgkmcnt(0)" ::: "memory"); } while (0)
    AT_LOAD(0, AT_SOF(0)); AT_LOAD(1, AT_SOF(1));
#pragma unroll 1
    for (int j = 0; j < cnt; j += 2) {
        AT_STEP(0, AT_SOF(j), AT_SOF(j + 2));
        AT_STEP(1, AT_SOF(j + 1), AT_SOF(j + 3));
    }
#undef AT_STEP
#undef AT_LOAD
#undef AT_SOF
    lsum = pg8::xrow16_sum(lsum);
    const float inv = 1.f / lsum;
    bf16* op = MIX + (rowbase + 256 * tb + r + 16 * fr) * 1024 + h * 64 + 4 * g;
#pragma unroll
    for (int c = 0; c < 4; ++c) { u32x2 w; w.x = pg8::cvt_pk_bf16(o[c][0] * inv, o[c][1] * inv); w.y = pg8::cvt_pk_bf16(o[c][2] * inv, o[c][3] * inv); *(u32x2*)(op + 16 * c) = w; }
}

constexpr int SA_NR = 1288, SA_STEPS = 42, SA_SPLIT = 20;
__device__ __forceinline__ int sa_a_of(int j) { return j < 768 ? ((j >> 3) << 4) + (j & 7) : 768 + j; }
__device__ __forceinline__ bf16x8 pack8(const f32x4 a, const f32x4 b) { v4u w; w.x = pg8::cvt_pk_bf16(a.x, a.y); w.y = pg8::cvt_pk_bf16(a.z, a.w); w.z = pg8::cvt_pk_bf16(b.x, b.y); w.w = pg8::cvt_pk_bf16(b.z, b.w); return __builtin_bit_cast(bf16x8, w); }
__device__ __forceinline__ void sattn_mfma(const float* __restrict__ ck, const float* __restrict__ cv, const float* __restrict__ NKs, const float* __restrict__ NVs, const bf16* __restrict__ Qb, float* PART, LAS unsigned char* vst, int n, int h, int half, int lane) {
    asm volatile("" : "+v"(lane));
    const int fr = lane & 15, g = lane >> 4;
    bf16x8 qf[2]; qf[0] = (bf16x8){0, 0, 0, 0, 0, 0, 0, 0}; qf[1] = qf[0];
    if (fr < 8) { const bf16* qp = Qb + (size_t)(MP + n * 8 + fr) * 512 + h * 64 + 8 * g; qf[0] = *(const bf16x8*)qp; qf[1] = *(const bf16x8*)(qp + 32); }
    f32x4 o[4];
#pragma unroll
    for (int c = 0; c < 4; ++c) o[c] = (f32x4){0.f, 0.f, 0.f, 0.f};
    float mrun = -1e30f, lsum = 0.f;
    const float* kbase = ck + (size_t)n * LBUF * 512 + h * 64; const float* vbase = cv + (size_t)n * LBUF * 512 + h * 64;
    const float* oks = NKs + (size_t)n * 8 * 512 + h * 64; const float* ovs = NVs + (size_t)n * 8 * 512 + h * 64;
    const LAS unsigned char* trp = vst + (4 * g + (fr >> 2)) * 144 + 8 * (fr & 3);
    const int s0 = half ? SA_SPLIT : 0, s1 = half ? SA_STEPS : SA_SPLIT;
    f32x4 kreg[2][2][2][2], vreg[2][4][2];
#define SM_LOAD(B, S) do { const int sl_ = (S); const int s_ = sl_ < SA_STEPS ? (sl_ < 0 ? 0 : sl_) : SA_STEPS - 1; \
        const bool new_ = s_ >= 40;                                \
        const float* kb_ = new_ ? oks : kbase; const float* vb_ = new_ ? ovs : vbase; \
        _Pragma("unroll") for (int T = 0; T < 2; ++T) { int j_ = 32 * s_ + 16 * T + fr; j_ = j_ < SA_NR ? j_ : SA_NR - 1; const int a_ = new_ ? 768 + j_ : sa_a_of(j_); \
            const float* kp = kb_ + (size_t)(new_ ? (a_ - LBUF) : a_) * 512 + 8 * g; \
            kreg[B][T][0][0] = *(const f32x4*)kp; kreg[B][T][0][1] = *(const f32x4*)(kp + 4); kreg[B][T][1][0] = *(const f32x4*)(kp + 32); kreg[B][T][1][1] = *(const f32x4*)(kp + 36); } \
        _Pragma("unroll") for (int i = 0; i < 4; ++i) { const int ci = i * 64 + lane; int j_ = 32 * s_ + (ci >> 3); j_ = j_ < SA_NR ? j_ : SA_NR - 1; const int a_ = new_ ? 768 + j_ : sa_a_of(j_); \
            const float* vp = vb_ + (size_t)(new_ ? (a_ - LBUF) : a_) * 512 + 8 * (ci & 7); \
            vreg[B][i][0] = *(const f32x4*)vp; vreg[B][i][1] = *(const f32x4*)(vp + 4); } } while (0)
#define SM_STEP(B, S, SN) do { const int sq_ = (S), sn_ = (SN);        \
        _Pragma("unroll") for (int i = 0; i < 4; ++i) { const int ci = i * 64 + lane; *(LAS bf16x8*)(vst + (ci >> 3) * 144 + (ci & 7) * 16) = pack8(vreg[B][i][0], vreg[B][i][1]); } \
        f32x4 st[2]; \
        _Pragma("unroll") for (int T = 0; T < 2; ++T) { st[T] = __builtin_amdgcn_mfma_f32_16x16x32_bf16(pack8(kreg[B][T][0][0], kreg[B][T][0][1]), qf[0], (f32x4){0.f, 0.f, 0.f, 0.f}, 0, 0, 0); \
            st[T] = __builtin_amdgcn_mfma_f32_16x16x32_bf16(pack8(kreg[B][T][1][0], kreg[B][T][1][1]), qf[1], st[T], 0, 0, 0); } \
        SM_LOAD(B, sn_); \
        float wgt[2][4]; float rm = -INFINITY; \
        _Pragma("unroll") for (int T = 0; T < 2; ++T) \
            _Pragma("unroll") for (int e = 0; e < 4; ++e) { const int j_ = 32 * sq_ + 16 * T + 4 * g + e; const int a_ = sa_a_of(j_ < SA_NR ? j_ : SA_NR - 1); const int dist = LBUF + fr - a_; \
                int w_ = (dist <= 128 ? 1 : 0) + (((dist & 3) == 0 && dist <= 512) ? 1 : 0) + (((dist & 15) == 0 && dist <= 2048) ? 1 : 0); \
                if (dist < 0 || fr >= 8 || j_ >= SA_NR) w_ = 0; \
                wgt[T][e] = (float)w_; if (w_ == 0) st[T][e] = -INFINITY; rm = fmaxf(rm, st[T][e]); } \
        rm = pg8::xrow16_max(rm); \
        const float mn = fmaxf(mrun, rm), al = ex2(mrun - mn); mrun = mn; \
        float ps = 0.f; \
        _Pragma("unroll") for (int T = 0; T < 2; ++T) \
            _Pragma("unroll") for (int e = 0; e < 4; ++e) { st[T][e] = wgt[T][e] * ex2(st[T][e] - mn); ps += st[T][e]; } \
        lsum = lsum * al + ps; \
        _Pragma("unroll") for (int c = 0; c < 4; ++c) o[c] = o[c] * al; \
        v4u pw; pw.x = pg8::cvt_pk_bf16(st[0][0], st[0][1]); pw.y = pg8::cvt_pk_bf16(st[0][2], st[0][3]); pw.z = pg8::cvt_pk_bf16(st[1][0], st[1][1]); pw.w = pg8::cvt_pk_bf16(st[1][2], st[1][3]); \
        const bf16x8 pb = __builtin_bit_cast(bf16x8, pw); \
        asm volatile("s_waitcnt lgkmcnt(0)" ::: "memory"); \
        _Pragma("unroll") for (int c = 0; c < 4; ++c) { const s16x4 lo = vtr(trp + 32 * c), hi = vtr(trp + 16 * 144 + 32 * c); \
            const bf16x8 va = (bf16x8){lo[0], lo[1], lo[2], lo[3], hi[0], hi[1], hi[2], hi[3]}; \
            o[c] = __builtin_amdgcn_mfma_f32_16x16x32_bf16(va, pb, o[c], 0, 0, 0); } \
        asm volatile("s_waitcnt lgkmcnt(0)" ::: "memory"); } while (0)
    SM_LOAD(0, s0); SM_LOAD(1, s0 + 1);
#pragma unroll 1
    for (int s = s0; s < s1; s += 2) {
        SM_STEP(0, s, (s + 2 < s1 ? s + 2 : s1 - 1));
        SM_STEP(1, s + 1, (s + 3 < s1 ? s + 3 : s1 - 1));
    }
#undef SM_STEP
#undef SM_LOAD
    lsum = pg8::xrow16_sum(lsum);
    if (fr < 8) { float* pp = PART + ((((size_t)n * NCH + half) * 8 + fr) * 8 + h) * 68;
#pragma unroll
        for (int c = 0; c < 4; ++c) *(f32x4*)(pp + 16 * c + 4 * g) = o[c];
        if (g == 0) { pp[64] = mrun; pp[65] = lsum; } }
}

constexpr int SF_STRIDE = 1040, SF_VIMG = 32 * SF_STRIDE;
__device__ __forceinline__ void stream_fused(const float* __restrict__ ck, const float* __restrict__ cv, const float* __restrict__ NKs, const float* __restrict__ NVs, float* out,
                                             const bf16* __restrict__ Qb, float* PART, LAS unsigned char* img, int n, int part, int tid) {
    asm volatile("" : "+v"(tid));
    const int lane = tid & 63, h = __builtin_amdgcn_readfirstlane(tid >> 6), fr = lane & 15, g = lane >> 4;
    const int rsub = __builtin_amdgcn_readfirstlane(tid >> 7), cc = tid & 127;
    bf16x8 qf[2]; qf[0] = (bf16x8){0, 0, 0, 0, 0, 0, 0, 0}; qf[1] = qf[0];
    if (fr < 8) { const bf16* qp = Qb + (size_t)(MP + n * 8 + fr) * 512 + h * 64 + 8 * g; qf[0] = *(const bf16x8*)qp; qf[1] = *(const bf16x8*)(qp + 32); }
    f32x4 o[4];
#pragma unroll
    for (int c = 0; c < 4; ++c) o[c] = (f32x4){0.f, 0.f, 0.f, 0.f};
    float mrun = -1e30f, lsum = 0.f;
    const float* kbase = ck + (size_t)n * LBUF * 512 + 4 * cc; const float* vbase = cv + (size_t)n * LBUF * 512 + 4 * cc;
    const float* nkb = NKs + (size_t)n * 8 * 512 + 4 * cc; const float* nvb = NVs + (size_t)n * 8 * 512 + 4 * cc;
    float* oks = out + O_KS + (size_t)n * LBUF * 512 + 4 * cc; float* ovs = out + O_VS + (size_t)n * LBUF * 512 + 4 * cc;
    const LAS unsigned char* kfp = img + fr * SF_STRIDE + h * 128 + 16 * g;
    const LAS unsigned char* trp = img + SF_VIMG + (4 * g + (fr >> 2)) * SF_STRIDE + h * 128 + 8 * (fr & 3);
    LAS unsigned char* wrp = img + rsub * SF_STRIDE + cc * 8;
    const int b0 = part ? 32 : 0, b1 = part ? 66 : 32;
    f32x4 ra[16], rb[16];
#define SF_LOAD(R, BB) do { const int bb_ = (BB) < b1 ? (BB) : b1 - 1; \
        _Pragma("unroll") for (int i = 0; i < 8; ++i) { int a_ = 32 * bb_ + 4 * i + rsub; a_ = a_ < LBUF + TS ? a_ : LBUF + TS - 1; const bool new_ = a_ >= LBUF; \
            const float* kp = new_ ? nkb + (size_t)(a_ - LBUF) * 512 : kbase + (size_t)a_ * 512; const float* vp = new_ ? nvb + (size_t)(a_ - LBUF) * 512 : vbase + (size_t)a_ * 512; \
            R[i] = __builtin_nontemporal_load((const f32x4*)kp); R[8 + i] = __builtin_nontemporal_load((const f32x4*)vp); } } while (0)
#define SF_CONSUME(R, BB) do { const int bb_ = (BB); \
        _Pragma("unroll") for (int i = 0; i < 8; ++i) { const int a_ = 32 * bb_ + 4 * i + rsub; \
            if (a_ >= 8 && a_ < LBUF) { __builtin_nontemporal_store(R[i], (f32x4*)(oks + (size_t)(a_ - 8) * 512)); __builtin_nontemporal_store(R[8 + i], (f32x4*)(ovs + (size_t)(a_ - 8) * 512)); } \
            u32x2 wk, wv; wk.x = pg8::cvt_pk_bf16(R[i].x, R[i].y); wk.y = pg8::cvt_pk_bf16(R[i].z, R[i].w); wv.x = pg8::cvt_pk_bf16(R[8 + i].x, R[8 + i].y); wv.y = pg8::cvt_pk_bf16(R[8 + i].z, R[8 + i].w); \
            *(LAS u32x2*)(wrp + 4 * i * SF_STRIDE) = wk; *(LAS u32x2*)(wrp + SF_VIMG + 4 * i * SF_STRIDE) = wv; } } while (0)
#define SF_BAR() do { asm volatile("s_waitcnt lgkmcnt(0)" ::: "memory"); __builtin_amdgcn_s_barrier(); asm volatile("" ::: "memory"); } while (0)
#define SF_STEP(BB) do { const int bq_ = (BB); \
        f32x4 st[2]; \
        _Pragma("unroll") for (int T = 0; T < 2; ++T) { const bf16x8 k0 = *(const LAS bf16x8*)(kfp + T * 16 * SF_STRIDE), k1 = *(const LAS bf16x8*)(kfp + T * 16 * SF_STRIDE + 64); \
            st[T] = __builtin_amdgcn_mfma_f32_16x16x32_bf16(k0, qf[0], (f32x4){0.f, 0.f, 0.f, 0.f}, 0, 0, 0); st[T] = __builtin_amdgcn_mfma_f32_16x16x32_bf16(k1, qf[1], st[T], 0, 0, 0); } \
        float wgt[2][4]; float rm = -INFINITY; \
        _Pragma("unroll") for (int T = 0; T < 2; ++T) \
            _Pragma("unroll") for (int e = 0; e < 4; ++e) { const int dist = LBUF + fr - (32 * bq_ + 16 * T + 4 * g + e); \
                int w_ = (dist <= 128 ? 1 : 0) + (((dist & 3) == 0 && dist <= 512) ? 1 : 0) + (((dist & 15) == 0 && dist <= 2048) ? 1 : 0); \
                if (dist < 0 || fr >= 8) w_ = 0; \
                wgt[T][e] = (float)w_; if (w_ == 0) st[T][e] = -INFINITY; rm = fmaxf(rm, st[T][e]); } \
        rm = pg8::xrow16_max(rm); \
        const float mn = fmaxf(mrun, rm), al = ex2(mrun - mn); mrun = mn; \
        float ps = 0.f; \
        _Pragma("unroll") for (int T = 0; T < 2; ++T) \
            _Pragma("unroll") for (int e = 0; e < 4; ++e) { st[T][e] = wgt[T][e] * ex2(st[T][e] - mn); ps += st[T][e]; } \
        lsum = lsum * al + ps; \
        _Pragma("unroll") for (int c = 0; c < 4; ++c) o[c] = o[c] * al; \
        v4u pw; pw.x = pg8::cvt_pk_bf16(st[0][0], st[0][1]); pw.y = pg8::cvt_pk_bf16(st[0][2], st[0][3]); pw.z = pg8::cvt_pk_bf16(st[1][0], st[1][1]); pw.w = pg8::cvt_pk_bf16(st[1][2], st[1][3]); \
        const bf16x8 pb = __builtin_bit_cast(bf16x8, pw); \
        _Pragma("unroll") for (int c = 0; c < 4; ++c) { const s16x4 lo = vtr(trp + 32 * c), hi = vtr(trp + 16 * SF_STRIDE + 32 * c); \
            const bf16x8 va = (bf16x8){lo[0], lo[1], lo[2], lo[3], hi[0], hi[1], hi[2], hi[3]}; \
            o[c] = __builtin_amdgcn_mfma_f32_16x16x32_bf16(va, pb, o[c], 0, 0, 0); } } while (0)
    SF_LOAD(ra, b0); SF_LOAD(rb, b0 + 1);
#pragma unroll 1
    for (int b = b0; b < b1; b += 2) {
        SF_CONSUME(ra, b); SF_LOAD(ra, b + 2); SF_BAR(); SF_STEP(b); SF_BAR();
        SF_CONSUME(rb, b + 1); SF_LOAD(rb, b + 3); SF_BAR(); SF_STEP(b + 1); SF_BAR();
    }
#undef SF_LOAD
#undef SF_CONSUME
#undef SF_STEP
#undef SF_BAR
    lsum = pg8::xrow16_sum(lsum);
    if (fr < 8) { float* pp = PART + ((((size_t)n * NCH + part) * 8 + fr) * 8 + h) * 68;
#pragma unroll
        for (int c = 0; c < 4; ++c) *(f32x4*)(pp + 16 * c + 4 * g) = o[c];
        if (g == 0) { pp[64] = mrun; pp[65] = lsum; } }
}

__device__ __forceinline__ void conv_task(const float* __restrict__ U, const float* __restrict__ state, const float* __restrict__ cw, const float* __restrict__ cb, const float* __restrict__ lng, const float* __restrict__ lnb,
                                          bf16* MIX, float* out, LAS float* cl, int task, int lane) {
    asm volatile("" : "+v"(lane));
    const bool samp = task >= 2048; const int n = task - 2048, b = task >> 8, t0 = (task & 255) * 8;
    const size_t row0 = samp ? (size_t)MP + (size_t)n * 8 : (size_t)b * SEQ + t0;
    float sum[8];
#pragma unroll
    for (int t = 0; t < 8; ++t) sum[t] = 0.f;
#pragma unroll 1
    for (int cg = 0; cg < 8; ++cg) { const int ch = 64 * cg + lane;
        float win[38];
        if (samp) {
#pragma unroll
            for (int j = 0; j < 30; ++j) win[j] = state[((size_t)n * 30 + j) * 512 + ch];
#pragma unroll
            for (int j = 30; j < 38; ++j) win[j] = U[(row0 + (j - 30)) * 512 + ch];
        } else {
#pragma unroll
            for (int j = 0; j < 38; ++j) { const int tt = t0 - 30 + j; const float v = U[((size_t)b * SEQ + (tt < 0 ? 0 : tt)) * 512 + ch]; win[j] = (tt >= 0) ? v : 0.f; }
        }
        float wv[31];
#pragma unroll
        for (int j = 0; j < 31; ++j) wv[j] = cw[j * 512 + ch];
        const float bias = cb[ch];
#pragma unroll
        for (int t = 0; t < 8; ++t) { float a = bias;
#pragma unroll
            for (int j = 0; j < 31; ++j) a += wv[j] * win[t + j];
            cl[t * 512 + ch] = a; sum[t] += a; }
        if (samp) {
#pragma unroll
            for (int i = 0; i < 30; ++i) out[O_CS + ((size_t)n * 30 + i) * 512 + ch] = win[8 + i];
        } else if (t0 >= 2016) {
#pragma unroll
            for (int j = 30; j < 38; ++j) { const int tt = t0 - 30 + j; if (tt >= 2018) out[O_CP + ((size_t)b * 30 + (tt - 2018)) * 512 + ch] = win[j]; }
        }
    }
    LDS_WAIT(); asm volatile("" ::: "memory");
    float mean[8], rstd[8], s2[8];
#pragma unroll
    for (int t = 0; t < 8; ++t) { mean[t] = wave_sum(sum[t]) * (1.f / 512.f); s2[t] = 0.f; }
#pragma unroll 1
    for (int cg = 0; cg < 8; ++cg) { const int ch = 64 * cg + lane;
#pragma unroll
        for (int t = 0; t < 8; ++t) { const float d = cl[t * 512 + ch] - mean[t]; s2[t] += d * d; } }
#pragma unroll
    for (int t = 0; t < 8; ++t) rstd[t] = 1.f / sqrtf(wave_sum(s2[t]) * (1.f / 512.f) + 1e-5f);
#pragma unroll 1
    for (int cg = 0; cg < 8; ++cg) { const int ch = 64 * cg + lane; const float gg = lng[ch], bb = lnb[ch];
#pragma unroll
        for (int t = 0; t < 8; ++t) { const float y = (cl[t * 512 + ch] - mean[t]) * rstd[t] * gg + bb; const float sw = y * pg8::sigmoidf_fast(y);
            MIX[(row0 + t) * 1024 + 512 + ch] = (bf16)f2bf(sw); } }
    LDS_WAIT(); asm volatile("" ::: "memory");
}

template <int MODE> __device__ __forceinline__ void small_gemm(const bf16* __restrict__ A, int lda, const bf16* __restrict__ Bt, int K, int tile, LAS float* red,
                                                               const float* __restrict__ xs, float* X1F, bf16* X1b, float* SSQ, float* y, int tid) {
    asm volatile("" : "+v"(tid));
    const int lane = tid & 63, wv = __builtin_amdgcn_readfirstlane(tid >> 6), fr = lane & 15, g = lane >> 4;
    const int tm = tile >> 4, tn = tile & 15, kw = K / 8, nst = kw / 32;
    f32x4 acc[4][4];
#pragma unroll
    for (int i = 0; i < 4; ++i)
#pragma unroll
        for (int j = 0; j < 4; ++j) acc[i][j] = (f32x4){0.f, 0.f, 0.f, 0.f};
    const bf16* ap = A + (size_t)(tm * 64 + fr) * lda + wv * kw + 8 * g;
    const bf16* bp = Bt + (size_t)(tn * 64 + fr) * K + wv * kw + 8 * g;
    bf16x8 a0[4], b0[4];
#pragma unroll
    for (int i = 0; i < 4; ++i) { a0[i] = *(const bf16x8*)(ap + (size_t)i * 16 * lda); b0[i] = *(const bf16x8*)(bp + (size_t)i * 16 * K); }
#pragma unroll 1
    for (int st = 0; st < nst; ++st) {
        bf16x8 a1[4], b1[4]; const int sn = (st + 1 < nst) ? st + 1 : st;
#pragma unroll
        for (int i = 0; i < 4; ++i) { a1[i] = *(const bf16x8*)(ap + (size_t)i * 16 * lda + 32 * sn); b1[i] = *(const bf16x8*)(bp + (size_t)i * 16 * K + 32 * sn); }
#pragma unroll
        for (int i = 0; i < 4; ++i)
#pragma unroll
            for (int j = 0; j < 4; ++j) acc[i][j] = __builtin_amdgcn_mfma_f32_16x16x32_bf16(a0[i], b0[j], acc[i][j], 0, 0, 0);
#pragma unroll
        for (int i = 0; i < 4; ++i) { a0[i] = a1[i]; b0[i] = b1[i]; }
    }
    LAS float* rw = red + wv * 4096;
#pragma unroll
    for (int i = 0; i < 4; ++i)
#pragma unroll
        for (int j = 0; j < 4; ++j)
#pragma unroll
            for (int e = 0; e < 4; ++e) rw[(16 * i + 4 * g + e) * 64 + 16 * j + fr] = acc[i][j][e];
    __syncthreads();
    const int row = tid >> 3, c0 = (tid & 7) * 8;
    f32x4 s0 = (f32x4){0.f, 0.f, 0.f, 0.f}, s1 = s0;
#pragma unroll
    for (int w = 0; w < 8; ++w) { const LAS float* rp = red + w * 4096 + row * 64 + c0; s0 = s0 + *(const LAS f32x4*)rp; s1 = s1 + *(const LAS f32x4*)(rp + 4); }
    const size_t grow = (size_t)MP + tm * 64 + row; const int col = tn * 64 + c0;
    if (MODE == 0) {
        const float* xr = xs + (size_t)(tm * 64 + row) * 1024 + col;
        const f32x4 v0 = s0 + *(const f32x4*)xr, v1 = s1 + *(const f32x4*)(xr + 4);
        *(f32x4*)(X1F + grow * 1024 + col) = v0; *(f32x4*)(X1F + grow * 1024 + col + 4) = v1;
        v4u w; w.x = pg8::cvt_pk_bf16(v0[0], v0[1]); w.y = pg8::cvt_pk_bf16(v0[2], v0[3]); w.z = pg8::cvt_pk_bf16(v1[0], v1[1]); w.w = pg8::cvt_pk_bf16(v1[2], v1[3]);
        *(v4u*)(X1b + grow * 1024 + col) = w;
        float ss = (v0[0] * v0[0] + v0[1] * v0[1]) + (v0[2] * v0[2] + v0[3] * v0[3]) + (v1[0] * v1[0] + v1[1] * v1[1]) + (v1[2] * v1[2] + v1[3] * v1[3]);
        ss += dppf<0xB1>(ss); ss += dppf<0x4E>(ss); ss += dppf<0x141>(ss);
        if ((tid & 7) == 0) SSQ[grow * 16 + tn] = ss;
    } else {
        const float* xr = X1F + grow * 1024 + col;
        *(f32x4*)(y + grow * 1024 + col) = s0 + *(const f32x4*)xr; *(f32x4*)(y + grow * 1024 + col + 4) = s1 + *(const f32x4*)(xr + 4);
    }
    __syncthreads();
}

#ifndef PH_MASK
#define PH_MASK 0xFFFF
#endif
#ifndef NC_P1
#define NC_P1 256
#endif
#ifndef NC_P3
#define NC_P3 256
#endif
#ifndef NC_P4
#define NC_P4 256
#endif
#ifndef NC_P5
#define NC_P5 256
#endif
#ifndef REP_P5
#define REP_P5 1
#endif
#ifndef REP_P0
#define REP_P0 1
#endif
#ifndef REP_P1
#define REP_P1 1
#endif
#ifndef REP_P2
#define REP_P2 1
#endif
#ifndef REP_P3
#define REP_P3 1
#endif
#ifndef REP_P4
#define REP_P4 1
#endif
struct Args { const float* in[18]; float* out; unsigned char* ws; };
__global__ void __launch_bounds__(NWAVES * 64, 2) hymba_fwd(Args args) {
    extern __shared__ __attribute__((aligned(16))) unsigned char lds[];
    LAS unsigned char* L = (LAS unsigned char*)lds;
    volatile LAS unsigned* MISC = (volatile LAS unsigned*)(L + MISC_OFF);
    const int tid = threadIdx.x, lane = tid & 63, wave = __builtin_amdgcn_readfirstlane(tid >> 6);
    const int G = gridDim.x; const int bx = blockIdx.x; const int vcu = (G % 8 == 0) ? (bx % 8) * (G / 8) + bx / 8 : bx;
    unsigned char* ws = args.ws; float* out = args.out;
    gu32* ctl = (gu32*)(ws + WS_CTL);
    const float* x_p = args.in[0]; const float* x_s = args.in[1]; const float* cache_k = args.in[2]; const float* cache_v = args.in[3]; const float* state_conv = args.in[4];
    const float* g_attn = args.in[5]; const float* w_in = args.in[6]; const float* g_q = args.in[7]; const float* g_k = args.in[8]; const float* conv_w = args.in[9]; const float* conv_b = args.in[10];
    const float* ln_g = args.in[11]; const float* ln_b = args.in[12]; const float* w_out = args.in[13]; const float* g_ffn = args.in[14]; const float* w_gate = args.in[15]; const float* w_up = args.in[16]; const float* w_down = args.in[17];
    bf16* W1t = (bf16*)(ws + WS_W1); bf16* W2t = (bf16*)(ws + WS_W2); bf16* W3t = (bf16*)(ws + WS_W3); bf16* W4t = (bf16*)(ws + WS_W4);
    bf16* H1 = (bf16*)(ws + WS_H1); bf16* Qb = (bf16*)(ws + WS_QB); bf16* Kb = (bf16*)(ws + WS_KB); bf16* Vb = (bf16*)(ws + WS_VB);
    float* Qs = (float*)(ws + WS_QS); float* U = (float*)(ws + WS_U); bf16* MIX = (bf16*)(ws + WS_MIX); bf16* X1b = (bf16*)(ws + WS_X1B); float* SSQ = (float*)(ws + WS_SSQ);
    bf16* HID = (bf16*)(ws + WS_HID); float* PART = (float*)(ws + WS_PART); float* X1F = (float*)(ws + WS_X1F); float* NKs = (float*)(ws + WS_NKS); float* NVs = (float*)(ws + WS_NVS);

    for (int u = tid; u < (LDS_BYTES - LDSCTL_OFF) / 4; u += NWAVES * 64) ((LAS unsigned*)(L + LDSCTL_OFF))[u] = 0u;
    __syncthreads();
    XcdBarrier bar = xcd_barrier_post((unsigned*)(ctl + CW_BAR), MISC + 8);
#ifdef PROBE_A
#define STAMP(k) do { if (tid == 0) MISC[16 + (k)] = (unsigned)rt(); } while (0)
#else
#define STAMP(k) do { } while (0)
#endif
    STAMP(0);
    const int gw = vcu * NWAVES + wave, NGW = G * NWAVES;

_Pragma("unroll 1") for (int rep = 0; rep < REP_P0; ++rep)
    if (PH_MASK & 1) {
        LAS float* scr = (LAS float*)(L + RING_OFF + wave * 16384);
        constexpr int I_1 = (DM / 32) * (DIN / 64), I_2 = (DM / 32) * (DM / 64), I_3 = (DM / 32) * (DFF / 64), I_4 = (DFF / 32) * (DM / 64);
        constexpr int NITEMS = I_1 + I_2 + 2 * I_3 + I_4;
        for (int it = gw; it < NITEMS; it += NGW) {
            int r = it;
            if (r < I_1) { p0_item<1>(w_in, DM, DIN, W1t, nullptr, scr, r, lane); continue; } r -= I_1;
            if (r < I_2) { p0_item<0>(w_out, DM, DM, W2t, nullptr, scr, r, lane); continue; } r -= I_2;
            if (r < I_3) { p0_item<2>(w_gate, DM, DFF, W3t, g_ffn, scr, r, lane); continue; } r -= I_3;
            if (r < I_3) { p0_item<3>(w_up, DM, DFF, W3t, g_ffn, scr, r, lane); continue; } r -= I_3;
            p0_item<0>(w_down, DFF, DM, W4t, nullptr, scr, r, lane);
        }
        f32x4 gv[4];
#pragma unroll
        for (int j = 0; j < 4; ++j) gv[j] = *((const f32x4*)g_attn + lane + 64 * j);
        for (int m = gw; m < M; m += 2 * NGW) { const int m2 = m + NGW;
            rms_row2_to_bf16(m < MP ? x_p + (size_t)m * DM : x_s + (size_t)(m - MP) * DM, m2 < M ? (m2 < MP ? x_p + (size_t)m2 * DM : x_s + (size_t)(m2 - MP) * DM) : nullptr, gv, H1 + (size_t)m * DM, H1 + (size_t)(m2 < M ? m2 : m) * DM, lane); }
    }
    xcd_barrier(bar);
    if (tid == 0) MISC[12] = 0u;
    STAMP(1);

_Pragma("unroll 1") for (int rep = 0; rep < REP_P1; ++rep)
    if (bx < (G == 256 ? NC_P1 : G)) {
        const int nc = (G == 256 ? NC_P1 : G);
        pg8::Gemm g{H1, W1t, M, DIN, DM}; pg8::StaticOrder S; S.init(M, DIN, nc, bx);
        pg8::EpiIn E{Qb, Kb, Vb, Qs, U, out, g_q, g_k, NKs, NVs};
        pg8::gemm_phase<pg8::EpiIn, pg8::StaticOrder, true, true>(L + RING_OFF, g, S, E);
    }
    xcd_barrier(bar);
    if (tid == 0) MISC[12] = 0u;
    STAMP(2);

    {
        LAS unsigned char* vst = L + RING_OFF + wave * 16384;
        if (G == 256) { stream_fused(cache_k, cache_v, NKs, NVs, out, Qb, PART, L + RING_OFF, vcu >> 1, vcu & 1, tid);
            if ((vcu & 1) == 0 && wave == 0) conv_task(U, state_conv, conv_w, conv_b, ln_g, ln_b, MIX, out, (LAS float*)vst, 2048 + (vcu >> 1), lane); }
    }
    STAMP(9);
    xcd_barrier(bar);
    if (tid == 0) MISC[12] = 0u;
    STAMP(3);
    {
        LAS unsigned char* vst = L + RING_OFF + wave * 16384;
        for (int it = gw; it < N_ATT; it += NGW) attn_tile(Qb, Kb, Vb, MIX, vst, it >> 10, (it >> 7) & 7, ((it >> 4) + 2 * (it >> 11)) & 7, it & 15, lane);
        STAMP(10);
        for (int it = gw; it < 2048; it += NGW) conv_task(U, state_conv, conv_w, conv_b, ln_g, ln_b, MIX, out, (LAS float*)vst, it, lane);
        for (int it = gw; it < 2 * MS; it += NGW) combine_task(PART, MIX, it >> 4, (it >> 1) & 7, it & 1, lane);
    }
    STAMP(11);
    xcd_barrier(bar);
    if (tid == 0) MISC[12] = 0u;
    STAMP(4);

_Pragma("unroll 1") for (int rep = 0; rep < REP_P3; ++rep)
    if (bx < (G == 256 ? NC_P3 : G)) {
        const int nc = (G == 256 ? NC_P3 : G);
        pg8::Gemm g{MIX, W2t, MP, DM, DM}; pg8::StaticOrder S; S.init(MP, DM, nc, bx);
        pg8::EpiOut E{x_p, x_s, X1F, X1b, SSQ};
        pg8::gemm_phase<pg8::EpiOut, pg8::StaticOrder, true, true>(L + RING_OFF, g, S, E);
    }
    if (G == 256) small_gemm<0>(MIX + (size_t)MP * DM, DM, W2t, DM, vcu, (LAS float*)(L + RING_OFF), x_s, X1F, X1b, SSQ, out, tid);
    xcd_barrier(bar);
    if (tid == 0) MISC[12] = 0u;
    STAMP(5);
_Pragma("unroll 1") for (int rep = 0; rep < REP_P4; ++rep)
    if (bx < (G == 256 ? NC_P4 : G)) {
        const int nc = (G == 256 ? NC_P4 : G);
        pg8::Gemm g{X1b, W3t, M, 2 * DFF, DM}; pg8::StaticOrder S; S.init(M, 2 * DFF, nc, bx);
        pg8::EpiGateUp E{SSQ, HID, (LAS float*)(L + RSTAB_OFF)};
        pg8::gemm_phase<pg8::EpiGateUp, pg8::StaticOrder, true, true>(L + RING_OFF, g, S, E);
    }
    xcd_barrier(bar);
    if (tid == 0) MISC[12] = 0u;
    STAMP(6);
_Pragma("unroll 1") for (int rep = 0; rep < REP_P5; ++rep)
    if (bx < (G == 256 ? NC_P5 : G)) {
        const int nc = (G == 256 ? NC_P5 : G);
        pg8::Gemm g{HID, W4t, MP, DM, DFF}; pg8::StaticOrder S; S.init(MP, DM, nc, bx);
        pg8::EpiDown E{X1F, out};
        pg8::gemm_phase<pg8::EpiDown, pg8::StaticOrder, true, true>(L + RING_OFF, g, S, E);
    }
    if (G == 256) small_gemm<1>(HID + (size_t)MP * DFF, DFF, W4t, DFF, vcu, (LAS float*)(L + RING_OFF), x_s, X1F, X1b, SSQ, out, tid);
    STAMP(7);
#ifdef PROBE_A
    __syncthreads(); STAMP(8);
    if (bx == 0 && tid == 0) {
        const unsigned ta = MISC[16 + PROBE_A1] - MISC[16 + PROBE_A], tb = MISC[16 + PROBE_B1] - MISC[16 + PROBE_B];
        #ifdef PROBE_MUL
        const unsigned long long delay = (unsigned long long)PROBE_MUL * ta + 0ull * tb;
#else
        const unsigned long long delay = (unsigned long long)ta + 102400ull * ((tb + 200u) / 400u);
#endif
        const unsigned long long t_end = rt(); while (rt() - t_end < delay) __builtin_amdgcn_s_sleep(8);
    }
#endif
}

extern "C" void kernel_launch(void* const* d_in, const int* in_sizes, int n_in, void* d_out, int out_size, void* d_ws, size_t ws_size, hipStream_t stream) {
    static int grid = 0;
    if (grid == 0) {
        if (n_in != 18 || (size_t)out_size != O_END || ws_size < WS_END) { fprintf(stderr, "kernel_launch: unexpected shapes (n_in %d, out %d, ws %zu); nothing launched\n", n_in, out_size, ws_size); grid = -1; return; }
        int dev = 0, cus = 0, per_cu = 0;
        if (hipGetDevice(&dev) != hipSuccess || hipDeviceGetAttribute(&cus, hipDeviceAttributeMultiprocessorCount, dev) != hipSuccess) { grid = -1; return; }
        if (hipFuncSetAttribute((const void*)hymba_fwd, hipFuncAttributeMaxDynamicSharedMemorySize, LDS_BYTES) != hipSuccess) { fprintf(stderr, "kernel_launch: hipFuncSetAttribute failed\n"); grid = -1; return; }
        if (hipOccupancyMaxActiveBlocksPerMultiprocessor(&per_cu, (const void*)hymba_fwd, NWAVES * 64, LDS_BYTES) != hipSuccess || per_cu < 1)
            fprintf(stderr, "kernel_launch: note: occupancy query reports %d workgroups per CU\n", per_cu);
        (void)hipGetLastError();
        grid = cus;
    }
    if (grid < 0) return;
    if (hipMemsetAsync((char*)d_ws + WS_CTL, 0, CTL_ZERO_BYTES, stream) != hipSuccess) return;
    Args a{};
    for (int i = 0; i < 18; ++i) a.in[i] = (const float*)d_in[i];
    a.out = (float*)d_out; a.ws = (unsigned char*)d_ws;
    hipLaunchKernelGGL(hymba_fwd, dim3(grid), dim3(NWAVES * 64), LDS_BYTES, stream, a);
}
```

```cpp
#include <hip/hip_runtime.h>
#include <cstdio>
#include <cstdint>
#include <cmath>
namespace pg8 {
#define PG8_LAS __attribute__((address_space(3)))
typedef unsigned short bf16_t;
typedef short bf16x8 __attribute__((ext_vector_type(8)));
typedef float f32x4 __attribute__((ext_vector_type(4)));
typedef unsigned u32x4 __attribute__((ext_vector_type(4)));
constexpr int BM = 256, BK = 64, HALF = 128, HTB = HALF * BK * 2  , STAGE_BYTES = 8 * HTB, NXCD = 8, WGM = 8;

__host__ __device__ __forceinline__ int lds_byte(int r, int c) { const int st = (r >> 4) * 2 + (c >> 5), rr = r & 15, cc = c & 31, ob = rr * 64 + cc * 2; return st * 1024 + (ob ^ (((ob >> 9) & 1) << 5)); }
__host__ __device__ __forceinline__ void stage_rc(int b, int& R, int& C) { const int st = b / 1024, sb = b % 1024, swz = sb ^ (((sb >> 9) & 1) << 5); R = (st >> 1) * 16 + swz / 64; C = (st & 1) * 32 + (swz % 64) / 2; }
__host__ __device__ __forceinline__ int perm32(int rho) { const int n = rho >> 4, i = rho & 15; return 8 * (i >> 2) + 4 * n + (i & 3); }

struct Unit { int pm, pn; };
struct Gemm { const bf16_t* A; const bf16_t* Bt; int M, N, K; };

struct StaticOrder {
    int nM, nN, nwg, G, c;
    __host__ __device__ void init(int M, int N, int G_, int c_) { nM = M / BM; nN = N / BM; nwg = nM * nN; G = G_; c = c_; }
    __host__ __device__ bool next(int i, Unit& u) const {
        const long L = (long)i * G + c; if (L >= nwg) return false;
        int wgid = (int)L; { const int q = nwg / NXCD, r = nwg % NXCD, xcd = wgid % NXCD, off = wgid / NXCD; wgid = (xcd < r ? xcd * (q + 1) : r * (q + 1) + (xcd - r) * q) + off; }
        const int nig = WGM * nN, gid = wgid / nig, fm = gid * WGM, gsz = (nM - fm) < WGM ? (nM - fm) : WGM;
        u.pm = fm + ((wgid % nig) % gsz); u.pn = (wgid % nig) / gsz; return true;
    }
    __device__ __forceinline__ void a_ready(const Unit&) const {}
    __device__ __forceinline__ void done(const Unit&) const {}
};

__device__ __forceinline__ unsigned cvt_pk_bf16(float lo, float hi) { unsigned r; asm volatile("v_cvt_pk_bf16_f32 %0, %1, %2" : "=v"(r) : "v"(lo), "v"(hi)); return r; }
constexpr int E_MP = 16384;
constexpr size_t EO_KP = 17825792, EO_VP = 26214400, EO_KS = 34725888, EO_VS = 168943616;
constexpr float E_C2 = 0.125f * 1.4426950408889634f;
__device__ __forceinline__ float xrow16_sum(float x) {
    auto s = __builtin_amdgcn_permlane16_swap(__float_as_uint(x), __float_as_uint(x), false, false);
    x = __uint_as_float(s[0]) + __uint_as_float(s[1]);
    auto t = __builtin_amdgcn_permlane32_swap(__float_as_uint(x), __float_as_uint(x), false, false);
    return __uint_as_float(t[0]) + __uint_as_float(t[1]);
}
__device__ __forceinline__ float xrow16_max(float x) {
    auto s = __builtin_amdgcn_permlane16_swap(__float_as_uint(x), __float_as_uint(x), false, false);
    x = fmaxf(__uint_as_float(s[0]), __uint_as_float(s[1]));
    auto t = __builtin_amdgcn_permlane32_swap(__float_as_uint(x), __float_as_uint(x), false, false);
    return fmaxf(__uint_as_float(t[0]), __uint_as_float(t[1]));
}
__device__ __forceinline__ float sigmoidf_fast(float g) { return __builtin_amdgcn_rcpf(1.f + __builtin_amdgcn_exp2f(-1.4426950408889634f * g)); }

struct EpiIn {
    static constexpr bool PERM = true, AFTER_DRAIN = false;
    bf16_t *Qb, *Kb, *Vb; float *U, *out; const float *gq, *gk; float *NKs, *NVs;
    __device__ __forceinline__ void init(f32x4 (&acc)[2][2][4][2], const Unit&, int, int, int, int) const {
#pragma unroll
        for (int a = 0; a < 2; ++a)
#pragma unroll
            for (int b = 0; b < 2; ++b)
#pragma unroll
                for (int m = 0; m < 4; ++m)
#pragma unroll
                    for (int n = 0; n < 2; ++n) acc[a][b][m][n] = (f32x4){0.f, 0.f, 0.f, 0.f};
    }
    template <int SEC, bool SAMP> __device__ __forceinline__ void qkv(const f32x4 (&acc)[2][2][4][2], const Unit& u, int wr, int wc, int fr, int fq) const {
        const int row0 = u.pm * BM + wr * 64 + fr;
        const int head = (u.pn & 1) * 4 + wc, cb = head * 64 + 8 * fq;
        f32x4 gv[2][2];
#pragma unroll
        for (int bj = 0; bj < 2; ++bj)
#pragma unroll
            for (int n = 0; n < 2; ++n) { gv[bj][n] = (f32x4){1.f, 1.f, 1.f, 1.f};
                if (SEC == 0) gv[bj][n] = *(const f32x4*)(gq + 32 * bj + 8 * fq + 4 * n) * E_C2;
                if (SEC == 1) gv[bj][n] = *(const f32x4*)(gk + 32 * bj + 8 * fq + 4 * n); }
#pragma unroll
        for (int ai = 0; ai < 2; ++ai)
#pragma unroll
            for (int m = 0; m < 4; ++m) { const int row = row0 + ai * HALF + m * 16;
                f32x4 v[2][2];
#pragma unroll
                for (int bj = 0; bj < 2; ++bj)
#pragma unroll
                    for (int n = 0; n < 2; ++n) v[bj][n] = acc[ai][bj][m][n];
                if (SEC < 2) { float ss = 0.f;
#pragma unroll
                    for (int bj = 0; bj < 2; ++bj)
#pragma unroll
                        for (int n = 0; n < 2; ++n) ss += (v[bj][n][0] * v[bj][n][0] + v[bj][n][1] * v[bj][n][1]) + (v[bj][n][2] * v[bj][n][2] + v[bj][n][3] * v[bj][n][3]);
                    ss = xrow16_sum(ss);
                    const float rinv = 1.0f / sqrtf(ss * (1.f / 64.f) + 1e-6f);
#pragma unroll
                    for (int bj = 0; bj < 2; ++bj)
#pragma unroll
                        for (int n = 0; n < 2; ++n) v[bj][n] = v[bj][n] * rinv * gv[bj][n]; }
                bf16_t* dstb = (SEC == 0 ? Qb : (SEC == 1 ? Kb : Vb)) + (size_t)row * 512 + cb;
#pragma unroll
                for (int bj = 0; bj < 2; ++bj) { u32x4 w; w.x = cvt_pk_bf16(v[bj][0][0], v[bj][0][1]); w.y = cvt_pk_bf16(v[bj][0][2], v[bj][0][3]); w.z = cvt_pk_bf16(v[bj][1][0], v[bj][1][1]); w.w = cvt_pk_bf16(v[bj][1][2], v[bj][1][3]);
                    *(u32x4*)(dstb + 32 * bj) = w; }
                if (SEC == 0) { asm volatile("" ::: "memory"); continue; }
                float* o;
                if (!SAMP) o = out + (SEC == 1 ? EO_KP : EO_VP) + (size_t)row * 512 + cb;
                else { const int ms = row - E_MP; o = out + (SEC == 1 ? EO_KS : EO_VS) + ((size_t)(ms >> 3) * 2048 + 2040 + (ms & 7)) * 512 + cb; }
#pragma unroll
                for (int bj = 0; bj < 2; ++bj)
#pragma unroll
                    for (int n = 0; n < 2; ++n) *(f32x4*)(o + 32 * bj + 4 * n) = v[bj][n];
                if (SEC != 0 && SAMP) { float* o2 = (SEC == 1 ? NKs : NVs) + (size_t)(row - E_MP) * 512 + cb;
#pragma unroll
                    for (int bj = 0; bj < 2; ++bj)
#pragma unroll
                        for (int n = 0; n < 2; ++n) *(f32x4*)(o2 + 32 * bj + 4 * n) = v[bj][n]; }
                asm volatile("" ::: "memory");
            }
    }
    __device__ __forceinline__ void operator()(const f32x4 (&acc)[2][2][4][2], const Unit& u, int wr, int wc, int fr, int fq) const {
        const bool samp = u.pm >= E_MP / BM; const int sec = u.pn >> 1;
        if (u.pn < 6) {
            if (sec == 0) { if (samp) qkv<0, true>(acc, u, wr, wc, fr, fq); else qkv<0, false>(acc, u, wr, wc, fr, fq); }
            else if (sec == 1) { if (samp) qkv<1, true>(acc, u, wr, wc, fr, fq); else qkv<1, false>(acc, u, wr, wc, fr, fq); }
            else { if (samp) qkv<2, true>(acc, u, wr, wc, fr, fq); else qkv<2, false>(acc, u, wr, wc, fr, fq); }
        } else {
            const int row0 = u.pm * BM + wr * 64 + fr, cb = 128 * (u.pn - 6) + 32 * wc + 8 * fq;
#pragma unroll
            for (int ai = 0; ai < 2; ++ai)
#pragma unroll
                for (int m = 0; m < 4; ++m) { float* o = U + (size_t)(row0 + ai * HALF + m * 16) * 512 + cb;
#pragma unroll
                    for (int n = 0; n < 2; ++n) { const f32x4 a = acc[ai][0][m][n], g = acc[ai][1][m][n]; f32x4 r;
#pragma unroll
                        for (int e = 0; e < 4; ++e) r[e] = a[e] * sigmoidf_fast(g[e]);
                        *(f32x4*)(o + 4 * n) = r; } }
        }
    }
};

struct EpiOut {
    static constexpr bool PERM = true, AFTER_DRAIN = false;
    const float *xp, *xs; bf16_t* X1b; float* ssq;
    __device__ __forceinline__ void init(f32x4 (&acc)[2][2][4][2], const Unit& u, int wr, int wc, int fr, int fq) const {
        const int row0 = u.pm * BM + wr * 64 + fr, col = u.pn * BM + 32 * wc + 8 * fq; const bool samp = u.pm >= E_MP / BM;
#pragma unroll
        for (int ai = 0; ai < 2; ++ai)
#pragma unroll
            for (int m = 0; m < 4; ++m) { const int row = row0 + ai * HALF + m * 16;
                const float* xr = (samp ? xs + (size_t)(row - E_MP) * 1024 : xp + (size_t)row * 1024) + col;
#pragma unroll
                for (int bj = 0; bj < 2; ++bj)
#pragma unroll
                    for (int n = 0; n < 2; ++n) acc[ai][bj][m][n] = *(const f32x4*)(xr + bj * HALF + 4 * n); }
    }
    __device__ __forceinline__ void operator()(const f32x4 (&acc)[2][2][4][2], const Unit& u, int wr, int wc, int fr, int fq) const {
        const int row0 = u.pm * BM + wr * 64 + fr, col = u.pn * BM + 32 * wc + 8 * fq;
#pragma unroll
        for (int ai = 0; ai < 2; ++ai)
#pragma unroll
            for (int m = 0; m < 4; ++m) { const int row = row0 + ai * HALF + m * 16;
                bf16_t* br = X1b + (size_t)row * 1024 + col; float ss = 0.f;
#pragma unroll
                for (int bj = 0; bj < 2; ++bj) { const f32x4 v0 = acc[ai][bj][m][0], v1 = acc[ai][bj][m][1];
                    u32x4 w; w.x = cvt_pk_bf16(v0[0], v0[1]); w.y = cvt_pk_bf16(v0[2], v0[3]); w.z = cvt_pk_bf16(v1[0], v1[1]); w.w = cvt_pk_bf16(v1[2], v1[3]);
                    *(u32x4*)(br + bj * HALF) = w;
                    ss += (v0[0] * v0[0] + v0[1] * v0[1]) + (v0[2] * v0[2] + v0[3] * v0[3]) + (v1[0] * v1[0] + v1[1] * v1[1]) + (v1[2] * v1[2] + v1[3] * v1[3]); }
                ss = xrow16_sum(ss);
                if (fq == 0) ssq[(size_t)row * 16 + u.pn * 4 + wc] = ss; }
    }
};

struct EpiGateUp {
    static constexpr bool PERM = true, AFTER_DRAIN = false;
    const float* ssq; bf16_t* HID; PG8_LAS float* rstab; int row_off;
    __device__ __forceinline__ void init(f32x4 (&acc)[2][2][4][2], const Unit&, int, int, int, int) const {
#pragma unroll
        for (int a = 0; a < 2; ++a)
#pragma unroll
            for (int b = 0; b < 2; ++b)
#pragma unroll
                for (int m = 0; m < 4; ++m)
#pragma unroll
                    for (int n = 0; n < 2; ++n) acc[a][b][m][n] = (f32x4){0.f, 0.f, 0.f, 0.f};
    }
    __device__ __forceinline__ void operator()(const f32x4 (&acc)[2][2][4][2], const Unit& u, int wr, int wc, int fr, int fq) const {
        const int row0 = row_off + u.pm * BM + wr * 64 + fr, col = u.pn * HALF + 32 * wc + 8 * fq, lane = fr + 16 * fq;
        PG8_LAS float* tab = rstab + (wr * 4 + wc) * 128;
#pragma unroll
        for (int k = 0; k < 2; ++k) { const int j = lane + 64 * k, row = row_off + u.pm * BM + (j >> 6) * HALF + wr * 64 + ((j >> 4) & 3) * 16 + (j & 15);
            const f32x4* sp = (const f32x4*)(ssq + (size_t)row * 16); const f32x4 s0 = sp[0], s1 = sp[1], s2 = sp[2], s3 = sp[3];
            const float tot = ((s0[0] + s0[1]) + (s0[2] + s0[3])) + ((s1[0] + s1[1]) + (s1[2] + s1[3])) + ((s2[0] + s2[1]) + (s2[2] + s2[3])) + ((s3[0] + s3[1]) + (s3[2] + s3[3]));
            tab[j] = 1.0f / sqrtf(tot * (1.f / 1024.f) + 1e-6f); }
        asm volatile("s_waitcnt lgkmcnt(0)" ::: "memory");
#pragma unroll
        for (int ai = 0; ai < 2; ++ai)
#pragma unroll
            for (int m = 0; m < 4; ++m) { const int row = row0 + ai * HALF + m * 16;
                const float rs = tab[(ai * 4 + m) * 16 + fr];
                float h[8];
#pragma unroll
                for (int n = 0; n < 2; ++n)
#pragma unroll
                    for (int e = 0; e < 4; ++e) { const float g = acc[ai][0][m][n][e] * rs, up = acc[ai][1][m][n][e] * rs; h[4 * n + e] = g * sigmoidf_fast(g) * up; }
                u32x4 w; w.x = cvt_pk_bf16(h[0], h[1]); w.y = cvt_pk_bf16(h[2], h[3]); w.z = cvt_pk_bf16(h[4], h[5]); w.w = cvt_pk_bf16(h[6], h[7]);
                *(u32x4*)(HID + (size_t)row * 2816 + col) = w; }
        asm volatile("s_waitcnt lgkmcnt(0)" ::: "memory");
    }
};

struct EpiDown {
    static constexpr bool PERM = true, AFTER_DRAIN = false;
    const bf16_t* x1; float* y;
    __device__ __forceinline__ void init(f32x4 (&acc)[2][2][4][2], const Unit& u, int wr, int wc, int fr, int fq) const {
        const int row0 = u.pm * BM + wr * 64 + fr, col = u.pn * BM + 32 * wc + 8 * fq;
#pragma unroll
        for (int ai = 0; ai < 2; ++ai)
#pragma unroll
            for (int m = 0; m < 4; ++m) { const bf16_t* xr = x1 + (size_t)(row0 + ai * HALF + m * 16) * 1024 + col;
#pragma unroll
                for (int bj = 0; bj < 2; ++bj) { const u32x4 w = *(const u32x4*)(xr + bj * HALF);
                    acc[ai][bj][m][0] = (f32x4){__uint_as_float(w.x << 16), __uint_as_float(w.x & 0xffff0000u), __uint_as_float(w.y << 16), __uint_as_float(w.y & 0xffff0000u)};
                    acc[ai][bj][m][1] = (f32x4){__uint_as_float(w.z << 16), __uint_as_float(w.z & 0xffff0000u), __uint_as_float(w.w << 16), __uint_as_float(w.w & 0xffff0000u)}; } }
    }
    __device__ __forceinline__ void operator()(const f32x4 (&acc)[2][2][4][2], const Unit& u, int wr, int wc, int fr, int fq) const {
        const int row0 = u.pm * BM + wr * 64 + fr, col = u.pn * BM + 32 * wc + 8 * fq;
#pragma unroll
        for (int ai = 0; ai < 2; ++ai)
#pragma unroll
            for (int m = 0; m < 4; ++m) { float* yr = y + (size_t)(row0 + ai * HALF + m * 16) * 1024 + col;
#pragma unroll
                for (int bj = 0; bj < 2; ++bj)
#pragma unroll
                    for (int n = 0; n < 2; ++n) *(f32x4*)(yr + bj * HALF + 4 * n) = acc[ai][bj][m][n]; }
    }
};

template <class Epi, class Sched, bool ALIGN_EPI = false, bool SP2 = false>
__device__ __forceinline__ void gemm_phase(PG8_LAS unsigned char* lds, const Gemm g, const Sched& S, const Epi& E) {
    int tid_ = threadIdx.x; asm volatile("" : "+v"(tid_));
    const int tid = tid_, wid = __builtin_amdgcn_readfirstlane(tid >> 6), lane = tid & 63, wr = wid >> 2, wc = wid & 3, fr = lane & 15, fq = lane >> 4;
    const int K = g.K, nt = K / BK;
    unsigned voffA[2], voffB[2];
#pragma unroll
    for (int i = 0; i < 2; ++i) { int R, C; stage_rc(tid * 16 + i * 8192, R, C); const int Rb = Epi::PERM ? ((R & ~31) + perm32(R & 31)) : R;
        voffA[i] = (unsigned)(R * K + C) * 2u; voffB[i] = (unsigned)(Rb * K + C) * 2u; }
    const size_t kstep = (size_t)(BK * 2);
    const size_t hstep = (size_t)HALF * K * 2;
    const size_t tstep = 2 * hstep;
    const unsigned ldsw = (unsigned)wid * 1024u;
    const int aoff = lds_byte(wr * 64 + fr, fq * 8), boff = lds_byte(wc * 32 + fr, fq * 8);
#define PG8_SA(b, h) (((b) * 2 + (h)) * HTB)
#define PG8_SB(b, h) ((4 + (b) * 2 + (h)) * HTB)
#define PG8_STAGE(bufoff, gbase, voff) do { _Pragma("unroll") for (int _i = 0; _i < 2; ++_i) \
        __builtin_amdgcn_global_load_lds((const unsigned*)((const char*)(gbase) + (voff)[_i]), (PG8_LAS unsigned*)(lds + (bufoff) + ldsw + _i * 8192), 16, 0, 0); } while (0)
#define PG8_LDA(dst, b, h) do { _Pragma("unroll") for (int m = 0; m < 4; ++m) _Pragma("unroll") for (int k = 0; k < 2; ++k) dst[m][k] = *(const PG8_LAS bf16x8*)(lds + PG8_SA(b, h) + aoff + m * 2048 + k * 1024); } while (0)
#define PG8_LDB(dst, b, h) do { _Pragma("unroll") for (int n = 0; n < 2; ++n) _Pragma("unroll") for (int k = 0; k < 2; ++k) dst[n][k] = *(const PG8_LAS bf16x8*)(lds + PG8_SB(b, h) + boff + n * 2048 + k * 1024); } while (0)
#define PG8_MMA(ai, bj, At, Bt) do { __builtin_amdgcn_s_setprio(1); _Pragma("unroll") for (int m = 0; m < 4; ++m) _Pragma("unroll") for (int n = 0; n < 2; ++n) _Pragma("unroll") for (int k = 0; k < 2; ++k) \
        acc[ai][bj][m][n] = __builtin_amdgcn_mfma_f32_16x16x32_bf16(Bt[n][k], At[m][k], acc[ai][bj][m][n], 0, 0, 0); __builtin_amdgcn_s_setprio(0); } while (0)
#define PG8_WAIT_V(n) asm volatile("s_waitcnt vmcnt(" #n ")" ::: "memory")
#define PG8_WAIT_L(n) asm volatile("s_waitcnt lgkmcnt(" #n ")" ::: "memory")
#define PG8_BAR __builtin_amdgcn_s_barrier()
#define PG8_SCHED __builtin_amdgcn_sched_barrier(0)
    Unit cur, nxt; int ui = 0;
    if (!S.next(0, cur)) return;
    f32x4 acc[2][2][4][2];
    E.init(acc, cur, wr, wc, fr, fq);
    bf16x8 At[4][2], B0[2][2], B1[2][2];
    const char* cA = (const char*)g.A + (size_t)cur.pm * tstep; const char* cB = (const char*)g.Bt + (size_t)cur.pn * tstep;
    S.a_ready(cur);
    if constexpr (SP2) {
        PG8_STAGE(PG8_SB(0, 0), cB, voffB); PG8_STAGE(PG8_SB(0, 1), cB + hstep, voffB); PG8_STAGE(PG8_SA(0, 0), cA, voffA); PG8_STAGE(PG8_SA(0, 1), cA + hstep, voffA);
        if (wr == 1) PG8_BAR;
        PG8_WAIT_V(2); PG8_BAR;
        PG8_STAGE(PG8_SB(1, 0), cB + kstep, voffB); PG8_STAGE(PG8_SA(1, 0), cA + kstep, voffA); PG8_STAGE(PG8_SB(1, 1), cB + hstep + kstep, voffB);
        PG8_WAIT_V(6); PG8_BAR;
    } else {
        PG8_STAGE(PG8_SB(0, 0), cB, voffB); PG8_STAGE(PG8_SA(0, 0), cA, voffA); PG8_STAGE(PG8_SB(0, 1), cB + hstep, voffB); PG8_STAGE(PG8_SA(0, 1), cA + hstep, voffA);
        if (wr == 1) PG8_BAR;
        PG8_WAIT_V(4); PG8_BAR;
        PG8_STAGE(PG8_SB(1, 0), cB + kstep, voffB); PG8_STAGE(PG8_SA(1, 0), cA + kstep, voffA); PG8_STAGE(PG8_SB(1, 1), cB + hstep + kstep, voffB);
        PG8_WAIT_V(6); PG8_BAR;
    }
    for (;;) {
        const bool has_next = S.next(ui + 1, nxt);
        const char* nA = has_next ? (const char*)g.A + (size_t)nxt.pm * tstep : cA; const char* nB = has_next ? (const char*)g.Bt + (size_t)nxt.pn * tstep : cB;
        for (int t = 0; t < nt; t += 2) {
            const bool last = (t == nt - 2);
            const char* a1 = cA + (size_t)(t + 1) * kstep;
            const char* a2 = last ? nA : cA + (size_t)(t + 2) * kstep; const char* b2 = last ? nB : cB + (size_t)(t + 2) * kstep;
            const char* a3 = a2 + kstep; const char* b3 = b2 + kstep;
            if (last && has_next) S.a_ready(nxt);
            if constexpr (SP2) {
            PG8_LDB(B0, 0, 0); PG8_LDB(B1, 0, 1); PG8_SCHED; PG8_LDA(At, 0, 0); PG8_STAGE(PG8_SA(1, 1), a1 + hstep, voffA);
            PG8_WAIT_V(8); PG8_WAIT_L(0); PG8_BAR; PG8_MMA(0, 0, At, B0); PG8_MMA(0, 1, At, B1); PG8_BAR; PG8_SCHED;
            PG8_LDA(At, 0, 1); PG8_STAGE(PG8_SB(0, 0), b2, voffB); PG8_STAGE(PG8_SB(0, 1), b2 + hstep, voffB); PG8_STAGE(PG8_SA(0, 0), a2, voffA);
            PG8_WAIT_V(8); PG8_WAIT_L(0); PG8_BAR; PG8_MMA(1, 0, At, B0); PG8_MMA(1, 1, At, B1); PG8_BAR; PG8_SCHED;
            PG8_LDB(B0, 1, 0); PG8_LDB(B1, 1, 1); PG8_SCHED; PG8_LDA(At, 1, 0); PG8_STAGE(PG8_SA(0, 1), a2 + hstep, voffA);
            PG8_WAIT_V(8); PG8_WAIT_L(0); PG8_BAR; PG8_MMA(0, 0, At, B0); PG8_MMA(0, 1, At, B1); PG8_BAR; PG8_SCHED;
            PG8_LDA(At, 1, 1); PG8_STAGE(PG8_SB(1, 0), b3, voffB); PG8_STAGE(PG8_SB(1, 1), b3 + hstep, voffB); PG8_STAGE(PG8_SA(1, 0), a3, voffA);
            PG8_WAIT_V(8); PG8_WAIT_L(0); PG8_BAR; PG8_MMA(1, 0, At, B0); PG8_MMA(1, 1, At, B1); PG8_BAR; PG8_SCHED;
            } else {
            PG8_LDB(B0, 0, 0); PG8_SCHED; PG8_LDA(At, 0, 0); PG8_STAGE(PG8_SA(1, 1), a1 + hstep, voffA);
            PG8_WAIT_L(8); PG8_BAR; PG8_WAIT_L(0); PG8_MMA(0, 0, At, B0); PG8_BAR; PG8_SCHED;
            PG8_LDB(B1, 0, 1); PG8_STAGE(PG8_SB(0, 0), b2, voffB);
            PG8_BAR; PG8_WAIT_L(0); PG8_MMA(0, 1, At, B1); PG8_BAR;
            PG8_LDA(At, 0, 1); PG8_STAGE(PG8_SA(0, 0), a2, voffA);
            PG8_BAR; PG8_WAIT_L(0); PG8_MMA(1, 0, At, B0); PG8_BAR; PG8_SCHED;
            PG8_STAGE(PG8_SB(0, 1), b2 + hstep, voffB);
            PG8_WAIT_V(6); PG8_BAR; PG8_MMA(1, 1, At, B1); PG8_BAR;
            PG8_LDB(B0, 1, 0); PG8_SCHED; PG8_LDA(At, 1, 0); PG8_STAGE(PG8_SA(0, 1), a2 + hstep, voffA);
            PG8_WAIT_L(8); PG8_BAR; PG8_WAIT_L(0); PG8_MMA(0, 0, At, B0); PG8_BAR; PG8_SCHED;
            PG8_LDB(B1, 1, 1); PG8_STAGE(PG8_SB(1, 0), b3, voffB);
            PG8_BAR; PG8_WAIT_L(0); PG8_MMA(0, 1, At, B1); PG8_BAR;
            PG8_LDA(At, 1, 1); PG8_STAGE(PG8_SA(1, 0), a3, voffA);
            PG8_BAR; PG8_WAIT_L(0); PG8_MMA(1, 0, At, B0); PG8_BAR; PG8_SCHED;
            PG8_STAGE(PG8_SB(1, 1), b3 + hstep, voffB);
            PG8_WAIT_V(6); PG8_BAR; PG8_MMA(1, 1, At, B1); PG8_BAR;
            }
        }
        if constexpr (ALIGN_EPI) { if (wr == 0) PG8_BAR; }
        if constexpr (!Epi::AFTER_DRAIN) { E(acc, cur, wr, wc, fr, fq); S.done(cur); }
        if (!has_next) break;
        E.init(acc, nxt, wr, wc, fr, fq);
        cur = nxt; cA = nA; cB = nB; ++ui;
        if constexpr (ALIGN_EPI) { if (wr == 1) PG8_BAR; }
    }
    PG8_WAIT_V(0);
    if constexpr (!ALIGN_EPI) { if (wr == 0) PG8_BAR; }
    PG8_BAR;
    if constexpr (Epi::AFTER_DRAIN) { E.fused(acc, cur, wr, wc, fr, fq, lds, wid, lane); S.done(cur); }
#undef PG8_SA
#undef PG8_SB
#undef PG8_STAGE
#undef PG8_LDA
#undef PG8_LDB
#undef PG8_MMA
#undef PG8_WAIT_V
#undef PG8_WAIT_L
#undef PG8_BAR
#undef PG8_SCHED
}
}

constexpr int NWAVES = 8;
constexpr int DM = 1024, NB = 8, SEQ = 2048, MP = NB * SEQ, NSMP = 128, TS = 8, MS = NSMP * TS, M = MP + MS;
constexpr int NH = 8, HD = 64, DA = 512, DC = 512, DIN = 2560, DFF = 2816, CW = 31, LBUF = 2048;
constexpr int NCH = 2;
constexpr int N_ATT = NB * NH * 8 * 16;
constexpr size_t O_YP = 0, O_KP = 17825792, O_VP = 26214400, O_CP = 34603008, O_KS = 34725888, O_VS = 168943616, O_CS = 303161344, O_END = 305127424;
static_assert(O_KP == pg8::EO_KP && O_VP == pg8::EO_VP && O_KS == pg8::EO_KS && O_VS == pg8::EO_VS, "output map");
constexpr size_t MiB = 1u << 20;
constexpr size_t WS_CTL = 0, CTL_ZERO_BYTES = 1 * MiB;
constexpr size_t WS_W1 = 2 * MiB, WS_W2 = 8 * MiB, WS_W3 = 10 * MiB, WS_W4 = 22 * MiB;
constexpr size_t WS_H1 = 32 * MiB;
constexpr size_t WS_QB = 66 * MiB, WS_KB = 84 * MiB, WS_VB = 102 * MiB;
constexpr size_t WS_U = 122 * MiB;
constexpr size_t WS_MIX = 156 * MiB;
constexpr size_t WS_X1B = 190 * MiB;
constexpr size_t WS_SSQ = 224 * MiB;
constexpr size_t WS_HID = 226 * MiB;
constexpr size_t WS_PART = 320 * MiB;
constexpr size_t WS_NKS = 432 * MiB, WS_NVS = 434 * MiB;
constexpr size_t WS_END = 436 * MiB;
static_assert(WS_W1 + (size_t)DIN * DM * 2 <= WS_W2 && WS_W2 + (size_t)DM * DM * 2 <= WS_W3 && WS_W3 + (size_t)2 * DFF * DM * 2 <= WS_W4 && WS_W4 + (size_t)DM * DFF * 2 <= WS_H1, "ws map 1");
static_assert(WS_H1 + (size_t)M * DM * 2 <= WS_QB && WS_QB + (size_t)M * 512 * 2 <= WS_KB && WS_KB + (size_t)M * 512 * 2 <= WS_VB && WS_VB + (size_t)M * 512 * 2 <= WS_U, "ws map 2");
static_assert(WS_VB + (size_t)M * 512 * 2 <= WS_U && WS_U + (size_t)M * 512 * 4 <= WS_MIX && WS_MIX + (size_t)M * DM * 2 <= WS_X1B && WS_X1B + (size_t)M * DM * 2 <= WS_SSQ, "ws map 3");
static_assert(WS_SSQ + (size_t)M * 16 * 4 <= WS_HID && WS_HID + (size_t)M * DFF * 2 <= WS_PART && WS_PART + (size_t)NSMP * NCH * 64 * 68 * 4 <= WS_NKS, "ws map 4");
constexpr int CW_BAR = 4096;
constexpr int RING_OFF = 0, RING_BYTES = 131072;
constexpr int SCRATCH_BYTES = 152064;
constexpr int LDSCTL_OFF = SCRATCH_BYTES, MISC_OFF = LDSCTL_OFF + 320;
constexpr int RSTAB_OFF = LDSCTL_OFF + 1024;
constexpr int LDS_BYTES = 157696;
static_assert(MISC_OFF + 128 <= RSTAB_OFF && RSTAB_OFF + 4096 <= LDS_BYTES, "LDS map");

#define GAS __attribute__((address_space(1)))
#define LAS __attribute__((address_space(3)))
typedef unsigned short bf16;
typedef unsigned v4u __attribute__((ext_vector_type(4)));
typedef float f32x4 __attribute__((ext_vector_type(4)));
typedef short bf16x8 __attribute__((ext_vector_type(8)));
typedef GAS unsigned gu32;
typedef GAS unsigned long long gu64;
#define RLX_AGENT __ATOMIC_RELAXED, __HIP_MEMORY_SCOPE_AGENT
#define LDS_WAIT() asm volatile("s_waitcnt lgkmcnt(0)" ::: "memory")
#define VM_WAIT() asm volatile("s_waitcnt vmcnt(0)" ::: "memory")
__device__ __forceinline__ unsigned long long rt() { return __builtin_amdgcn_s_memrealtime(); }
__device__ __forceinline__ unsigned f2bf(float f) { unsigned u = __builtin_bit_cast(unsigned, f); return (u + 0x7fffu + ((u >> 16) & 1u)) >> 16; }
__device__ __forceinline__ unsigned pk2(float lo, float hi) { return f2bf(lo) | (f2bf(hi) << 16); }
#define XB_TMO      128
#define XB_XCNT(j)  (256  + 64 * (j))
#define XB_XSUB(j)  (1280 + 64 * (j))
#define XB_XGEN(j)  (2304 + 64 * (j))
#define XB_TOP      3328
#define XB_TOPGEN   3392
#define XCD_BAR_WORDS 3456
#define XB_SPIN_CAP (1u << 18)

__device__ __forceinline__ unsigned xb_ld(unsigned* p)              { return __hip_atomic_load(p, __ATOMIC_RELAXED, __HIP_MEMORY_SCOPE_AGENT); }
__device__ __forceinline__ unsigned xb_add(unsigned* p, unsigned v) { return __hip_atomic_fetch_add(p, v, __ATOMIC_RELAXED, __HIP_MEMORY_SCOPE_AGENT); }
__device__ __forceinline__ unsigned xb_xcc_id() { return (unsigned)__builtin_amdgcn_s_getreg((3 << 11) | 20) & 0xFu; }
#define XB_SPIN(cond, bar) do { unsigned _sp = 0; while (cond) { __builtin_amdgcn_s_sleep(1); \
    if ((++_sp & 255u) == 0u) { if (xb_ld(&(bar)[XB_TMO])) break; if (_sp > XB_SPIN_CAP) { atomicAdd(&(bar)[XB_TMO], 1u); break; } } } } while (0)

struct XcdBarrier {
    unsigned* bar; unsigned x;
    volatile LAS unsigned* st;
};

__device__ __forceinline__ XcdBarrier xcd_barrier_post(unsigned* bar, volatile LAS unsigned* st) {
    XcdBarrier b; b.bar = bar; b.x = xb_xcc_id(); b.st = st;
    if (threadIdx.x == 0) (void)xb_add(&bar[XB_XCNT(b.x)], 1u);
    return b;
}
__device__ __forceinline__ void xcd_barrier_complete(unsigned* bar, unsigned x, unsigned& nloc, unsigned& nx) {
    const unsigned G = gridDim.x * gridDim.y * gridDim.z;
    unsigned sum, cnt, mine, sp = 0u;
    for (;;) {
        sum = 0u; cnt = 0u; mine = 0u;
#pragma unroll
        for (unsigned j = 0; j < 16; ++j) { const unsigned c = xb_ld(&bar[XB_XCNT(j)]); sum += c; cnt += (c > 0u) ? 1u : 0u; mine = (j == x) ? c : mine; }
        if (sum == G) break;
        __builtin_amdgcn_s_sleep(1);
        if ((++sp & 255u) == 0u) { if (xb_ld(&bar[XB_TMO])) break; if (sp > XB_SPIN_CAP) { atomicAdd(&bar[XB_TMO], 1u); break; } }
    }
    nloc = mine > 0u ? mine : 1u; nx = cnt > 0u ? cnt : 1u;
}

__device__ __forceinline__ void xcd_barrier(const XcdBarrier& b) {
    asm volatile("s_waitcnt vmcnt(0)" ::: "memory");
    __syncthreads();
    if (threadIdx.x == 0) {
        unsigned* bar = b.bar;
        __builtin_amdgcn_s_waitcnt(0);
        unsigned nloc = b.st[0], nx = b.st[1];
        if (nloc == 0u) { xcd_barrier_complete(bar, b.x, nloc, nx); b.st[0] = nloc; b.st[1] = nx; }
        const unsigned old = xb_add(&bar[XB_XSUB(b.x)], 1u);
        const unsigned gen = old / nloc;
        if (old + 1u == (gen + 1u) * nloc) {
            __builtin_amdgcn_fence(__ATOMIC_RELEASE, "agent");
            asm volatile("s_waitcnt vmcnt(0)" ::: "memory");
            const unsigned og = xb_add(&bar[XB_TOP], 1u);
            const unsigned tg = og / nx;
            if (og + 1u == (tg + 1u) * nx) xb_add(&bar[XB_TOPGEN], 1u);
            else XB_SPIN(xb_ld(&bar[XB_TOPGEN]) == tg, bar);
            __builtin_amdgcn_fence(__ATOMIC_ACQUIRE, "agent");
            xb_add(&bar[XB_XGEN(b.x)], 1u);
            asm volatile("s_waitcnt vmcnt(0)" ::: "memory");
        } else {
            XB_SPIN(xb_ld(&bar[XB_XGEN(b.x)]) == gen, bar);
            __builtin_amdgcn_fence(__ATOMIC_ACQUIRE, "agent");
            asm volatile("s_waitcnt vmcnt(0)" ::: "memory");
        }
    }
    __syncthreads();
}

typedef short s16x4 __attribute__((ext_vector_type(4)));
typedef unsigned u32x2 __attribute__((ext_vector_type(2)));
__device__ __forceinline__ float wave_sum(float v) {
#pragma unroll
    for (int o = 1; o < 64; o <<= 1) v += __shfl_xor(v, o);
    return v;
}
template <int CTRL> __device__ __forceinline__ float dppf(float x) { return __builtin_bit_cast(float, __builtin_amdgcn_mov_dpp(__builtin_bit_cast(int, x), CTRL, 0xf, 0xf, true)); }
__device__ __forceinline__ float row16_sum(float x) {
    x += dppf<0xB1>(x); x += dppf<0x4E>(x); x += dppf<0x141>(x); x += dppf<0x128>(x); return x;
}
__device__ __forceinline__ float ex2(float x) { return __builtin_amdgcn_exp2f(x); }

template <int MAP> __device__ __forceinline__ int p0_dst_row(int n0) {
    if (MAP == 1) {
        if (n0 < 1536) { const int sec = n0 >> 9, hh = (n0 & 511) >> 6, d = n0 & 63; return 256 * (2 * sec + (hh >> 2)) + 128 * (d >> 5) + 32 * (hh & 3) + (d & 31); }
        if (n0 < 2048) { const int c = n0 - 1536; return 256 * (6 + (c >> 7)) + (c & 127); }
        const int c = n0 - 2048; return 256 * (6 + (c >> 7)) + 128 + (c & 127);
    }
    if (MAP == 2) return 256 * (n0 >> 7) + (n0 & 127);
    if (MAP == 3) return 256 * (n0 >> 7) + 128 + (n0 & 127);
    return n0;
}
template <int MAP> __device__ __forceinline__ void p0_item(const float* W, int K, int N, bf16* WT, const float* g, LAS float* scr, int item, int lane) {
    const int nblk = N / 64, kb = item / nblk, nb = item % nblk, k0 = 32 * kb, n0 = 64 * nb;
    f32x4 v[8];
#pragma unroll
    for (int i = 0; i < 8; ++i) v[i] = *(const f32x4*)(W + (size_t)(k0 + 4 * i + (lane >> 4)) * N + n0 + 4 * (lane & 15));
#pragma unroll
    for (int i = 0; i < 8; ++i) { const int kk = 4 * i + (lane >> 4); f32x4 w = v[i]; if (g) w = w * g[k0 + kk];
        LAS float* d = scr + kk * 65 + 4 * (lane & 15); d[0] = w.x; d[1] = w.y; d[2] = w.z; d[3] = w.w; }
    LDS_WAIT(); asm volatile("" ::: "memory");
#pragma unroll
    for (int j = 0; j < 4; ++j) { const int id = j * 64 + lane, n = id >> 2, c = id & 3; const LAS float* sp = scr + (8 * c) * 65 + n;
        v4u o; o.x = pk2(sp[0 * 65], sp[1 * 65]); o.y = pk2(sp[2 * 65], sp[3 * 65]); o.z = pk2(sp[4 * 65], sp[5 * 65]); o.w = pk2(sp[6 * 65], sp[7 * 65]);
        const int drow = p0_dst_row<MAP>(n0 + (n & 32)) + (n & 31);
        *(GAS v4u*)(WT + (size_t)drow * K + k0 + 8 * c) = o; }
    LDS_WAIT(); asm volatile("" ::: "memory");
}
struct P0D { const float* W; bf16* WT; const float* g; int K, N, map, k0, n0; };
__device__ __forceinline__ void p0_load(const P0D& d, f32x4 (&v)[8], int lane) {
#pragma unroll
    for (int i = 0; i < 8; ++i) v[i] = *(const f32x4*)(d.W + (size_t)(d.k0 + 4 * i + (lane >> 4)) * d.N + d.n0 + 4 * (lane & 15));
}
__device__ __forceinline__ void p0_store(const P0D& d, const f32x4 (&v)[8], LAS float* scr, int lane) {
#pragma unroll
    for (int i = 0; i < 8; ++i) { const int kk = 4 * i + (lane >> 4); f32x4 w = v[i]; if (d.g) w = w * d.g[d.k0 + kk];
        LAS float* q = scr + kk * 65 + 4 * (lane & 15); q[0] = w.x; q[1] = w.y; q[2] = w.z; q[3] = w.w; }
    LDS_WAIT(); asm volatile("" ::: "memory");
#pragma unroll
    for (int j = 0; j < 4; ++j) { const int id = j * 64 + lane, n = id >> 2, c = id & 3; const LAS float* sp = scr + (8 * c) * 65 + n;
        v4u o; o.x = pk2(sp[0 * 65], sp[1 * 65]); o.y = pk2(sp[2 * 65], sp[3 * 65]); o.z = pk2(sp[4 * 65], sp[5 * 65]); o.w = pk2(sp[6 * 65], sp[7 * 65]);
        const int nn = d.n0 + (n & 32);
        const int drow = (d.map == 1 ? p0_dst_row<1>(nn) : d.map == 2 ? p0_dst_row<2>(nn) : d.map == 3 ? p0_dst_row<3>(nn) : nn) + (n & 31);
        *(GAS v4u*)(d.WT + (size_t)drow * d.K + d.k0 + 8 * c) = o; }
    LDS_WAIT(); asm volatile("" ::: "memory");
}
__device__ __forceinline__ void rms_row_to_bf16(const float* xrow, const f32x4 (&gv)[4], bf16* orow, int lane) {
    const GAS f32x4* xr = (const GAS f32x4*)xrow + lane;
    f32x4 v[4]; float s = 0.f;
#pragma unroll
    for (int j = 0; j < 4; ++j) { v[j] = xr[64 * j]; s += (v[j].x * v[j].x + v[j].y * v[j].y) + (v[j].z * v[j].z + v[j].w * v[j].w); }
    const float rs = 1.f / sqrtf(wave_sum(s) * (1.f / 1024.f) + 1e-6f);
    GAS unsigned long long* o8 = (GAS unsigned long long*)orow + lane;
#pragma unroll
    for (int j = 0; j < 4; ++j) { const f32x4 y = v[j] * rs * gv[j]; o8[64 * j] = (unsigned long long)pk2(y.x, y.y) | ((unsigned long long)pk2(y.z, y.w) << 32); }
}

__device__ __forceinline__ void rms4_load(const float* x_p, const float* x_s, int m, int stride, int mfb, f32x4 (&v)[4][4], int lane) {
#pragma unroll
    for (int r = 0; r < 4; ++r) { int mr = m + r * stride; mr = mr < M ? mr : mfb;
        const GAS f32x4* p = (const GAS f32x4*)(mr < MP ? x_p + (size_t)mr * DM : x_s + (size_t)(mr - MP) * DM) + lane;
#pragma unroll
        for (int j = 0; j < 4; ++j) v[r][j] = p[64 * j]; }
}
__device__ __forceinline__ void rms4_finish(const f32x4 (&v)[4][4], int m, int stride, const f32x4 (&gv)[4], bf16* H1, int lane) {
#pragma unroll
    for (int r = 0; r < 4; ++r) { const int mr = m + r * stride; float sq = 0.f;
#pragma unroll
        for (int j = 0; j < 4; ++j) sq += (v[r][j].x * v[r][j].x + v[r][j].y * v[r][j].y) + (v[r][j].z * v[r][j].z + v[r][j].w * v[r][j].w);
        const float rs = 1.f / sqrtf(wave_sum(sq) * (1.f / 1024.f) + 1e-6f);
        if (mr < M) { GAS unsigned long long* q = (GAS unsigned long long*)(H1 + (size_t)mr * DM) + lane;
#pragma unroll
            for (int j = 0; j < 4; ++j) { const f32x4 y = v[r][j] * rs * gv[j]; q[64 * j] = (unsigned long long)pk2(y.x, y.y) | ((unsigned long long)pk2(y.z, y.w) << 32); } } }
}

__device__ __forceinline__ void rms_row2_to_bf16(const float* xa, const float* xb, const f32x4 (&gv)[4], bf16* oa, bf16* ob, int lane) {
    const GAS f32x4* pa = (const GAS f32x4*)xa + lane; const GAS f32x4* pb = (const GAS f32x4*)(xb ? xb : xa) + lane;
    f32x4 va[4], vb[4]; float sa = 0.f, sb = 0.f;
#pragma unroll
    for (int j = 0; j < 4; ++j) { va[j] = pa[64 * j]; vb[j] = pb[64 * j]; }
#pragma unroll
    for (int j = 0; j < 4; ++j) { sa += (va[j].x * va[j].x + va[j].y * va[j].y) + (va[j].z * va[j].z + va[j].w * va[j].w); sb += (vb[j].x * vb[j].x + vb[j].y * vb[j].y) + (vb[j].z * vb[j].z + vb[j].w * vb[j].w); }
    const float ra = 1.f / sqrtf(wave_sum(sa) * (1.f / 1024.f) + 1e-6f), rb = 1.f / sqrtf(wave_sum(sb) * (1.f / 1024.f) + 1e-6f);
    GAS unsigned long long* qa = (GAS unsigned long long*)oa + lane; GAS unsigned long long* qb = (GAS unsigned long long*)ob + lane;
#pragma unroll
    for (int j = 0; j < 4; ++j) { const f32x4 y = va[j] * ra * gv[j]; qa[64 * j] = (unsigned long long)pk2(y.x, y.y) | ((unsigned long long)pk2(y.z, y.w) << 32); }
    if (xb) {
#pragma unroll
        for (int j = 0; j < 4; ++j) { const f32x4 y = vb[j] * rb * gv[j]; qb[64 * j] = (unsigned long long)pk2(y.x, y.y) | ((unsigned long long)pk2(y.z, y.w) << 32); } }
}

__device__ __forceinline__ void combine_task(const float* __restrict__ PART, bf16* MIX, int n, int t, int hf, int lane) {
    const int head = hf * 4 + (lane >> 4);
    const float* p0 = PART + (((size_t)n * NCH * 8 + t) * 8 + head) * 68;
    float mc[NCH], lc[NCH]; f32x4 oc[NCH];
#pragma unroll
    for (int c = 0; c < NCH; ++c) { const float* pp = p0 + (size_t)c * 64 * 68; mc[c] = pp[64]; lc[c] = pp[65]; oc[c] = *(const f32x4*)(pp + 4 * (lane & 15)); }
    float mm = -1e30f;
#pragma unroll
    for (int c = 0; c < NCH; ++c) mm = fmaxf(mm, mc[c]);
    f32x4 num = (f32x4){0.f, 0.f, 0.f, 0.f}; float den = 0.f;
#pragma unroll
    for (int c = 0; c < NCH; ++c) { const float f = ex2(mc[c] - mm); den += f * lc[c]; num = num + oc[c] * f; }
    const float inv = 1.f / den;
    u32x2 w; w.x = pk2(num.x * inv, num.y * inv); w.y = pk2(num.z * inv, num.w * inv);
    *(u32x2*)(MIX + (size_t)(MP + n * 8 + t) * 1024 + head * 64 + 4 * (lane & 15)) = w;
}

__device__ __forceinline__ int at_kstart(int s, int tb, int r) { return s < 5 ? 16 * tb - 128 + 32 * s : (s < 11 ? 64 * tb + (r >> 2) - 128 + 32 * (s - 5) : 256 * tb + r - 128 + 32 * (s - 11)); }
__device__ __forceinline__ s16x4 vtr(const LAS unsigned char* p) { typedef short v4i16_t __attribute__((ext_vector_type(4))); return __builtin_bit_cast(s16x4, __builtin_amdgcn_ds_read_tr16_b64_v4i16((LAS v4i16_t*)p)); }
constexpr int AB_ROWS = 400, AB_PITCH = 144, AB_VIMG = AB_ROWS * AB_PITCH, AB_STG = 2 * AB_ROWS * AB_PITCH;
static_assert(AB_STG + 8 * 4608 <= SCRATCH_BYTES, "attention LDS map");
__device__ __forceinline__ void attn_tile_s(const bf16* __restrict__ Qb, const bf16* __restrict__ Kb, const bf16* __restrict__ Vb, bf16* MIX, const LAS unsigned char* kimg, const LAS unsigned char* vimg,
                                            LAS unsigned char* vst, int b, int h, int tb, int r, int lane) {
    asm volatile("" : "+v"(lane));
    const int fr = lane & 15, g = lane >> 4;
    const size_t rowbase = (size_t)b * SEQ;
    const bf16* qp = Qb + (rowbase + 256 * tb + r + 16 * fr) * 512 + h * 64 + 8 * g;
    bf16x8 qf[2]; qf[0] = *(const bf16x8*)qp; qf[1] = *(const bf16x8*)(qp + 32);
    f32x4 o[4];
#pragma unroll
    for (int c = 0; c < 4; ++c) o[c] = (f32x4){0.f, 0.f, 0.f, 0.f};
    float mrun = -1e30f, lsum = 0.f;
    const bf16* Kh = Kb + rowbase * 512 + h * 64; const bf16* Vh = Vb + rowbase * 512 + h * 64;
    const LAS unsigned char* trp = vst + (4 * g + (fr >> 2)) * 144 + 8 * (fr & 3);
    const int kb16 = 16 * tb - 128, kb4 = 64 * tb + (r >> 2) - 128, kb1 = 256 * tb + r - 128;
    const int m16 = kb16 < 0 ? ((-kb16) >> 5) : 0, m4 = kb4 < 0 ? ((-kb4) >> 5) : 0, m1 = kb1 < 0 ? ((-kb1) >> 5) : 0;
    const int n16 = 5 - m16, cntg = n16 + 6 - m4;
#define AT_SOF(J) ((J) < n16 ? m16 + (J) : ((J) < cntg ? 5 + m4 + ((J) - n16) : 23))
#define AT_SOFTMAX_PV(TRP) \
        float rm = -INFINITY; \
        _Pragma("unroll") for (int T = 0; T < 2; ++T) \
            _Pragma("unroll") for (int e = 0; e < 4; ++e) { if (hi_ < lo_ || (unsigned)(16 * T + e - lo_) > span_) st[T][e] = -INFINITY; rm = fmaxf(rm, st[T][e]); } \
        rm = pg8::xrow16_max(rm); \
        const float mn = fmaxf(mrun, rm), al = ex2(mrun - mn); mrun = mn; \
        float ps = 0.f; \
        _Pragma("unroll") for (int T = 0; T < 2; ++T) \
            _Pragma("unroll") for (int e = 0; e < 4; ++e) { st[T][e] = ex2(st[T][e] - mn); ps += st[T][e]; } \
        lsum = lsum * al + ps; \
        _Pragma("unroll") for (int c = 0; c < 4; ++c) o[c] = o[c] * al; \
        v4u pw; pw.x = pg8::cvt_pk_bf16(st[0][0], st[0][1]); pw.y = pg8::cvt_pk_bf16(st[0][2], st[0][3]); pw.z = pg8::cvt_pk_bf16(st[1][0], st[1][1]); pw.w = pg8::cvt_pk_bf16(st[1][2], st[1][3]); \
        const bf16x8 pb = __builtin_bit_cast(bf16x8, pw); \
        asm volatile("s_waitcnt lgkmcnt(0)" ::: "memory"); \
        _Pragma("unroll") for (int c = 0; c < 4; ++c) { const s16x4 lo = vtr((TRP) + 32 * c), hi = vtr((TRP) + 16 * 144 + 32 * c); \
            const bf16x8 va = (bf16x8){lo[0], lo[1], lo[2], lo[3], hi[0], hi[1], hi[2], hi[3]}; \
            o[c] = __builtin_amdgcn_mfma_f32_16x16x32_bf16(va, pb, o[c], 0, 0, 0); } \
        asm volatile("s_waitcnt lgkmcnt(0)" ::: "memory");
    bf16x8 kreg[2][2][2]; v4u vreg[2][4];
#define AT_LOAD(B, S) do { const int s_ = (S) < 11 ? (S) : 10; const int dsh_ = s_ < 5 ? 4 : 2, rd_ = s_ < 5 ? r : (r & 3), ks_ = at_kstart(s_, tb, r); \
        _Pragma("unroll") for (int T = 0; T < 2; ++T) { int pos = rd_ + ((ks_ + 16 * T + fr) << dsh_); pos = pos < 0 ? 0 : (pos > SEQ - 1 ? SEQ - 1 : pos); const bf16* kp = Kh + (size_t)pos * 512 + 8 * g; \
            kreg[B][T][0] = *(const bf16x8*)kp; kreg[B][T][1] = *(const bf16x8*)(kp + 32); } \
        _Pragma("unroll") for (int i = 0; i < 4; ++i) { const int ci = i * 64 + lane; int pos = rd_ + ((ks_ + (ci >> 3)) << dsh_); pos = pos < 0 ? 0 : (pos > SEQ - 1 ? SEQ - 1 : pos); \
            vreg[B][i] = *(const v4u*)(Vh + (size_t)pos * 512 + 8 * (ci & 7)); } } while (0)
#define AT_STEP(B, S, SN) do { const int sx = (S); const bool null_ = sx >= 11; const int s = null_ ? 10 : sx; \
        const int c0 = s < 5 ? 16 * tb : 64 * tb + (r >> 2), sqsh = s < 5 ? 0 : 2, ks = at_kstart(s, tb, r); \
        _Pragma("unroll") for (int i = 0; i < 4; ++i) { const int ci = i * 64 + lane; *(LAS v4u*)(vst + (ci >> 3) * 144 + (ci & 7) * 16) = vreg[B][i]; } \
        f32x4 st[2]; \
        _Pragma("unroll") for (int T = 0; T < 2; ++T) { st[T] = __builtin_amdgcn_mfma_f32_16x16x32_bf16(kreg[B][T][0], qf[0], (f32x4){0.f, 0.f, 0.f, 0.f}, 0, 0, 0); st[T] = __builtin_amdgcn_mfma_f32_16x16x32_bf16(kreg[B][T][1], qf[1], st[T], 0, 0, 0); } \
        AT_LOAD(B, (SN)); \
        const int hi_ = null_ ? -1 : c0 + (fr << sqsh) - ks - 4 * g;       \
        const int lo_ = null_ ? 0 : ((hi_ - 128) > (-ks - 4 * g) ? (hi_ - 128) : (-ks - 4 * g)); const unsigned span_ = (unsigned)(hi_ - lo_); \
        AT_SOFTMAX_PV(trp) } while (0)
    AT_LOAD(0, AT_SOF(0)); AT_LOAD(1, AT_SOF(1));
#pragma unroll 1
    for (int j = 0; j < cntg; j += 2) {
        AT_STEP(0, AT_SOF(j), AT_SOF(j + 2));
        AT_STEP(1, AT_SOF(j + 1), AT_SOF(j + 3));
    }
    const LAS unsigned char* kfp = kimg + (r + fr) * AB_PITCH + 16 * g;
    const LAS unsigned char* trv = vimg + (r + 4 * g + (fr >> 2)) * AB_PITCH + 8 * (fr & 3);
#pragma unroll 1
    for (int sl = m1; sl < 12; ++sl) {
        const int ks = kb1 + 32 * sl;
        f32x4 st[2];
#pragma unroll
        for (int T = 0; T < 2; ++T) { const LAS unsigned char* kp = kfp + (32 * sl + 16 * T) * AB_PITCH; const bf16x8 k0 = *(const LAS bf16x8*)kp, k1 = *(const LAS bf16x8*)(kp + 64);
            st[T] = __builtin_amdgcn_mfma_f32_16x16x32_bf16(k0, qf[0], (f32x4){0.f, 0.f, 0.f, 0.f}, 0, 0, 0); st[T] = __builtin_amdgcn_mfma_f32_16x16x32_bf16(k1, qf[1], st[T], 0, 0, 0); }
        const int hi_ = 256 * tb + r + (fr << 4) - ks - 4 * g;
        const int lo_ = (hi_ - 128) > (-ks - 4 * g) ? (hi_ - 128) : (-ks - 4 * g); const unsigned span_ = (unsigned)(hi_ - lo_);
        const LAS unsigned char* trl = trv + 32 * sl * AB_PITCH;
        AT_SOFTMAX_PV(trl)
    }
#undef AT_STEP
#undef AT_LOAD
#undef AT_SOFTMAX_PV
#undef AT_SOF
    lsum = pg8::xrow16_sum(lsum);
    const float inv = 1.f / lsum;
    bf16* op = MIX + (rowbase + 256 * tb + r + 16 * fr) * 1024 + h * 64 + 4 * g;
#pragma unroll
    for (int c = 0; c < 4; ++c) { u32x2 w; w.x = pg8::cvt_pk_bf16(o[c][0] * inv, o[c][1] * inv); w.y = pg8::cvt_pk_bf16(o[c][2] * inv, o[c][3] * inv); *(u32x2*)(op + 16 * c) = w; }
}
__device__ __forceinline__ void attn_block(const bf16* __restrict__ Qb, const bf16* __restrict__ Kb, const bf16* __restrict__ Vb, bf16* MIX, LAS unsigned char* lds, int b, int h, int tb, int tid) {
    const int lane = tid & 63, wv = __builtin_amdgcn_readfirstlane(tid >> 6);
    const bf16* Kh = Kb + (size_t)b * SEQ * 512 + h * 64; const bf16* Vh = Vb + (size_t)b * SEQ * 512 + h * 64;
    const int base = 256 * tb - 128;
    v4u kv[7], vv[7];
#pragma unroll
    for (int i = 0; i < 7; ++i) { const int c = i * 512 + tid; int row = c >> 3; row = row < AB_ROWS ? row : AB_ROWS - 1; int pos = base + row; pos = pos < 0 ? 0 : (pos > SEQ - 1 ? SEQ - 1 : pos);
        kv[i] = *(const v4u*)(Kh + (size_t)pos * 512 + 8 * (c & 7)); vv[i] = *(const v4u*)(Vh + (size_t)pos * 512 + 8 * (c & 7)); }
#pragma unroll
    for (int i = 0; i < 7; ++i) { const int c = i * 512 + tid, row = c >> 3;
        if (row < AB_ROWS) { *(LAS v4u*)(lds + row * AB_PITCH + (c & 7) * 16) = kv[i]; *(LAS v4u*)(lds + AB_VIMG + row * AB_PITCH + (c & 7) * 16) = vv[i]; } }
    asm volatile("s_waitcnt lgkmcnt(0)" ::: "memory"); __builtin_amdgcn_s_barrier(); asm volatile("" ::: "memory");
    attn_tile_s(Qb, Kb, Vb, MIX, lds, lds + AB_VIMG, lds + AB_STG + wv * 4608, b, h, tb, wv, lane);
    attn_tile_s(Qb, Kb, Vb, MIX, lds, lds + AB_VIMG, lds + AB_STG + wv * 4608, b, h, tb, wv + 8, lane);
    asm volatile("s_waitcnt lgkmcnt(0)" ::: "memory"); __builtin_amdgcn_s_barrier(); asm volatile("" ::: "memory");
}

constexpr int SF_STRIDE = 1040, SF_VIMG = 32 * SF_STRIDE;
__device__ __forceinline__ void stream_fused(const float* __restrict__ ck, const float* __restrict__ cv, const float* __restrict__ NKs, const float* __restrict__ NVs, float* out,
                                             const bf16* __restrict__ Qb, float* PART, LAS unsigned char* img, int n, int part, int tid) {
    asm volatile("" : "+v"(tid));
    const int lane = tid & 63, h = __builtin_amdgcn_readfirstlane(tid >> 6), fr = lane & 15, g = lane >> 4;
    const int rsub = __builtin_amdgcn_readfirstlane(tid >> 7), cc = tid & 127;
    bf16x8 qf[2]; qf[0] = (bf16x8){0, 0, 0, 0, 0, 0, 0, 0}; qf[1] = qf[0];
    if (fr < 8) { const bf16* qp = Qb + (size_t)(MP + n * 8 + fr) * 512 + h * 64 + 8 * g; qf[0] = *(const bf16x8*)qp; qf[1] = *(const bf16x8*)(qp + 32); }
    f32x4 o[4];
#pragma unroll
    for (int c = 0; c < 4; ++c) o[c] = (f32x4){0.f, 0.f, 0.f, 0.f};
    float mrun = -1e30f, lsum = 0.f;
    const bool isv = tid >= 256;
    const int rsub2 = __builtin_amdgcn_readfirstlane((tid >> 7) & 1);
    const float* sbase = (isv ? cv : ck) + (size_t)n * LBUF * 512 + 4 * cc; const float* nsb = (isv ? NVs : NKs) + (size_t)n * 8 * 512 + 4 * cc;
    float* obase = out + (isv ? O_VS : O_KS) + (size_t)n * LBUF * 512 + 4 * cc;
    const LAS unsigned char* kfp = img + fr * SF_STRIDE + h * 128 + 16 * g;
    const LAS unsigned char* trp = img + SF_VIMG + (4 * g + (fr >> 2)) * SF_STRIDE + h * 128 + 8 * (fr & 3);
    LAS unsigned char* wrp = img + (isv ? SF_VIMG : 0) + rsub2 * SF_STRIDE + cc * 8;
    const int b0 = part ? 32 : 0, b1 = part ? 66 : 32;
    f32x4 ra[16], rb[16];
#define SF_LOAD(R, BB) do { const int bb_ = (BB) < b1 ? (BB) : b1 - 1; \
        _Pragma("unroll") for (int i = 0; i < 16; ++i) { int a_ = 32 * bb_ + 2 * i + rsub2; a_ = a_ < LBUF + TS ? a_ : LBUF + TS - 1; const bool new_ = a_ >= LBUF; \
            const float* sp = new_ ? nsb + (size_t)(a_ - LBUF) * 512 : sbase + (size_t)a_ * 512; \
            R[i] = __builtin_nontemporal_load((const f32x4*)sp); } } while (0)
#define SF_CONSUME(R, BB) do { const int bb_ = (BB); \
        _Pragma("unroll") for (int i = 0; i < 16; ++i) { const int a_ = 32 * bb_ + 2 * i + rsub2; \
            if (a_ >= 8 && a_ < LBUF) __builtin_nontemporal_store(R[i], (f32x4*)(obase + (size_t)(a_ - 8) * 512)); \
            u32x2 wk; wk.x = pg8::cvt_pk_bf16(R[i].x, R[i].y); wk.y = pg8::cvt_pk_bf16(R[i].z, R[i].w); \
            *(LAS u32x2*)(wrp + 2 * i * SF_STRIDE) = wk; } } while (0)
#define SF_BAR() do { asm volatile("s_waitcnt lgkmcnt(0)" ::: "memory"); __builtin_amdgcn_s_barrier(); asm volatile("" ::: "memory"); } while (0)
#define SF_STEP(BB) do { const int bq_ = (BB); \
        f32x4 st[2]; \
        _Pragma("unroll") for (int T = 0; T < 2; ++T) { const bf16x8 k0 = *(const LAS bf16x8*)(kfp + T * 16 * SF_STRIDE), k1 = *(const LAS bf16x8*)(kfp + T * 16 * SF_STRIDE + 64); \
            st[T] = __builtin_amdgcn_mfma_f32_16x16x32_bf16(k0, qf[0], (f32x4){0.f, 0.f, 0.f, 0.f}, 0, 0, 0); st[T] = __builtin_amdgcn_mfma_f32_16x16x32_bf16(k1, qf[1], st[T], 0, 0, 0); } \
        float wgt[2][4]; float rm = -INFINITY; \
        _Pragma("unroll") for (int T = 0; T < 2; ++T) \
            _Pragma("unroll") for (int e = 0; e < 4; ++e) { const int dist = LBUF + fr - (32 * bq_ + 16 * T + 4 * g + e); \
                int w_ = (dist <= 128 ? 1 : 0) + (((dist & 3) == 0 && dist <= 512) ? 1 : 0) + (((dist & 15) == 0 && dist <= 2048) ? 1 : 0); \
                if (dist < 0 || fr >= 8) w_ = 0; \
                wgt[T][e] = (float)w_; if (w_ == 0) st[T][e] = -INFINITY; rm = fmaxf(rm, st[T][e]); } \
        rm = pg8::xrow16_max(rm); \
        const float mn = fmaxf(mrun, rm), al = ex2(mrun - mn); mrun = mn; \
        float ps = 0.f; \
        _Pragma("unroll") for (int T = 0; T < 2; ++T) \
            _Pragma("unroll") for (int e = 0; e < 4; ++e) { st[T][e] = wgt[T][e] * ex2(st[T][e] - mn); ps += st[T][e]; } \
        lsum = lsum * al + ps; \
        _Pragma("unroll") for (int c = 0; c < 4; ++c) o[c] = o[c] * al; \
        v4u pw; pw.x = pg8::cvt_pk_bf16(st[0][0], st[0][1]); pw.y = pg8::cvt_pk_bf16(st[0][2], st[0][3]); pw.z = pg8::cvt_pk_bf16(st[1][0], st[1][1]); pw.w = pg8::cvt_pk_bf16(st[1][2], st[1][3]); \
        const bf16x8 pb = __builtin_bit_cast(bf16x8, pw); \
        _Pragma("unroll") for (int c = 0; c < 4; ++c) { const s16x4 lo = vtr(trp + 32 * c), hi = vtr(trp + 16 * SF_STRIDE + 32 * c); \
            const bf16x8 va = (bf16x8){lo[0], lo[1], lo[2], lo[3], hi[0], hi[1], hi[2], hi[3]}; \
            o[c] = __builtin_amdgcn_mfma_f32_16x16x32_bf16(va, pb, o[c], 0, 0, 0); } } while (0)
    SF_LOAD(ra, b0); SF_LOAD(rb, b0 + 1);
#pragma unroll 1
    for (int b = b0; b < b1; b += 2) {
        SF_CONSUME(ra, b); SF_LOAD(ra, b + 2); SF_BAR(); SF_STEP(b); SF_BAR();
        SF_CONSUME(rb, b + 1); SF_LOAD(rb, b + 3); SF_BAR(); SF_STEP(b + 1); SF_BAR();
    }
#undef SF_LOAD
#undef SF_CONSUME
#undef SF_STEP
#undef SF_BAR
    lsum = pg8::xrow16_sum(lsum);
    if (fr < 8) { float* pp = PART + ((((size_t)n * NCH + part) * 8 + fr) * 8 + h) * 68;
#pragma unroll
        for (int c = 0; c < 4; ++c) *(f32x4*)(pp + 16 * c + 4 * g) = o[c];
        if (g == 0) { pp[64] = mrun; pp[65] = lsum; } }
}

__device__ __forceinline__ void conv_task(const float* __restrict__ U, const float* __restrict__ state, const float* __restrict__ cw, const float* __restrict__ cb, const float* __restrict__ lng, const float* __restrict__ lnb,
                                          bf16* MIX, float* out, LAS float* cl, int task, int lane) {
    asm volatile("" : "+v"(lane));
    const bool samp = task >= 2048; const int n = task - 2048, b = task >> 8, t0 = (task & 255) * 8;
    const size_t row0 = samp ? (size_t)MP + (size_t)n * 8 : (size_t)b * SEQ + t0;
    float sum[8];
#pragma unroll
    for (int t = 0; t < 8; ++t) sum[t] = 0.f;
#define CONV_LOAD(WIN, CG) do { const int ch_ = 64 * (CG) + lane; \
        if (samp) { \
            _Pragma("unroll") for (int j = 0; j < 30; ++j) WIN[j] = state[((size_t)n * 30 + j) * 512 + ch_]; \
            _Pragma("unroll") for (int j = 30; j < 38; ++j) WIN[j] = U[(row0 + (j - 30)) * 512 + ch_]; \
        } else { \
            _Pragma("unroll") for (int j = 0; j < 38; ++j) { const int tt = t0 - 30 + j; const float v = U[((size_t)b * SEQ + (tt < 0 ? 0 : tt)) * 512 + ch_]; WIN[j] = (tt >= 0) ? v : 0.f; } \
        } \
        } while (0)
    float win[38];
    CONV_LOAD(win, 0);
#pragma unroll 1
    for (int cg = 0; cg < 8; ++cg) { const int ch = 64 * cg + lane;
        float wv[31];
#pragma unroll
        for (int j = 0; j < 31; ++j) wv[j] = cw[j * 512 + ch];
        const float bias = cb[ch];
        float winn[38];
        CONV_LOAD(winn, (cg < 7 ? cg + 1 : 7));
#pragma unroll
        for (int t = 0; t < 8; ++t) { float a = bias;
#pragma unroll
            for (int j = 0; j < 31; ++j) a += wv[j] * win[t + j];
            cl[t * 512 + ch] = a; sum[t] += a; }
        if (samp) {
#pragma unroll
            for (int i = 0; i < 30; ++i) out[O_CS + ((size_t)n * 30 + i) * 512 + ch] = win[8 + i];
        } else if (t0 >= 2016) {
#pragma unroll
            for (int j = 30; j < 38; ++j) { const int tt = t0 - 30 + j; if (tt >= 2018) out[O_CP + ((size_t)b * 30 + (tt - 2018)) * 512 + ch] = win[j]; }
        }
#pragma unroll
        for (int j = 0; j < 38; ++j) win[j] = winn[j];
    }
#undef CONV_LOAD
    LDS_WAIT(); asm volatile("" ::: "memory");
    float mean[8], rstd[8], s2[8];
#pragma unroll
    for (int t = 0; t < 8; ++t) { mean[t] = wave_sum(sum[t]) * (1.f / 512.f); s2[t] = 0.f; }
#pragma unroll 1
    for (int cg = 0; cg < 8; ++cg) { const int ch = 64 * cg + lane;
#pragma unroll
        for (int t = 0; t < 8; ++t) { const float d = cl[t * 512 + ch] - mean[t]; s2[t] += d * d; } }
#pragma unroll
    for (int t = 0; t < 8; ++t) rstd[t] = 1.f / sqrtf(wave_sum(s2[t]) * (1.f / 512.f) + 1e-5f);
#pragma unroll 1
    for (int cg = 0; cg < 8; ++cg) { const int ch = 64 * cg + lane; const float gg = lng[ch], bb = lnb[ch];
#pragma unroll
        for (int t = 0; t < 8; ++t) { const float y = (cl[t * 512 + ch] - mean[t]) * rstd[t] * gg + bb; const float sw = y * pg8::sigmoidf_fast(y);
            MIX[(row0 + t) * 1024 + 512 + ch] = (bf16)f2bf(sw); } }
    LDS_WAIT(); asm volatile("" ::: "memory");
}

__device__ __forceinline__ void conv_samp_wg(const float* __restrict__ U, const float* __restrict__ state, const float* __restrict__ cw, const float* __restrict__ cb, const float* __restrict__ lng, const float* __restrict__ lnb,
                                             bf16* MIX, float* out, LAS float* red, int n, int wave, int lane) {
    asm volatile("" : "+v"(lane));
    const int ch = 64 * wave + lane; const size_t row0 = (size_t)MP + (size_t)n * 8;
    float win[38], wv[31];
#pragma unroll
    for (int j = 0; j < 30; ++j) win[j] = state[((size_t)n * 30 + j) * 512 + ch];
#pragma unroll
    for (int j = 30; j < 38; ++j) win[j] = U[(row0 + (j - 30)) * 512 + ch];
#pragma unroll
    for (int j = 0; j < 31; ++j) wv[j] = cw[j * 512 + ch];
    const float bias = cb[ch], gg = lng[ch], bb = lnb[ch];
    float a[8];
#pragma unroll
    for (int t = 0; t < 8; ++t) { float acc = bias;
#pragma unroll
        for (int j = 0; j < 31; ++j) acc += wv[j] * win[t + j];
        a[t] = acc; }
#pragma unroll
    for (int i = 0; i < 30; ++i) out[O_CS + ((size_t)n * 30 + i) * 512 + ch] = win[8 + i];
#pragma unroll
    for (int t = 0; t < 8; ++t) { const float sq = wave_sum(a[t]); if (lane == 0) red[wave * 8 + t] = sq; }
    __syncthreads();
#pragma unroll
    for (int t = 0; t < 8; ++t) { float sq = 0.f;
#pragma unroll
        for (int w = 0; w < 8; ++w) sq += red[w * 8 + t];
        a[t] -= sq * (1.f / 512.f);
        const float s2 = wave_sum(a[t] * a[t]); if (lane == 0) red[64 + wave * 8 + t] = s2; }
    __syncthreads();
#pragma unroll
    for (int t = 0; t < 8; ++t) { float s2 = 0.f;
#pragma unroll
        for (int w = 0; w < 8; ++w) s2 += red[64 + w * 8 + t];
        const float y = a[t] * (1.f / sqrtf(s2 * (1.f / 512.f) + 1e-5f)) * gg + bb; const float sw = y * pg8::sigmoidf_fast(y);
        MIX[(row0 + t) * 1024 + 512 + ch] = (bf16)f2bf(sw); }
    __syncthreads();
}

template <int MODE> __device__ __forceinline__ void small_gemm(const bf16* __restrict__ A, int lda, const bf16* __restrict__ Bt, int K, int tile, LAS float* red,
                                                               const float* __restrict__ xs, bf16* X1b, float* SSQ, float* y, int tid) {
    asm volatile("" : "+v"(tid));
    const int lane = tid & 63, wv = __builtin_amdgcn_readfirstlane(tid >> 6), fr = lane & 15, g = lane >> 4;
    const int tm = tile >> 4, tn = tile & 15, kw = K / 8, nst = kw / 32;
    f32x4 acc[4][4];
#pragma unroll
    for (int i = 0; i < 4; ++i)
#pragma unroll
        for (int j = 0; j < 4; ++j) acc[i][j] = (f32x4){0.f, 0.f, 0.f, 0.f};
    const bf16* ap = A + (size_t)(tm * 64 + fr) * lda + wv * kw + 8 * g;
    const bf16* bp = Bt + (size_t)(tn * 64 + fr) * K + wv * kw + 8 * g;
    bf16x8 a0[4], b0[4];
#pragma unroll
    for (int i = 0; i < 4; ++i) { a0[i] = *(const bf16x8*)(ap + (size_t)i * 16 * lda); b0[i] = *(const bf16x8*)(bp + (size_t)i * 16 * K); }
#pragma unroll 1
    for (int st = 0; st < nst; ++st) {
        bf16x8 a1[4], b1[4]; const int sn = (st + 1 < nst) ? st + 1 : st;
#pragma unroll
        for (int i = 0; i < 4; ++i) { a1[i] = *(const bf16x8*)(ap + (size_t)i * 16 * lda + 32 * sn); b1[i] = *(const bf16x8*)(bp + (size_t)i * 16 * K + 32 * sn); }
#pragma unroll
        for (int i = 0; i < 4; ++i)
#pragma unroll
            for (int j = 0; j < 4; ++j) acc[i][j] = __builtin_amdgcn_mfma_f32_16x16x32_bf16(a0[i], b0[j], acc[i][j], 0, 0, 0);
#pragma unroll
        for (int i = 0; i < 4; ++i) { a0[i] = a1[i]; b0[i] = b1[i]; }
    }
    LAS float* rw = red + wv * 4096;
#pragma unroll
    for (int i = 0; i < 4; ++i)
#pragma unroll
        for (int j = 0; j < 4; ++j)
#pragma unroll
            for (int e = 0; e < 4; ++e) rw[(16 * i + 4 * g + e) * 64 + 16 * j + fr] = acc[i][j][e];
    __syncthreads();
    const int row = tid >> 3, c0 = (tid & 7) * 8;
    f32x4 s0 = (f32x4){0.f, 0.f, 0.f, 0.f}, s1 = s0;
#pragma unroll
    for (int w = 0; w < 8; ++w) { const LAS float* rp = red + w * 4096 + row * 64 + c0; s0 = s0 + *(const LAS f32x4*)rp; s1 = s1 + *(const LAS f32x4*)(rp + 4); }
    const size_t grow = (size_t)MP + tm * 64 + row; const int col = tn * 64 + c0;
    if (MODE == 0) {
        const float* xr = xs + (size_t)(tm * 64 + row) * 1024 + col;
        const f32x4 v0 = s0 + *(const f32x4*)xr, v1 = s1 + *(const f32x4*)(xr + 4);
        v4u w; w.x = pg8::cvt_pk_bf16(v0[0], v0[1]); w.y = pg8::cvt_pk_bf16(v0[2], v0[3]); w.z = pg8::cvt_pk_bf16(v1[0], v1[1]); w.w = pg8::cvt_pk_bf16(v1[2], v1[3]);
        *(v4u*)(X1b + grow * 1024 + col) = w;
        float ss = (v0[0] * v0[0] + v0[1] * v0[1]) + (v0[2] * v0[2] + v0[3] * v0[3]) + (v1[0] * v1[0] + v1[1] * v1[1]) + (v1[2] * v1[2] + v1[3] * v1[3]);
        ss += dppf<0xB1>(ss); ss += dppf<0x4E>(ss); ss += dppf<0x141>(ss);
        if ((tid & 7) == 0) SSQ[grow * 16 + tn] = ss;
    } else {
        const v4u w = *(const v4u*)(X1b + grow * 1024 + col);
        const f32x4 r0 = (f32x4){__uint_as_float(w.x << 16), __uint_as_float(w.x & 0xffff0000u), __uint_as_float(w.y << 16), __uint_as_float(w.y & 0xffff0000u)};
        const f32x4 r1 = (f32x4){__uint_as_float(w.z << 16), __uint_as_float(w.z & 0xffff0000u), __uint_as_float(w.w << 16), __uint_as_float(w.w & 0xffff0000u)};
        *(f32x4*)(y + grow * 1024 + col) = s0 + r0; *(f32x4*)(y + grow * 1024 + col + 4) = s1 + r1;
    }
    __syncthreads();
}

struct Args { const float* in[18]; float* out; unsigned char* ws; };
__global__ void __launch_bounds__(NWAVES * 64, 2) hymba_fwd(Args args) {
    extern __shared__ __attribute__((aligned(16))) unsigned char lds[];
    LAS unsigned char* L = (LAS unsigned char*)lds;
    volatile LAS unsigned* MISC = (volatile LAS unsigned*)(L + MISC_OFF);
    const int tid = threadIdx.x, lane = tid & 63, wave = __builtin_amdgcn_readfirstlane(tid >> 6);
    const int G = gridDim.x; const int bx = blockIdx.x; const int vcu = (G % 8 == 0) ? (bx % 8) * (G / 8) + bx / 8 : bx;
    unsigned char* ws = args.ws; float* out = args.out;
    gu32* ctl = (gu32*)(ws + WS_CTL);
    const float* x_p = args.in[0]; const float* x_s = args.in[1]; const float* cache_k = args.in[2]; const float* cache_v = args.in[3]; const float* state_conv = args.in[4];
    const float* g_attn = args.in[5]; const float* w_in = args.in[6]; const float* g_q = args.in[7]; const float* g_k = args.in[8]; const float* conv_w = args.in[9]; const float* conv_b = args.in[10];
    const float* ln_g = args.in[11]; const float* ln_b = args.in[12]; const float* w_out = args.in[13]; const float* g_ffn = args.in[14]; const float* w_gate = args.in[15]; const float* w_up = args.in[16]; const float* w_down = args.in[17];
    bf16* W1t = (bf16*)(ws + WS_W1); bf16* W2t = (bf16*)(ws + WS_W2); bf16* W3t = (bf16*)(ws + WS_W3); bf16* W4t = (bf16*)(ws + WS_W4);
    bf16* H1 = (bf16*)(ws + WS_H1); bf16* Qb = (bf16*)(ws + WS_QB); bf16* Kb = (bf16*)(ws + WS_KB); bf16* Vb = (bf16*)(ws + WS_VB);
    float* U = (float*)(ws + WS_U); bf16* MIX = (bf16*)(ws + WS_MIX); bf16* X1b = (bf16*)(ws + WS_X1B); float* SSQ = (float*)(ws + WS_SSQ);
    bf16* HID = (bf16*)(ws + WS_HID); float* PART = (float*)(ws + WS_PART); float* NKs = (float*)(ws + WS_NKS); float* NVs = (float*)(ws + WS_NVS);

    for (int u = tid; u < (LDS_BYTES - LDSCTL_OFF) / 4; u += NWAVES * 64) ((LAS unsigned*)(L + LDSCTL_OFF))[u] = 0u;
    __syncthreads();
    XcdBarrier bar = xcd_barrier_post((unsigned*)(ctl + CW_BAR), MISC + 8);
    const int gw = vcu * NWAVES + wave, NGW = G * NWAVES;

    {
        LAS float* scr = (LAS float*)(L + RING_OFF + wave * 16384);
        constexpr int I_1 = (DM / 32) * (DIN / 64), I_2 = (DM / 32) * (DM / 64), I_3 = (DM / 32) * (DFF / 64), I_4 = (DFF / 32) * (DM / 64);
        constexpr int NITEMS = I_1 + I_2 + 2 * I_3 + I_4;
        auto dec = [&](int it) -> P0D { P0D d; int r = it;
            if (r < I_1) { d.W = w_in; d.WT = W1t; d.g = nullptr; d.K = DM; d.N = DIN; d.map = 1; }
            else if ((r -= I_1) < I_2) { d.W = w_out; d.WT = W2t; d.g = nullptr; d.K = DM; d.N = DM; d.map = 0; }
            else if ((r -= I_2) < I_3) { d.W = w_gate; d.WT = W3t; d.g = g_ffn; d.K = DM; d.N = DFF; d.map = 2; }
            else if ((r -= I_3) < I_3) { d.W = w_up; d.WT = W3t; d.g = g_ffn; d.K = DM; d.N = DFF; d.map = 3; }
            else { r -= I_3; d.W = w_down; d.WT = W4t; d.g = nullptr; d.K = DFF; d.N = DM; d.map = 0; }
            const int nblk = d.N / 64; d.k0 = 32 * (r / nblk); d.n0 = 64 * (r % nblk); return d; };
        for (int it = gw; it < NITEMS; it += 3 * NGW) {
            const int it2 = it + NGW, it3 = it + 2 * NGW; const bool has2 = it2 < NITEMS, has3 = it3 < NITEMS;
            const P0D da = dec(it), db = dec(has2 ? it2 : it), dc = dec(has3 ? it3 : it);
            f32x4 va[8], vb[8], vc[8];
            p0_load(da, va, lane); p0_load(db, vb, lane); p0_load(dc, vc, lane);
            p0_store(da, va, scr, lane);
            if (has2) p0_store(db, vb, scr, lane);
            if (has3) p0_store(dc, vc, scr, lane);
        }
        f32x4 gv[4];
#pragma unroll
        for (int j = 0; j < 4; ++j) gv[j] = *((const f32x4*)g_attn + lane + 64 * j);
        {
            f32x4 ra[4][4], rb[4][4]; int m = gw;
            if (m < M) { rms4_load(x_p, x_s, m, NGW, gw, ra, lane);
                for (;;) {
                    const int mb = m + 4 * NGW; rms4_load(x_p, x_s, mb, NGW, gw, rb, lane); rms4_finish(ra, m, NGW, gv, H1, lane); if (mb >= M) break;
                    m = mb + 4 * NGW;           rms4_load(x_p, x_s, m, NGW, gw, ra, lane);  rms4_finish(rb, mb, NGW, gv, H1, lane); if (m >= M) break;
                } }
        }
    }
    xcd_barrier(bar);

    {
        const int nc = G;
        pg8::Gemm g{H1, W1t, M, DIN, DM}; pg8::StaticOrder S; S.init(M, DIN, nc, bx);
        pg8::EpiIn E{Qb, Kb, Vb, U, out, g_q, g_k, NKs, NVs};
        pg8::gemm_phase<pg8::EpiIn, pg8::StaticOrder, true, true>(L + RING_OFF, g, S, E);
    }
    xcd_barrier(bar);

    {
        LAS unsigned char* vst = L + RING_OFF + wave * 16384;
        if (G == 256) { const int bh = vcu >> 2, p = vcu & 3;
            attn_block(Qb, Kb, Vb, MIX, L + RING_OFF, bh >> 3, bh & 7, p, tid); attn_block(Qb, Kb, Vb, MIX, L + RING_OFF, bh >> 3, bh & 7, 7 - p, tid); __syncthreads(); }
        for (int it = gw; it < 2048; it += NGW) conv_task(U, state_conv, conv_w, conv_b, ln_g, ln_b, MIX, out, (LAS float*)vst, it, lane);
    }
    xcd_barrier(bar);

    {
        pg8::Gemm g{MIX, W2t, MP, DM, DM}; pg8::StaticOrder S; S.init(MP, DM, G, bx);
        pg8::EpiOut E{x_p, x_s, X1b, SSQ};
        pg8::gemm_phase<pg8::EpiOut, pg8::StaticOrder, true, true>(L + RING_OFF, g, S, E);
    }
    xcd_barrier(bar);

#define P4_PROMPT() do { pg8::Gemm g{X1b, W3t, MP, 2 * DFF, DM}; pg8::StaticOrder S; S.init(MP, 2 * DFF, G, bx); pg8::EpiGateUp E{SSQ, HID, (LAS float*)(L + RSTAB_OFF), 0}; \
        pg8::gemm_phase<pg8::EpiGateUp, pg8::StaticOrder, true, true>(L + RING_OFF, g, S, E); } while (0)
#define STREAM_TASK() do { if (G == 256) { stream_fused(cache_k, cache_v, NKs, NVs, out, Qb, PART, L + RING_OFF, vcu >> 1, vcu & 1, tid); \
        if ((vcu & 1) == 0) conv_samp_wg(U, state_conv, conv_w, conv_b, ln_g, ln_b, MIX, out, (LAS float*)(L + RSTAB_OFF), vcu >> 1, wave, lane); } } while (0)
    if (vcu & 1) { P4_PROMPT(); __syncthreads(); STREAM_TASK(); }
    else         { STREAM_TASK(); __syncthreads(); P4_PROMPT(); }
#undef P4_PROMPT
#undef STREAM_TASK
    xcd_barrier(bar);

    for (int it = gw; it < 2 * MS; it += NGW) combine_task(PART, MIX, it >> 4, (it >> 1) & 7, it & 1, lane);
    xcd_barrier(bar);
    if (G == 256) small_gemm<0>(MIX + (size_t)MP * DM, DM, W2t, DM, vcu, (LAS float*)(L + RING_OFF), x_s, X1b, SSQ, out, tid);
    xcd_barrier(bar);
    {
        { pg8::Gemm g{X1b + (size_t)MP * DM, W3t, MS, 2 * DFF, DM}; pg8::StaticOrder S; S.init(MS, 2 * DFF, G, bx); pg8::EpiGateUp E{SSQ, HID, (LAS float*)(L + RSTAB_OFF), MP};
          pg8::gemm_phase<pg8::EpiGateUp, pg8::StaticOrder, true, true>(L + RING_OFF, g, S, E); }
        __syncthreads();
        { pg8::Gemm g{HID, W4t, MP, DM, DFF}; pg8::StaticOrder S; S.init(MP, DM, G, bx); pg8::EpiDown E{X1b, out};
          pg8::gemm_phase<pg8::EpiDown, pg8::StaticOrder, true, true>(L + RING_OFF, g, S, E); }
    }
    xcd_barrier(bar);
    if (G == 256) small_gemm<1>(HID + (size_t)MP * DFF, DFF, W4t, DFF, vcu, (LAS float*)(L + RING_OFF), x_s, X1b, SSQ, out, tid);
}

extern "C" void kernel_launch(void* const* d_in, const int* in_sizes, int n_in, void* d_out, int out_size, void* d_ws, size_t ws_size, hipStream_t stream) {
    static int grid = 0;
    if (grid == 0) {
        if (n_in != 18 || (size_t)out_size != O_END || ws_size < WS_END) { fprintf(stderr, "kernel_launch: unexpected shapes (n_in %d, out %d, ws %zu); nothing launched\n", n_in, out_size, ws_size); grid = -1; return; }
        int dev = 0, cus = 0, per_cu = 0;
        if (hipGetDevice(&dev) != hipSuccess || hipDeviceGetAttribute(&cus, hipDeviceAttributeMultiprocessorCount, dev) != hipSuccess) { grid = -1; return; }
        if (hipFuncSetAttribute((const void*)hymba_fwd, hipFuncAttributeMaxDynamicSharedMemorySize, LDS_BYTES) != hipSuccess) { fprintf(stderr, "kernel_launch: hipFuncSetAttribute failed\n"); grid = -1; return; }
        if (hipOccupancyMaxActiveBlocksPerMultiprocessor(&per_cu, (const void*)hymba_fwd, NWAVES * 64, LDS_BYTES) != hipSuccess || per_cu < 1)
            fprintf(stderr, "kernel_launch: note: occupancy query reports %d workgroups per CU\n", per_cu);
        (void)hipGetLastError();
        grid = cus;
        if (grid != 256) fprintf(stderr, "kernel_launch: built for a 256-CU device (MI355X); %d CUs found: the sample-group phases will not run\n", grid);
    }
    if (grid < 0) return;
    if (hipMemsetAsync((char*)d_ws + WS_CTL, 0, CTL_ZERO_BYTES, stream) != hipSuccess) return;
    Args a{};
    for (int i = 0; i < 18; ++i) a.in[i] = (const float*)d_in[i];
    a.out = (float*)d_out; a.ws = (unsigned char*)d_ws;
    hipLaunchKernelGGL(hymba_fwd, dim3(grid), dim3(NWAVES * 64), LDS_BYTES, stream, a);
}
```

```cpp
#include <hip/hip_runtime.h>
#include <cstdio>
#include <cstdint>
#include <cmath>
namespace pg8 {
#define PG8_LAS __attribute__((address_space(3)))
typedef unsigned short bf16_t;
typedef short bf16x8 __attribute__((ext_vector_type(8)));
typedef float f32x4 __attribute__((ext_vector_type(4)));
typedef unsigned u32x4 __attribute__((ext_vector_type(4)));
constexpr int BM = 256, BK = 64, HALF = 128, HTB = HALF * BK * 2  , STAGE_BYTES = 8 * HTB, NXCD = 8, WGM = 8;

__host__ __device__ __forceinline__ int lds_byte(int r, int c) { const int st = (r >> 4) * 2 + (c >> 5), rr = r & 15, cc = c & 31, ob = rr * 64 + cc * 2; return st * 1024 + (ob ^ (((ob >> 9) & 1) << 5)); }
__host__ __device__ __forceinline__ void stage_rc(int b, int& R, int& C) { const int st = b / 1024, sb = b % 1024, swz = sb ^ (((sb >> 9) & 1) << 5); R = (st >> 1) * 16 + swz / 64; C = (st & 1) * 32 + (swz % 64) / 2; }
__host__ __device__ __forceinline__ int perm32(int rho) { const int n = rho >> 4, i = rho & 15; return 8 * (i >> 2) + 4 * n + (i & 3); }

struct Unit { int pm, pn; };
struct Gemm { const bf16_t* A; const bf16_t* Bt; int M, N, K; };

struct StaticOrder {
    int nM, nN, nwg, G, c;
    __host__ __device__ void init(int M, int N, int G_, int c_) { nM = M / BM; nN = N / BM; nwg = nM * nN; G = G_; c = c_; }
    __host__ __device__ bool next(int i, Unit& u) const {
        const long L = (long)i * G + c; if (L >= nwg) return false;
        int wgid = (int)L; { const int q = nwg / NXCD, r = nwg % NXCD, xcd = wgid % NXCD, off = wgid / NXCD; wgid = (xcd < r ? xcd * (q + 1) : r * (q + 1) + (xcd - r) * q) + off; }
        const int nig = WGM * nN, gid = wgid / nig, fm = gid * WGM, gsz = (nM - fm) < WGM ? (nM - fm) : WGM;
        u.pm = fm + ((wgid % nig) % gsz); u.pn = (wgid % nig) / gsz; return true;
    }
    __device__ __forceinline__ void a_ready(const Unit&) const {}
    __device__ __forceinline__ void done(const Unit&) const {}
};

__device__ __forceinline__ unsigned cvt_pk_bf16(float lo, float hi) { unsigned r; asm volatile("v_cvt_pk_bf16_f32 %0, %1, %2" : "=v"(r) : "v"(lo), "v"(hi)); return r; }
constexpr int E_MP = 16384;
constexpr size_t EO_KP = 17825792, EO_VP = 26214400, EO_KS = 34725888, EO_VS = 168943616;
constexpr float E_C2 = 0.125f * 1.4426950408889634f;
__device__ __forceinline__ float xrow16_sum(float x) {
    auto s = __builtin_amdgcn_permlane16_swap(__float_as_uint(x), __float_as_uint(x), false, false);
    x = __uint_as_float(s[0]) + __uint_as_float(s[1]);
    auto t = __builtin_amdgcn_permlane32_swap(__float_as_uint(x), __float_as_uint(x), false, false);
    return __uint_as_float(t[0]) + __uint_as_float(t[1]);
}
__device__ __forceinline__ float xrow16_max(float x) {
    auto s = __builtin_amdgcn_permlane16_swap(__float_as_uint(x), __float_as_uint(x), false, false);
    x = fmaxf(__uint_as_float(s[0]), __uint_as_float(s[1]));
    auto t = __builtin_amdgcn_permlane32_swap(__float_as_uint(x), __float_as_uint(x), false, false);
    return fmaxf(__uint_as_float(t[0]), __uint_as_float(t[1]));
}
__device__ __forceinline__ float sigmoidf_fast(float g) { return __builtin_amdgcn_rcpf(1.f + __builtin_amdgcn_exp2f(-1.4426950408889634f * g)); }

struct EpiIn {
    static constexpr bool PERM = true, AFTER_DRAIN = false;
    bf16_t *Qb, *Kb, *Vb; float *U, *out; const float *gq, *gk; float *NKs, *NVs;
    __device__ __forceinline__ void init(f32x4 (&acc)[2][2][4][2], const Unit&, int, int, int, int) const {
#pragma unroll
        for (int a = 0; a < 2; ++a)
#pragma unroll
            for (int b = 0; b < 2; ++b)
#pragma unroll
                for (int m = 0; m < 4; ++m)
#pragma unroll
                    for (int n = 0; n < 2; ++n) acc[a][b][m][n] = (f32x4){0.f, 0.f, 0.f, 0.f};
    }
    template <int SEC, bool SAMP> __device__ __forceinline__ void qkv(const f32x4 (&acc)[2][2][4][2], const Unit& u, int wr, int wc, int fr, int fq) const {
        const int row0 = u.pm * BM + wr * 64 + fr;
        const int head = (u.pn & 1) * 4 + wc, cb = head * 64 + 8 * fq;
        f32x4 gv[2][2];
#pragma unroll
        for (int bj = 0; bj < 2; ++bj)
#pragma unroll
            for (int n = 0; n < 2; ++n) { gv[bj][n] = (f32x4){1.f, 1.f, 1.f, 1.f};
                if (SEC == 0) gv[bj][n] = *(const f32x4*)(gq + 32 * bj + 8 * fq + 4 * n) * E_C2;
                if (SEC == 1) gv[bj][n] = *(const f32x4*)(gk + 32 * bj + 8 * fq + 4 * n); }
#pragma unroll
        for (int ai = 0; ai < 2; ++ai)
#pragma unroll
            for (int m = 0; m < 4; ++m) { const int row = row0 + ai * HALF + m * 16;
                f32x4 v[2][2];
#pragma unroll
                for (int bj = 0; bj < 2; ++bj)
#pragma unroll
                    for (int n = 0; n < 2; ++n) v[bj][n] = acc[ai][bj][m][n];
                if (SEC < 2) { float ss = 0.f;
#pragma unroll
                    for (int bj = 0; bj < 2; ++bj)
#pragma unroll
                        for (int n = 0; n < 2; ++n) ss += (v[bj][n][0] * v[bj][n][0] + v[bj][n][1] * v[bj][n][1]) + (v[bj][n][2] * v[bj][n][2] + v[bj][n][3] * v[bj][n][3]);
                    ss = xrow16_sum(ss);
                    const float rinv = 1.0f / sqrtf(ss * (1.f / 64.f) + 1e-6f);
#pragma unroll
                    for (int bj = 0; bj < 2; ++bj)
#pragma unroll
                        for (int n = 0; n < 2; ++n) v[bj][n] = v[bj][n] * rinv * gv[bj][n]; }
                bf16_t* dstb = (SEC == 0 ? Qb : (SEC == 1 ? Kb : Vb)) + (size_t)row * 512 + cb;
#pragma unroll
                for (int bj = 0; bj < 2; ++bj) { u32x4 w; w.x = cvt_pk_bf16(v[bj][0][0], v[bj][0][1]); w.y = cvt_pk_bf16(v[bj][0][2], v[bj][0][3]); w.z = cvt_pk_bf16(v[bj][1][0], v[bj][1][1]); w.w = cvt_pk_bf16(v[bj][1][2], v[bj][1][3]);
                    *(u32x4*)(dstb + 32 * bj) = w; }
                if (SEC == 0) { asm volatile("" ::: "memory"); continue; }
                float* o;
                if (!SAMP) o = out + (SEC == 1 ? EO_KP : EO_VP) + (size_t)row * 512 + cb;
                else { const int ms = row - E_MP; o = out + (SEC == 1 ? EO_KS : EO_VS) + ((size_t)(ms >> 3) * 2048 + 2040 + (ms & 7)) * 512 + cb; }
#pragma unroll
                for (int bj = 0; bj < 2; ++bj)
#pragma unroll
                    for (int n = 0; n < 2; ++n) *(f32x4*)(o + 32 * bj + 4 * n) = v[bj][n];
                if (SEC != 0 && SAMP) { float* o2 = (SEC == 1 ? NKs : NVs) + (size_t)(row - E_MP) * 512 + cb;
#pragma unroll
                    for (int bj = 0; bj < 2; ++bj)
#pragma unroll
                        for (int n = 0; n < 2; ++n) *(f32x4*)(o2 + 32 * bj + 4 * n) = v[bj][n]; }
                asm volatile("" ::: "memory");
            }
    }
    __device__ __forceinline__ void operator()(const f32x4 (&acc)[2][2][4][2], const Unit& u, int wr, int wc, int fr, int fq) const {
        const bool samp = u.pm >= E_MP / BM; const int sec = u.pn >> 1;
        if (u.pn < 6) {
            if (sec == 0) { if (samp) qkv<0, true>(acc, u, wr, wc, fr, fq); else qkv<0, false>(acc, u, wr, wc, fr, fq); }
            else if (sec == 1) { if (samp) qkv<1, true>(acc, u, wr, wc, fr, fq); else qkv<1, false>(acc, u, wr, wc, fr, fq); }
            else { if (samp) qkv<2, true>(acc, u, wr, wc, fr, fq); else qkv<2, false>(acc, u, wr, wc, fr, fq); }
        } else {
            const int row0 = u.pm * BM + wr * 64 + fr, cb = 128 * (u.pn - 6) + 32 * wc + 8 * fq;
#pragma unroll
            for (int ai = 0; ai < 2; ++ai)
#pragma unroll
                for (int m = 0; m < 4; ++m) { float* o = U + (size_t)(row0 + ai * HALF + m * 16) * 512 + cb;
#pragma unroll
                    for (int n = 0; n < 2; ++n) { const f32x4 a = acc[ai][0][m][n], g = acc[ai][1][m][n]; f32x4 r;
#pragma unroll
                        for (int e = 0; e < 4; ++e) r[e] = a[e] * sigmoidf_fast(g[e]);
                        *(f32x4*)(o + 4 * n) = r; } }
        }
    }
};

struct EpiOut {
    static constexpr bool PERM = true, AFTER_DRAIN = false;
    const float *xp, *xs; bf16_t* X1b; float* ssq;
    __device__ __forceinline__ void init(f32x4 (&acc)[2][2][4][2], const Unit& u, int wr, int wc, int fr, int fq) const {
        const int row0 = u.pm * BM + wr * 64 + fr, col = u.pn * BM + 32 * wc + 8 * fq; const bool samp = u.pm >= E_MP / BM;
#pragma unroll
        for (int ai = 0; ai < 2; ++ai)
#pragma unroll
            for (int m = 0; m < 4; ++m) { const int row = row0 + ai * HALF + m * 16;
                const float* xr = (samp ? xs + (size_t)(row - E_MP) * 1024 : xp + (size_t)row * 1024) + col;
#pragma unroll
                for (int bj = 0; bj < 2; ++bj)
#pragma unroll
                    for (int n = 0; n < 2; ++n) acc[ai][bj][m][n] = *(const f32x4*)(xr + bj * HALF + 4 * n); }
    }
    __device__ __forceinline__ void operator()(const f32x4 (&acc)[2][2][4][2], const Unit& u, int wr, int wc, int fr, int fq) const {
        const int row0 = u.pm * BM + wr * 64 + fr, col = u.pn * BM + 32 * wc + 8 * fq;
#pragma unroll
        for (int ai = 0; ai < 2; ++ai)
#pragma unroll
            for (int m = 0; m < 4; ++m) { const int row = row0 + ai * HALF + m * 16;
                bf16_t* br = X1b + (size_t)row * 1024 + col; float ss = 0.f;
#pragma unroll
                for (int bj = 0; bj < 2; ++bj) { const f32x4 v0 = acc[ai][bj][m][0], v1 = acc[ai][bj][m][1];
                    u32x4 w; w.x = cvt_pk_bf16(v0[0], v0[1]); w.y = cvt_pk_bf16(v0[2], v0[3]); w.z = cvt_pk_bf16(v1[0], v1[1]); w.w = cvt_pk_bf16(v1[2], v1[3]);
                    *(u32x4*)(br + bj * HALF) = w;
                    ss += (v0[0] * v0[0] + v0[1] * v0[1]) + (v0[2] * v0[2] + v0[3] * v0[3]) + (v1[0] * v1[0] + v1[1] * v1[1]) + (v1[2] * v1[2] + v1[3] * v1[3]); }
                ss = xrow16_sum(ss);
                if (fq == 0) ssq[(size_t)row * 16 + u.pn * 4 + wc] = ss; }
    }
};

struct EpiGateUp {
    static constexpr bool PERM = true, AFTER_DRAIN = false;
    const float* ssq; bf16_t* HID; PG8_LAS float* rstab; int row_off;
    __device__ __forceinline__ void init(f32x4 (&acc)[2][2][4][2], const Unit&, int, int, int, int) const {
#pragma unroll
        for (int a = 0; a < 2; ++a)
#pragma unroll
            for (int b = 0; b < 2; ++b)
#pragma unroll
                for (int m = 0; m < 4; ++m)
#pragma unroll
                    for (int n = 0; n < 2; ++n) acc[a][b][m][n] = (f32x4){0.f, 0.f, 0.f, 0.f};
    }
    __device__ __forceinline__ void operator()(const f32x4 (&acc)[2][2][4][2], const Unit& u, int wr, int wc, int fr, int fq) const {
        const int row0 = row_off + u.pm * BM + wr * 64 + fr, col = u.pn * HALF + 32 * wc + 8 * fq, lane = fr + 16 * fq;
        PG8_LAS float* tab = rstab + (wr * 4 + wc) * 128;
#pragma unroll
        for (int k = 0; k < 2; ++k) { const int j = lane + 64 * k, row = row_off + u.pm * BM + (j >> 6) * HALF + wr * 64 + ((j >> 4) & 3) * 16 + (j & 15);
            const f32x4* sp = (const f32x4*)(ssq + (size_t)row * 16); const f32x4 s0 = sp[0], s1 = sp[1], s2 = sp[2], s3 = sp[3];
            const float tot = ((s0[0] + s0[1]) + (s0[2] + s0[3])) + ((s1[0] + s1[1]) + (s1[2] + s1[3])) + ((s2[0] + s2[1]) + (s2[2] + s2[3])) + ((s3[0] + s3[1]) + (s3[2] + s3[3]));
            tab[j] = 1.0f / sqrtf(tot * (1.f / 1024.f) + 1e-6f); }
        asm volatile("s_waitcnt lgkmcnt(0)" ::: "memory");
#pragma unroll
        for (int ai = 0; ai < 2; ++ai)
#pragma unroll
            for (int m = 0; m < 4; ++m) { const int row = row0 + ai * HALF + m * 16;
                const float rs = tab[(ai * 4 + m) * 16 + fr];
                float h[8];
#pragma unroll
                for (int n = 0; n < 2; ++n)
#pragma unroll
                    for (int e = 0; e < 4; ++e) { const float g = acc[ai][0][m][n][e] * rs, up = acc[ai][1][m][n][e] * rs; h[4 * n + e] = g * sigmoidf_fast(g) * up; }
                u32x4 w; w.x = cvt_pk_bf16(h[0], h[1]); w.y = cvt_pk_bf16(h[2], h[3]); w.z = cvt_pk_bf16(h[4], h[5]); w.w = cvt_pk_bf16(h[6], h[7]);
                *(u32x4*)(HID + (size_t)row * 2816 + col) = w; }
        asm volatile("s_waitcnt lgkmcnt(0)" ::: "memory");
    }
};

struct EpiDown {
    static constexpr bool PERM = true, AFTER_DRAIN = false;
    const bf16_t* x1; float* y;
    __device__ __forceinline__ void init(f32x4 (&acc)[2][2][4][2], const Unit& u, int wr, int wc, int fr, int fq) const {
        const int row0 = u.pm * BM + wr * 64 + fr, col = u.pn * BM + 32 * wc + 8 * fq;
#pragma unroll
        for (int ai = 0; ai < 2; ++ai)
#pragma unroll
            for (int m = 0; m < 4; ++m) { const bf16_t* xr = x1 + (size_t)(row0 + ai * HALF + m * 16) * 1024 + col;
#pragma unroll
                for (int bj = 0; bj < 2; ++bj) { const u32x4 w = *(const u32x4*)(xr + bj * HALF);
                    acc[ai][bj][m][0] = (f32x4){__uint_as_float(w.x << 16), __uint_as_float(w.x & 0xffff0000u), __uint_as_float(w.y << 16), __uint_as_float(w.y & 0xffff0000u)};
                    acc[ai][bj][m][1] = (f32x4){__uint_as_float(w.z << 16), __uint_as_float(w.z & 0xffff0000u), __uint_as_float(w.w << 16), __uint_as_float(w.w & 0xffff0000u)}; } }
    }
    __device__ __forceinline__ void operator()(const f32x4 (&acc)[2][2][4][2], const Unit& u, int wr, int wc, int fr, int fq) const {
        const int row0 = u.pm * BM + wr * 64 + fr, col = u.pn * BM + 32 * wc + 8 * fq;
#pragma unroll
        for (int ai = 0; ai < 2; ++ai)
#pragma unroll
            for (int m = 0; m < 4; ++m) { float* yr = y + (size_t)(row0 + ai * HALF + m * 16) * 1024 + col;
#pragma unroll
                for (int bj = 0; bj < 2; ++bj)
#pragma unroll
                    for (int n = 0; n < 2; ++n) *(f32x4*)(yr + bj * HALF + 4 * n) = acc[ai][bj][m][n]; }
    }
};

template <class Epi, class Sched, bool ALIGN_EPI = false, bool SP2 = false>
__device__ __forceinline__ void gemm_phase(PG8_LAS unsigned char* lds, const Gemm g, const Sched& S, const Epi& E) {
    int tid_ = threadIdx.x; asm volatile("" : "+v"(tid_));
    const int tid = tid_, wid = __builtin_amdgcn_readfirstlane(tid >> 6), lane = tid & 63, wr = wid >> 2, wc = wid & 3, fr = lane & 15, fq = lane >> 4;
    const int K = g.K, nt = K / BK;
    unsigned voffA[2], voffB[2];
#pragma unroll
    for (int i = 0; i < 2; ++i) { int R, C; stage_rc(tid * 16 + i * 8192, R, C); const int Rb = Epi::PERM ? ((R & ~31) + perm32(R & 31)) : R;
        voffA[i] = (unsigned)(R * K + C) * 2u; voffB[i] = (unsigned)(Rb * K + C) * 2u; }
    const size_t kstep = (size_t)(BK * 2);
    const size_t hstep = (size_t)HALF * K * 2;
    const size_t tstep = 2 * hstep;
    const unsigned ldsw = (unsigned)wid * 1024u;
    const int aoff = lds_byte(wr * 64 + fr, fq * 8), boff = lds_byte(wc * 32 + fr, fq * 8);
#define PG8_SA(b, h) (((b) * 2 + (h)) * HTB)
#define PG8_SB(b, h) ((4 + (b) * 2 + (h)) * HTB)
#define PG8_STAGE(bufoff, gbase, voff) do { _Pragma("unroll") for (int _i = 0; _i < 2; ++_i) \
        __builtin_amdgcn_global_load_lds((const unsigned*)((const char*)(gbase) + (voff)[_i]), (PG8_LAS unsigned*)(lds + (bufoff) + ldsw + _i * 8192), 16, 0, 0); } while (0)
#define PG8_LDA(dst, b, h) do { _Pragma("unroll") for (int m = 0; m < 4; ++m) _Pragma("unroll") for (int k = 0; k < 2; ++k) dst[m][k] = *(const PG8_LAS bf16x8*)(lds + PG8_SA(b, h) + aoff + m * 2048 + k * 1024); } while (0)
#define PG8_LDB(dst, b, h) do { _Pragma("unroll") for (int n = 0; n < 2; ++n) _Pragma("unroll") for (int k = 0; k < 2; ++k) dst[n][k] = *(const PG8_LAS bf16x8*)(lds + PG8_SB(b, h) + boff + n * 2048 + k * 1024); } while (0)
#define PG8_MMA(ai, bj, At, Bt) do { __builtin_amdgcn_s_setprio(1); _Pragma("unroll") for (int m = 0; m < 4; ++m) _Pragma("unroll") for (int n = 0; n < 2; ++n) _Pragma("unroll") for (int k = 0; k < 2; ++k) \
        acc[ai][bj][m][n] = __builtin_amdgcn_mfma_f32_16x16x32_bf16(Bt[n][k], At[m][k], acc[ai][bj][m][n], 0, 0, 0); __builtin_amdgcn_s_setprio(0); } while (0)
#define PG8_WAIT_V(n) asm volatile("s_waitcnt vmcnt(" #n ")" ::: "memory")
#define PG8_WAIT_L(n) asm volatile("s_waitcnt lgkmcnt(" #n ")" ::: "memory")
#define PG8_BAR __builtin_amdgcn_s_barrier()
#define PG8_SCHED __builtin_amdgcn_sched_barrier(0)
    Unit cur, nxt; int ui = 0;
    if (!S.next(0, cur)) return;
    f32x4 acc[2][2][4][2];
    E.init(acc, cur, wr, wc, fr, fq);
    bf16x8 At[4][2], B0[2][2], B1[2][2];
    const char* cA = (const char*)g.A + (size_t)cur.pm * tstep; const char* cB = (const char*)g.Bt + (size_t)cur.pn * tstep;
    S.a_ready(cur);
    if constexpr (SP2) {
        PG8_STAGE(PG8_SB(0, 0), cB, voffB); PG8_STAGE(PG8_SB(0, 1), cB + hstep, voffB); PG8_STAGE(PG8_SA(0, 0), cA, voffA); PG8_STAGE(PG8_SA(0, 1), cA + hstep, voffA);
        if (wr == 1) PG8_BAR;
        PG8_WAIT_V(2); PG8_BAR;
        PG8_STAGE(PG8_SB(1, 0), cB + kstep, voffB); PG8_STAGE(PG8_SA(1, 0), cA + kstep, voffA); PG8_STAGE(PG8_SB(1, 1), cB + hstep + kstep, voffB);
        PG8_WAIT_V(6); PG8_BAR;
    } else {
        PG8_STAGE(PG8_SB(0, 0), cB, voffB); PG8_STAGE(PG8_SA(0, 0), cA, voffA); PG8_STAGE(PG8_SB(0, 1), cB + hstep, voffB); PG8_STAGE(PG8_SA(0, 1), cA + hstep, voffA);
        if (wr == 1) PG8_BAR;
        PG8_WAIT_V(4); PG8_BAR;
        PG8_STAGE(PG8_SB(1, 0), cB + kstep, voffB); PG8_STAGE(PG8_SA(1, 0), cA + kstep, voffA); PG8_STAGE(PG8_SB(1, 1), cB + hstep + kstep, voffB);
        PG8_WAIT_V(6); PG8_BAR;
    }
    for (;;) {
        const bool has_next = S.next(ui + 1, nxt);
        const char* nA = has_next ? (const char*)g.A + (size_t)nxt.pm * tstep : cA; const char* nB = has_next ? (const char*)g.Bt + (size_t)nxt.pn * tstep : cB;
        for (int t = 0; t < nt; t += 2) {
            const bool last = (t == nt - 2);
            const char* a1 = cA + (size_t)(t + 1) * kstep;
            const char* a2 = last ? nA : cA + (size_t)(t + 2) * kstep; const char* b2 = last ? nB : cB + (size_t)(t + 2) * kstep;
            const char* a3 = a2 + kstep; const char* b3 = b2 + kstep;
            if (last && has_next) S.a_ready(nxt);
            if constexpr (SP2) {
            PG8_LDB(B0, 0, 0); PG8_LDB(B1, 0, 1); PG8_SCHED; PG8_LDA(At, 0, 0); PG8_STAGE(PG8_SA(1, 1), a1 + hstep, voffA);
            PG8_WAIT_V(8); PG8_WAIT_L(0); PG8_BAR; PG8_MMA(0, 0, At, B0); PG8_MMA(0, 1, At, B1); PG8_BAR; PG8_SCHED;
            PG8_LDA(At, 0, 1); PG8_STAGE(PG8_SB(0, 0), b2, voffB); PG8_STAGE(PG8_SB(0, 1), b2 + hstep, voffB); PG8_STAGE(PG8_SA(0, 0), a2, voffA);
            PG8_WAIT_V(8); PG8_WAIT_L(0); PG8_BAR; PG8_MMA(1, 0, At, B0); PG8_MMA(1, 1, At, B1); PG8_BAR; PG8_SCHED;
            PG8_LDB(B0, 1, 0); PG8_LDB(B1, 1, 1); PG8_SCHED; PG8_LDA(At, 1, 0); PG8_STAGE(PG8_SA(0, 1), a2 + hstep, voffA);
            PG8_WAIT_V(8); PG8_WAIT_L(0); PG8_BAR; PG8_MMA(0, 0, At, B0); PG8_MMA(0, 1, At, B1); PG8_BAR; PG8_SCHED;
            PG8_LDA(At, 1, 1); PG8_STAGE(PG8_SB(1, 0), b3, voffB); PG8_STAGE(PG8_SB(1, 1), b3 + hstep, voffB); PG8_STAGE(PG8_SA(1, 0), a3, voffA);
            PG8_WAIT_V(8); PG8_WAIT_L(0); PG8_BAR; PG8_MMA(1, 0, At, B0); PG8_MMA(1, 1, At, B1); PG8_BAR; PG8_SCHED;
            } else {
            PG8_LDB(B0, 0, 0); PG8_SCHED; PG8_LDA(At, 0, 0); PG8_STAGE(PG8_SA(1, 1), a1 + hstep, voffA);
            PG8_WAIT_L(8); PG8_BAR; PG8_WAIT_L(0); PG8_MMA(0, 0, At, B0); PG8_BAR; PG8_SCHED;
            PG8_LDB(B1, 0, 1); PG8_STAGE(PG8_SB(0, 0), b2, voffB);
            PG8_BAR; PG8_WAIT_L(0); PG8_MMA(0, 1, At, B1); PG8_BAR;
            PG8_LDA(At, 0, 1); PG8_STAGE(PG8_SA(0, 0), a2, voffA);
            PG8_BAR; PG8_WAIT_L(0); PG8_MMA(1, 0, At, B0); PG8_BAR; PG8_SCHED;
            PG8_STAGE(PG8_SB(0, 1), b2 + hstep, voffB);
            PG8_WAIT_V(6); PG8_BAR; PG8_MMA(1, 1, At, B1); PG8_BAR;
            PG8_LDB(B0, 1, 0); PG8_SCHED; PG8_LDA(At, 1, 0); PG8_STAGE(PG8_SA(0, 1), a2 + hstep, voffA);
            PG8_WAIT_L(8); PG8_BAR; PG8_WAIT_L(0); PG8_MMA(0, 0, At, B0); PG8_BAR; PG8_SCHED;
            PG8_LDB(B1, 1, 1); PG8_STAGE(PG8_SB(1, 0), b3, voffB);
            PG8_BAR; PG8_WAIT_L(0); PG8_MMA(0, 1, At, B1); PG8_BAR;
            PG8_LDA(At, 1, 1); PG8_STAGE(PG8_SA(1, 0), a3, voffA);
            PG8_BAR; PG8_WAIT_L(0); PG8_MMA(1, 0, At, B0); PG8_BAR; PG8_SCHED;
            PG8_STAGE(PG8_SB(1, 1), b3 + hstep, voffB);
            PG8_WAIT_V(6); PG8_BAR; PG8_MMA(1, 1, At, B1); PG8_BAR;
            }
        }
        if constexpr (ALIGN_EPI) { if (wr == 0) PG8_BAR; }
        if constexpr (!Epi::AFTER_DRAIN) { E(acc, cur, wr, wc, fr, fq); S.done(cur); }
        if (!has_next) break;
        E.init(acc, nxt, wr, wc, fr, fq);
        cur = nxt; cA = nA; cB = nB; ++ui;
        if constexpr (ALIGN_EPI) { if (wr == 1) PG8_BAR; }
    }
    PG8_WAIT_V(0);
    if constexpr (!ALIGN_EPI) { if (wr == 0) PG8_BAR; }
    PG8_BAR;
    if constexpr (Epi::AFTER_DRAIN) { E.fused(acc, cur, wr, wc, fr, fq, lds, wid, lane); S.done(cur); }
#undef PG8_SA
#undef PG8_SB
#undef PG8_STAGE
#undef PG8_LDA
#undef PG8_LDB
#undef PG8_MMA
#undef PG8_WAIT_V
#undef PG8_WAIT_L
#undef PG8_BAR
#undef PG8_SCHED
}
}

constexpr int NWAVES = 8;
constexpr int DM = 1024, NB = 8, SEQ = 2048, MP = NB * SEQ, NSMP = 128, TS = 8, MS = NSMP * TS, M = MP + MS;
constexpr int NH = 8, HD = 64, DA = 512, DC = 512, DIN = 2560, DFF = 2816, CW = 31, LBUF = 2048;
constexpr int NCH = 2;
constexpr int N_ATT = NB * NH * 8 * 16;
constexpr size_t O_YP = 0, O_KP = 17825792, O_VP = 26214400, O_CP = 34603008, O_KS = 34725888, O_VS = 168943616, O_CS = 303161344, O_END = 305127424;
static_assert(O_KP == pg8::EO_KP && O_VP == pg8::EO_VP && O_KS == pg8::EO_KS && O_VS == pg8::EO_VS, "output map");
constexpr size_t MiB = 1u << 20;
constexpr size_t WS_CTL = 0, CTL_ZERO_BYTES = 1 * MiB;
constexpr size_t WS_W1 = 2 * MiB, WS_W2 = 8 * MiB, WS_W3 = 10 * MiB, WS_W4 = 22 * MiB;
constexpr size_t WS_H1 = 32 * MiB;
constexpr size_t WS_QB = 66 * MiB, WS_KB = 84 * MiB, WS_VB = 102 * MiB;
constexpr size_t WS_U = 122 * MiB;
constexpr size_t WS_MIX = 156 * MiB;
constexpr size_t WS_X1B = 190 * MiB;
constexpr size_t WS_SSQ = 224 * MiB;
constexpr size_t WS_HID = 226 * MiB;
constexpr size_t WS_PART = 320 * MiB;
constexpr size_t WS_NKS = 432 * MiB, WS_NVS = 434 * MiB;
constexpr size_t WS_END = 436 * MiB;
static_assert(WS_W1 + (size_t)DIN * DM * 2 <= WS_W2 && WS_W2 + (size_t)DM * DM * 2 <= WS_W3 && WS_W3 + (size_t)2 * DFF * DM * 2 <= WS_W4 && WS_W4 + (size_t)DM * DFF * 2 <= WS_H1, "ws map 1");
static_assert(WS_H1 + (size_t)M * DM * 2 <= WS_QB && WS_QB + (size_t)M * 512 * 2 <= WS_KB && WS_KB + (size_t)M * 512 * 2 <= WS_VB && WS_VB + (size_t)M * 512 * 2 <= WS_U, "ws map 2");
static_assert(WS_VB + (size_t)M * 512 * 2 <= WS_U && WS_U + (size_t)M * 512 * 4 <= WS_MIX && WS_MIX + (size_t)M * DM * 2 <= WS_X1B && WS_X1B + (size_t)M * DM * 2 <= WS_SSQ, "ws map 3");
static_assert(WS_SSQ + (size_t)M * 16 * 4 <= WS_HID && WS_HID + (size_t)M * DFF * 2 <= WS_PART && WS_PART + (size_t)NSMP * NCH * 64 * 68 * 4 <= WS_NKS, "ws map 4");
constexpr int CW_P4S = 16384;
constexpr int CW_BAR = 4096;
constexpr int RING_OFF = 0, RING_BYTES = 131072;
constexpr int SCRATCH_BYTES = 152064;
constexpr int LDSCTL_OFF = SCRATCH_BYTES, MISC_OFF = LDSCTL_OFF + 320;
constexpr int RSTAB_OFF = LDSCTL_OFF + 1024;
constexpr int LDS_BYTES = 157696;
static_assert(MISC_OFF + 128 <= RSTAB_OFF && RSTAB_OFF + 4096 <= LDS_BYTES, "LDS map");

#define GAS __attribute__((address_space(1)))
#define LAS __attribute__((address_space(3)))
typedef unsigned short bf16;
typedef unsigned v4u __attribute__((ext_vector_type(4)));
typedef float f32x4 __attribute__((ext_vector_type(4)));
typedef short bf16x8 __attribute__((ext_vector_type(8)));
typedef GAS unsigned gu32;
typedef GAS unsigned long long gu64;
#define RLX_AGENT __ATOMIC_RELAXED, __HIP_MEMORY_SCOPE_AGENT
#define LDS_WAIT() asm volatile("s_waitcnt lgkmcnt(0)" ::: "memory")
#define VM_WAIT() asm volatile("s_waitcnt vmcnt(0)" ::: "memory")
__device__ __forceinline__ unsigned long long rt() { return __builtin_amdgcn_s_memrealtime(); }
__device__ __forceinline__ unsigned f2bf(float f) { unsigned u = __builtin_bit_cast(unsigned, f); return (u + 0x7fffu + ((u >> 16) & 1u)) >> 16; }
__device__ __forceinline__ unsigned pk2(float lo, float hi) { return f2bf(lo) | (f2bf(hi) << 16); }
#define XB_TMO      128
#define XB_XCNT(j)  (256  + 64 * (j))
#define XB_XSUB(j)  (1280 + 64 * (j))
#define XB_XGEN(j)  (2304 + 64 * (j))
#define XB_TOP      3328
#define XB_TOPGEN   3392
#define XCD_BAR_WORDS 3456
#define XB_SPIN_CAP (1u << 18)

__device__ __forceinline__ unsigned xb_ld(unsigned* p)              { return __hip_atomic_load(p, __ATOMIC_RELAXED, __HIP_MEMORY_SCOPE_AGENT); }
__device__ __forceinline__ unsigned xb_add(unsigned* p, unsigned v) { return __hip_atomic_fetch_add(p, v, __ATOMIC_RELAXED, __HIP_MEMORY_SCOPE_AGENT); }
__device__ __forceinline__ unsigned xb_xcc_id() { return (unsigned)__builtin_amdgcn_s_getreg((3 << 11) | 20) & 0xFu; }
#define XB_SPIN(cond, bar) do { unsigned _sp = 0; while (cond) { __builtin_amdgcn_s_sleep(1); \
    if ((++_sp & 255u) == 0u) { if (xb_ld(&(bar)[XB_TMO])) break; if (_sp > XB_SPIN_CAP) { atomicAdd(&(bar)[XB_TMO], 1u); break; } } } } while (0)

struct XcdBarrier {
    unsigned* bar; unsigned x;
    volatile LAS unsigned* st;
};

__device__ __forceinline__ XcdBarrier xcd_barrier_post(unsigned* bar, volatile LAS unsigned* st) {
    XcdBarrier b; b.bar = bar; b.x = xb_xcc_id(); b.st = st;
    if (threadIdx.x == 0) (void)xb_add(&bar[XB_XCNT(b.x)], 1u);
    return b;
}
__device__ __forceinline__ void xcd_barrier_complete(unsigned* bar, unsigned x, unsigned& nloc, unsigned& nx) {
    const unsigned G = gridDim.x * gridDim.y * gridDim.z;
    unsigned sum, cnt, mine, sp = 0u;
    for (;;) {
        sum = 0u; cnt = 0u; mine = 0u;
#pragma unroll
        for (unsigned j = 0; j < 16; ++j) { const unsigned c = xb_ld(&bar[XB_XCNT(j)]); sum += c; cnt += (c > 0u) ? 1u : 0u; mine = (j == x) ? c : mine; }
        if (sum == G) break;
        __builtin_amdgcn_s_sleep(1);
        if ((++sp & 255u) == 0u) { if (xb_ld(&bar[XB_TMO])) break; if (sp > XB_SPIN_CAP) { atomicAdd(&bar[XB_TMO], 1u); break; } }
    }
    nloc = mine > 0u ? mine : 1u; nx = cnt > 0u ? cnt : 1u;
}

__device__ __forceinline__ void xcd_barrier(const XcdBarrier& b) {
    asm volatile("s_waitcnt vmcnt(0)" ::: "memory");
    __syncthreads();
    if (threadIdx.x == 0) {
        unsigned* bar = b.bar;
        __builtin_amdgcn_s_waitcnt(0);
        unsigned nloc = b.st[0], nx = b.st[1];
        if (nloc == 0u) { xcd_barrier_complete(bar, b.x, nloc, nx); b.st[0] = nloc; b.st[1] = nx; }
        const unsigned old = xb_add(&bar[XB_XSUB(b.x)], 1u);
        const unsigned gen = old / nloc;
        if (old + 1u == (gen + 1u) * nloc) {
            __builtin_amdgcn_fence(__ATOMIC_RELEASE, "agent");
            asm volatile("s_waitcnt vmcnt(0)" ::: "memory");
            const unsigned og = xb_add(&bar[XB_TOP], 1u);
            const unsigned tg = og / nx;
            if (og + 1u == (tg + 1u) * nx) xb_add(&bar[XB_TOPGEN], 1u);
            else XB_SPIN(xb_ld(&bar[XB_TOPGEN]) == tg, bar);
            __builtin_amdgcn_fence(__ATOMIC_ACQUIRE, "agent");
            xb_add(&bar[XB_XGEN(b.x)], 1u);
            asm volatile("s_waitcnt vmcnt(0)" ::: "memory");
        } else {
            XB_SPIN(xb_ld(&bar[XB_XGEN(b.x)]) == gen, bar);
            __builtin_amdgcn_fence(__ATOMIC_ACQUIRE, "agent");
            asm volatile("s_waitcnt vmcnt(0)" ::: "memory");
        }
    }
    __syncthreads();
}

typedef short s16x4 __attribute__((ext_vector_type(4)));
typedef unsigned u32x2 __attribute__((ext_vector_type(2)));
__device__ __forceinline__ float wave_sum(float v) {
#pragma unroll
    for (int o = 1; o < 64; o <<= 1) v += __shfl_xor(v, o);
    return v;
}
template <int CTRL> __device__ __forceinline__ float dppf(float x) { return __builtin_bit_cast(float, __builtin_amdgcn_mov_dpp(__builtin_bit_cast(int, x), CTRL, 0xf, 0xf, true)); }
__device__ __forceinline__ float row16_sum(float x) {
    x += dppf<0xB1>(x); x += dppf<0x4E>(x); x += dppf<0x141>(x); x += dppf<0x128>(x); return x;
}
__device__ __forceinline__ float ex2(float x) { return __builtin_amdgcn_exp2f(x); }

template <int MAP> __device__ __forceinline__ int p0_dst_row(int n0) {
    if (MAP == 1) {
        if (n0 < 1536) { const int sec = n0 >> 9, hh = (n0 & 511) >> 6, d = n0 & 63; return 256 * (2 * sec + (hh >> 2)) + 128 * (d >> 5) + 32 * (hh & 3) + (d & 31); }
        if (n0 < 2048) { const int c = n0 - 1536; return 256 * (6 + (c >> 7)) + (c & 127); }
        const int c = n0 - 2048; return 256 * (6 + (c >> 7)) + 128 + (c & 127);
    }
    if (MAP == 2) return 256 * (n0 >> 7) + (n0 & 127);
    if (MAP == 3) return 256 * (n0 >> 7) + 128 + (n0 & 127);
    return n0;
}
template <int MAP> __device__ __forceinline__ void p0_item(const float* W, int K, int N, bf16* WT, const float* g, LAS float* scr, int item, int lane) {
    const int nblk = N / 64, kb = item / nblk, nb = item % nblk, k0 = 32 * kb, n0 = 64 * nb;
    f32x4 v[8];
#pragma unroll
    for (int i = 0; i < 8; ++i) v[i] = *(const f32x4*)(W + (size_t)(k0 + 4 * i + (lane >> 4)) * N + n0 + 4 * (lane & 15));
#pragma unroll
    for (int i = 0; i < 8; ++i) { const int kk = 4 * i + (lane >> 4); f32x4 w = v[i]; if (g) w = w * g[k0 + kk];
        LAS float* d = scr + kk * 65 + 4 * (lane & 15); d[0] = w.x; d[1] = w.y; d[2] = w.z; d[3] = w.w; }
    LDS_WAIT(); asm volatile("" ::: "memory");
#pragma unroll
    for (int j = 0; j < 4; ++j) { const int id = j * 64 + lane, n = id >> 2, c = id & 3; const LAS float* sp = scr + (8 * c) * 65 + n;
        v4u o; o.x = pk2(sp[0 * 65], sp[1 * 65]); o.y = pk2(sp[2 * 65], sp[3 * 65]); o.z = pk2(sp[4 * 65], sp[5 * 65]); o.w = pk2(sp[6 * 65], sp[7 * 65]);
        const int drow = p0_dst_row<MAP>(n0 + (n & 32)) + (n & 31);
        *(GAS v4u*)(WT + (size_t)drow * K + k0 + 8 * c) = o; }
    LDS_WAIT(); asm volatile("" ::: "memory");
}
struct P0D { const float* W; bf16* WT; const float* g; int K, N, map, k0, n0; };
__device__ __forceinline__ void p0_load(const P0D& d, f32x4 (&v)[8], int lane) {
#pragma unroll
    for (int i = 0; i < 8; ++i) v[i] = *(const f32x4*)(d.W + (size_t)(d.k0 + 4 * i + (lane >> 4)) * d.N + d.n0 + 4 * (lane & 15));
}
__device__ __forceinline__ void p0_store(const P0D& d, const f32x4 (&v)[8], LAS float* scr, int lane) {
#pragma unroll
    for (int i = 0; i < 8; ++i) { const int kk = 4 * i + (lane >> 4); f32x4 w = v[i]; if (d.g) w = w * d.g[d.k0 + kk];
        LAS float* q = scr + kk * 65 + 4 * (lane & 15); q[0] = w.x; q[1] = w.y; q[2] = w.z; q[3] = w.w; }
    LDS_WAIT(); asm volatile("" ::: "memory");
#pragma unroll
    for (int j = 0; j < 4; ++j) { const int id = j * 64 + lane, n = id >> 2, c = id & 3; const LAS float* sp = scr + (8 * c) * 65 + n;
        v4u o; o.x = pk2(sp[0 * 65], sp[1 * 65]); o.y = pk2(sp[2 * 65], sp[3 * 65]); o.z = pk2(sp[4 * 65], sp[5 * 65]); o.w = pk2(sp[6 * 65], sp[7 * 65]);
        const int nn = d.n0 + (n & 32);
        const int drow = (d.map == 1 ? p0_dst_row<1>(nn) : d.map == 2 ? p0_dst_row<2>(nn) : d.map == 3 ? p0_dst_row<3>(nn) : nn) + (n & 31);
        *(GAS v4u*)(d.WT + (size_t)drow * d.K + d.k0 + 8 * c) = o; }
    LDS_WAIT(); asm volatile("" ::: "memory");
}
__device__ __forceinline__ void rms_row_to_bf16(const float* xrow, const f32x4 (&gv)[4], bf16* orow, int lane) {
    const GAS f32x4* xr = (const GAS f32x4*)xrow + lane;
    f32x4 v[4]; float s = 0.f;
#pragma unroll
    for (int j = 0; j < 4; ++j) { v[j] = xr[64 * j]; s += (v[j].x * v[j].x + v[j].y * v[j].y) + (v[j].z * v[j].z + v[j].w * v[j].w); }
    const float rs = 1.f / sqrtf(wave_sum(s) * (1.f / 1024.f) + 1e-6f);
    GAS unsigned long long* o8 = (GAS unsigned long long*)orow + lane;
#pragma unroll
    for (int j = 0; j < 4; ++j) { const f32x4 y = v[j] * rs * gv[j]; o8[64 * j] = (unsigned long long)pk2(y.x, y.y) | ((unsigned long long)pk2(y.z, y.w) << 32); }
}

__device__ __forceinline__ void rms4_load(const float* x_p, const float* x_s, int m, int stride, int mfb, f32x4 (&v)[4][4], int lane) {
#pragma unroll
    for (int r = 0; r < 4; ++r) { int mr = m + r * stride; mr = mr < M ? mr : mfb;
        const GAS f32x4* p = (const GAS f32x4*)(mr < MP ? x_p + (size_t)mr * DM : x_s + (size_t)(mr - MP) * DM) + lane;
#pragma unroll
        for (int j = 0; j < 4; ++j) v[r][j] = p[64 * j]; }
}
__device__ __forceinline__ void rms4_finish(const f32x4 (&v)[4][4], int m, int stride, const f32x4 (&gv)[4], bf16* H1, int lane) {
#pragma unroll
    for (int r = 0; r < 4; ++r) { const int mr = m + r * stride; float sq = 0.f;
#pragma unroll
        for (int j = 0; j < 4; ++j) sq += (v[r][j].x * v[r][j].x + v[r][j].y * v[r][j].y) + (v[r][j].z * v[r][j].z + v[r][j].w * v[r][j].w);
        const float rs = 1.f / sqrtf(wave_sum(sq) * (1.f / 1024.f) + 1e-6f);
        if (mr < M) { GAS unsigned long long* q = (GAS unsigned long long*)(H1 + (size_t)mr * DM) + lane;
#pragma unroll
            for (int j = 0; j < 4; ++j) { const f32x4 y = v[r][j] * rs * gv[j]; q[64 * j] = (unsigned long long)pk2(y.x, y.y) | ((unsigned long long)pk2(y.z, y.w) << 32); } } }
}

__device__ __forceinline__ void rms_row2_to_bf16(const float* xa, const float* xb, const f32x4 (&gv)[4], bf16* oa, bf16* ob, int lane) {
    const GAS f32x4* pa = (const GAS f32x4*)xa + lane; const GAS f32x4* pb = (const GAS f32x4*)(xb ? xb : xa) + lane;
    f32x4 va[4], vb[4]; float sa = 0.f, sb = 0.f;
#pragma unroll
    for (int j = 0; j < 4; ++j) { va[j] = pa[64 * j]; vb[j] = pb[64 * j]; }
#pragma unroll
    for (int j = 0; j < 4; ++j) { sa += (va[j].x * va[j].x + va[j].y * va[j].y) + (va[j].z * va[j].z + va[j].w * va[j].w); sb += (vb[j].x * vb[j].x + vb[j].y * vb[j].y) + (vb[j].z * vb[j].z + vb[j].w * vb[j].w); }
    const float ra = 1.f / sqrtf(wave_sum(sa) * (1.f / 1024.f) + 1e-6f), rb = 1.f / sqrtf(wave_sum(sb) * (1.f / 1024.f) + 1e-6f);
    GAS unsigned long long* qa = (GAS unsigned long long*)oa + lane; GAS unsigned long long* qb = (GAS unsigned long long*)ob + lane;
#pragma unroll
    for (int j = 0; j < 4; ++j) { const f32x4 y = va[j] * ra * gv[j]; qa[64 * j] = (unsigned long long)pk2(y.x, y.y) | ((unsigned long long)pk2(y.z, y.w) << 32); }
    if (xb) {
#pragma unroll
        for (int j = 0; j < 4; ++j) { const f32x4 y = vb[j] * rb * gv[j]; qb[64 * j] = (unsigned long long)pk2(y.x, y.y) | ((unsigned long long)pk2(y.z, y.w) << 32); } }
}

__device__ __forceinline__ void combine_task(const float* __restrict__ PART, bf16* MIX, int n, int t, int hf, int lane) {
    const int head = hf * 4 + (lane >> 4);
    const float* p0 = PART + (((size_t)n * NCH * 8 + t) * 8 + head) * 68;
    float mc[NCH], lc[NCH]; f32x4 oc[NCH];
#pragma unroll
    for (int c = 0; c < NCH; ++c) { const float* pp = p0 + (size_t)c * 64 * 68; mc[c] = pp[64]; lc[c] = pp[65]; oc[c] = *(const f32x4*)(pp + 4 * (lane & 15)); }
    float mm = -1e30f;
#pragma unroll
    for (int c = 0; c < NCH; ++c) mm = fmaxf(mm, mc[c]);
    f32x4 num = (f32x4){0.f, 0.f, 0.f, 0.f}; float den = 0.f;
#pragma unroll
    for (int c = 0; c < NCH; ++c) { const float f = ex2(mc[c] - mm); den += f * lc[c]; num = num + oc[c] * f; }
    const float inv = 1.f / den;
    u32x2 w; w.x = pk2(num.x * inv, num.y * inv); w.y = pk2(num.z * inv, num.w * inv);
    *(u32x2*)(MIX + (size_t)(MP + n * 8 + t) * 1024 + head * 64 + 4 * (lane & 15)) = w;
}

__device__ __forceinline__ int at_kstart(int s, int tb, int r) { return s < 5 ? 16 * tb - 128 + 32 * s : (s < 11 ? 64 * tb + (r >> 2) - 128 + 32 * (s - 5) : 256 * tb + r - 128 + 32 * (s - 11)); }
__device__ __forceinline__ s16x4 vtr(const LAS unsigned char* p) { typedef short v4i16_t __attribute__((ext_vector_type(4))); return __builtin_bit_cast(s16x4, __builtin_amdgcn_ds_read_tr16_b64_v4i16((LAS v4i16_t*)p)); }
constexpr int AB_ROWS = 400, AB_PITCH = 144, AB_VIMG = AB_ROWS * AB_PITCH, AB_STG = 2 * AB_ROWS * AB_PITCH;
static_assert(AB_STG + 8 * 4608 <= SCRATCH_BYTES, "attention LDS map");
__device__ __forceinline__ void attn_tile_s(const bf16* __restrict__ Qb, const bf16* __restrict__ Kb, const bf16* __restrict__ Vb, bf16* MIX, const LAS unsigned char* kimg, const LAS unsigned char* vimg,
                                            LAS unsigned char* vst, int b, int h, int tb, int r, int lane) {
    asm volatile("" : "+v"(lane));
    const int fr = lane & 15, g = lane >> 4;
    const size_t rowbase = (size_t)b * SEQ;
    const bf16* qp = Qb + (rowbase + 256 * tb + r + 16 * fr) * 512 + h * 64 + 8 * g;
    bf16x8 qf[2]; qf[0] = *(const bf16x8*)qp; qf[1] = *(const bf16x8*)(qp + 32);
    f32x4 o[4];
#pragma unroll
    for (int c = 0; c < 4; ++c) o[c] = (f32x4){0.f, 0.f, 0.f, 0.f};
    float mrun = -1e30f, lsum = 0.f;
    const bf16* Kh = Kb + rowbase * 512 + h * 64; const bf16* Vh = Vb + rowbase * 512 + h * 64;
    const LAS unsigned char* trp = vst + (4 * g + (fr >> 2)) * 144 + 8 * (fr & 3);
    const int kb16 = 16 * tb - 128, kb4 = 64 * tb + (r >> 2) - 128, kb1 = 256 * tb + r - 128;
    const int m16 = kb16 < 0 ? ((-kb16) >> 5) : 0, m4 = kb4 < 0 ? ((-kb4) >> 5) : 0, m1 = kb1 < 0 ? ((-kb1) >> 5) : 0;
    const int n16 = 5 - m16, cntg = n16 + 6 - m4;
#define AT_SOF(J) ((J) < n16 ? m16 + (J) : ((J) < cntg ? 5 + m4 + ((J) - n16) : 23))
#define AT_SOFTMAX_PV(TRP) \
        float rm = -INFINITY; \
        _Pragma("unroll") for (int T = 0; T < 2; ++T) \
            _Pragma("unroll") for (int e = 0; e < 4; ++e) { if (hi_ < lo_ || (unsigned)(16 * T + e - lo_) > span_) st[T][e] = -INFINITY; rm = fmaxf(rm, st[T][e]); } \
        rm = pg8::xrow16_max(rm); \
        const float mn = fmaxf(mrun, rm), al = ex2(mrun - mn); mrun = mn; \
        float ps = 0.f; \
        _Pragma("unroll") for (int T = 0; T < 2; ++T) \
            _Pragma("unroll") for (int e = 0; e < 4; ++e) { st[T][e] = ex2(st[T][e] - mn); ps += st[T][e]; } \
        lsum = lsum * al + ps; \
        _Pragma("unroll") for (int c = 0; c < 4; ++c) o[c] = o[c] * al; \
        v4u pw; pw.x = pg8::cvt_pk_bf16(st[0][0], st[0][1]); pw.y = pg8::cvt_pk_bf16(st[0][2], st[0][3]); pw.z = pg8::cvt_pk_bf16(st[1][0], st[1][1]); pw.w = pg8::cvt_pk_bf16(st[1][2], st[1][3]); \
        const bf16x8 pb = __builtin_bit_cast(bf16x8, pw); \
        asm volatile("s_waitcnt lgkmcnt(0)" ::: "memory"); \
        _Pragma("unroll") for (int c = 0; c < 4; ++c) { const s16x4 lo = vtr((TRP) + 32 * c), hi = vtr((TRP) + 16 * 144 + 32 * c); \
            const bf16x8 va = (bf16x8){lo[0], lo[1], lo[2], lo[3], hi[0], hi[1], hi[2], hi[3]}; \
            o[c] = __builtin_amdgcn_mfma_f32_16x16x32_bf16(va, pb, o[c], 0, 0, 0); } \
        asm volatile("s_waitcnt lgkmcnt(0)" ::: "memory");
    bf16x8 kreg[2][2][2]; v4u vreg[2][4];
#define AT_LOAD(B, S) do { const int s_ = (S) < 11 ? (S) : 10; const int dsh_ = s_ < 5 ? 4 : 2, rd_ = s_ < 5 ? r : (r & 3), ks_ = at_kstart(s_, tb, r); \
        _Pragma("unroll") for (int T = 0; T < 2; ++T) { int pos = rd_ + ((ks_ + 16 * T + fr) << dsh_); pos = pos < 0 ? 0 : (pos > SEQ - 1 ? SEQ - 1 : pos); const bf16* kp = Kh + (size_t)pos * 512 + 8 * g; \
            kreg[B][T][0] = *(const bf16x8*)kp; kreg[B][T][1] = *(const bf16x8*)(kp + 32); } \
        _Pragma("unroll") for (int i = 0; i < 4; ++i) { const int ci = i * 64 + lane; int pos = rd_ + ((ks_ + (ci >> 3)) << dsh_); pos = pos < 0 ? 0 : (pos > SEQ - 1 ? SEQ - 1 : pos); \
            vreg[B][i] = *(const v4u*)(Vh + (size_t)pos * 512 + 8 * (ci & 7)); } } while (0)
#define AT_STEP(B, S, SN) do { const int sx = (S); const bool null_ = sx >= 11; const int s = null_ ? 10 : sx; \
        const int c0 = s < 5 ? 16 * tb : 64 * tb + (r >> 2), sqsh = s < 5 ? 0 : 2, ks = at_kstart(s, tb, r); \
        _Pragma("unroll") for (int i = 0; i < 4; ++i) { const int ci = i * 64 + lane; *(LAS v4u*)(vst + (ci >> 3) * 144 + (ci & 7) * 16) = vreg[B][i]; } \
        f32x4 st[2]; \
        _Pragma("unroll") for (int T = 0; T < 2; ++T) { st[T] = __builtin_amdgcn_mfma_f32_16x16x32_bf16(kreg[B][T][0], qf[0], (f32x4){0.f, 0.f, 0.f, 0.f}, 0, 0, 0); st[T] = __builtin_amdgcn_mfma_f32_16x16x32_bf16(kreg[B][T][1], qf[1], st[T], 0, 0, 0); } \
        AT_LOAD(B, (SN)); \
        const int hi_ = null_ ? -1 : c0 + (fr << sqsh) - ks - 4 * g;       \
        const int lo_ = null_ ? 0 : ((hi_ - 128) > (-ks - 4 * g) ? (hi_ - 128) : (-ks - 4 * g)); const unsigned span_ = (unsigned)(hi_ - lo_); \
        AT_SOFTMAX_PV(trp) } while (0)
    AT_LOAD(0, AT_SOF(0)); AT_LOAD(1, AT_SOF(1));
#pragma unroll 1
    for (int j = 0; j < cntg; j += 2) {
        AT_STEP(0, AT_SOF(j), AT_SOF(j + 2));
        AT_STEP(1, AT_SOF(j + 1), AT_SOF(j + 3));
    }
    const LAS unsigned char* kfp = kimg + (r + fr) * AB_PITCH + 16 * g;
    const LAS unsigned char* trv = vimg + (r + 4 * g + (fr >> 2)) * AB_PITCH + 8 * (fr & 3);
#pragma unroll 1
    for (int sl = m1; sl < 12; ++sl) {
        const int ks = kb1 + 32 * sl;
        f32x4 st[2];
#pragma unroll
        for (int T = 0; T < 2; ++T) { const LAS unsigned char* kp = kfp + (32 * sl + 16 * T) * AB_PITCH; const bf16x8 k0 = *(const LAS bf16x8*)kp, k1 = *(const LAS bf16x8*)(kp + 64);
            st[T] = __builtin_amdgcn_mfma_f32_16x16x32_bf16(k0, qf[0], (f32x4){0.f, 0.f, 0.f, 0.f}, 0, 0, 0); st[T] = __builtin_amdgcn_mfma_f32_16x16x32_bf16(k1, qf[1], st[T], 0, 0, 0); }
        const int hi_ = 256 * tb + r + (fr << 4) - ks - 4 * g;
        const int lo_ = (hi_ - 128) > (-ks - 4 * g) ? (hi_ - 128) : (-ks - 4 * g); const unsigned span_ = (unsigned)(hi_ - lo_);
        const LAS unsigned char* trl = trv + 32 * sl * AB_PITCH;
        AT_SOFTMAX_PV(trl)
    }
#undef AT_STEP
#undef AT_LOAD
#undef AT_SOFTMAX_PV
#undef AT_SOF
    lsum = pg8::xrow16_sum(lsum);
    const float inv = 1.f / lsum;
    bf16* op = MIX + (rowbase + 256 * tb + r + 16 * fr) * 1024 + h * 64 + 4 * g;
#pragma unroll
    for (int c = 0; c < 4; ++c) { u32x2 w; w.x = pg8::cvt_pk_bf16(o[c][0] * inv, o[c][1] * inv); w.y = pg8::cvt_pk_bf16(o[c][2] * inv, o[c][3] * inv); *(u32x2*)(op + 16 * c) = w; }
}
__device__ __forceinline__ void attn_block(const bf16* __restrict__ Qb, const bf16* __restrict__ Kb, const bf16* __restrict__ Vb, bf16* MIX, LAS unsigned char* lds, int b, int h, int tb, int tid) {
    const int lane = tid & 63, wv = __builtin_amdgcn_readfirstlane(tid >> 6);
    const bf16* Kh = Kb + (size_t)b * SEQ * 512 + h * 64; const bf16* Vh = Vb + (size_t)b * SEQ * 512 + h * 64;
    const int base = 256 * tb - 128;
    v4u kv[7], vv[7];
#pragma unroll
    for (int i = 0; i < 7; ++i) { const int c = i * 512 + tid; int row = c >> 3; row = row < AB_ROWS ? row : AB_ROWS - 1; int pos = base + row; pos = pos < 0 ? 0 : (pos > SEQ - 1 ? SEQ - 1 : pos);
        kv[i] = *(const v4u*)(Kh + (size_t)pos * 512 + 8 * (c & 7)); vv[i] = *(const v4u*)(Vh + (size_t)pos * 512 + 8 * (c & 7)); }
#pragma unroll
    for (int i = 0; i < 7; ++i) { const int c = i * 512 + tid, row = c >> 3;
        if (row < AB_ROWS) { *(LAS v4u*)(lds + row * AB_PITCH + (c & 7) * 16) = kv[i]; *(LAS v4u*)(lds + AB_VIMG + row * AB_PITCH + (c & 7) * 16) = vv[i]; } }
    asm volatile("s_waitcnt lgkmcnt(0)" ::: "memory"); __builtin_amdgcn_s_barrier(); asm volatile("" ::: "memory");
    attn_tile_s(Qb, Kb, Vb, MIX, lds, lds + AB_VIMG, lds + AB_STG + wv * 4608, b, h, tb, wv, lane);
    attn_tile_s(Qb, Kb, Vb, MIX, lds, lds + AB_VIMG, lds + AB_STG + wv * 4608, b, h, tb, wv + 8, lane);
    asm volatile("s_waitcnt lgkmcnt(0)" ::: "memory"); __builtin_amdgcn_s_barrier(); asm volatile("" ::: "memory");
}

constexpr int SF_STRIDE = 1040, SF_VIMG = 32 * SF_STRIDE;
__device__ __forceinline__ void stream_fused(const float* __restrict__ ck, const float* __restrict__ cv, const float* __restrict__ NKs, const float* __restrict__ NVs, float* out,
                                             const bf16* __restrict__ Qb, float* PART, LAS unsigned char* img, int n, int part, int tid) {
    asm volatile("" : "+v"(tid));
    const int lane = tid & 63, h = __builtin_amdgcn_readfirstlane(tid >> 6), fr = lane & 15, g = lane >> 4;
    const int rsub = __builtin_amdgcn_readfirstlane(tid >> 7), cc = tid & 127;
    bf16x8 qf[2]; qf[0] = (bf16x8){0, 0, 0, 0, 0, 0, 0, 0}; qf[1] = qf[0];
    if (fr < 8) { const bf16* qp = Qb + (size_t)(MP + n * 8 + fr) * 512 + h * 64 + 8 * g; qf[0] = *(const bf16x8*)qp; qf[1] = *(const bf16x8*)(qp + 32); }
    f32x4 o[4];
#pragma unroll
    for (int c = 0; c < 4; ++c) o[c] = (f32x4){0.f, 0.f, 0.f, 0.f};
    float mrun = -1e30f, lsum = 0.f;
    const bool isv = tid >= 256;
    const int rsub2 = __builtin_amdgcn_readfirstlane((tid >> 7) & 1);
    const float* sbase = (isv ? cv : ck) + (size_t)n * LBUF * 512 + 4 * cc; const float* nsb = (isv ? NVs : NKs) + (size_t)n * 8 * 512 + 4 * cc;
    float* obase = out + (isv ? O_VS : O_KS) + (size_t)n * LBUF * 512 + 4 * cc;
    const LAS unsigned char* kfp = img + fr * SF_STRIDE + h * 128 + 16 * g;
    const LAS unsigned char* trp = img + SF_VIMG + (4 * g + (fr >> 2)) * SF_STRIDE + h * 128 + 8 * (fr & 3);
    LAS unsigned char* wrp = img + (isv ? SF_VIMG : 0) + rsub2 * SF_STRIDE + cc * 8;
    const int b0 = part ? 32 : 0, b1 = part ? 66 : 32;
    f32x4 ra[16], rb[16];
#define SF_LOAD(R, BB) do { const int bb_ = (BB) < b1 ? (BB) : b1 - 1; \
        _Pragma("unroll") for (int i = 0; i < 16; ++i) { int a_ = 32 * bb_ + 2 * i + rsub2; a_ = a_ < LBUF + TS ? a_ : LBUF + TS - 1; const bool new_ = a_ >= LBUF; \
            const float* sp = new_ ? nsb + (size_t)(a_ - LBUF) * 512 : sbase + (size_t)a_ * 512; \
            R[i] = __builtin_nontemporal_load((const f32x4*)sp); } } while (0)
#define SF_CONSUME(R, BB) do { const int bb_ = (BB); \
        _Pragma("unroll") for (int i = 0; i < 16; ++i) { const int a_ = 32 * bb_ + 2 * i + rsub2; \
            if (a_ >= 8 && a_ < LBUF) __builtin_nontemporal_store(R[i], (f32x4*)(obase + (size_t)(a_ - 8) * 512)); \
            u32x2 wk; wk.x = pg8::cvt_pk_bf16(R[i].x, R[i].y); wk.y = pg8::cvt_pk_bf16(R[i].z, R[i].w); \
            *(LAS u32x2*)(wrp + 2 * i * SF_STRIDE) = wk; } } while (0)
#define SF_BAR() do { asm volatile("s_waitcnt lgkmcnt(0)" ::: "memory"); __builtin_amdgcn_s_barrier(); asm volatile("" ::: "memory"); } while (0)
#define SF_STEP(BB) do { const int bq_ = (BB); \
        f32x4 st[2]; \
        _Pragma("unroll") for (int T = 0; T < 2; ++T) { const bf16x8 k0 = *(const LAS bf16x8*)(kfp + T * 16 * SF_STRIDE), k1 = *(const LAS bf16x8*)(kfp + T * 16 * SF_STRIDE + 64); \
            st[T] = __builtin_amdgcn_mfma_f32_16x16x32_bf16(k0, qf[0], (f32x4){0.f, 0.f, 0.f, 0.f}, 0, 0, 0); st[T] = __builtin_amdgcn_mfma_f32_16x16x32_bf16(k1, qf[1], st[T], 0, 0, 0); } \
        float wgt[2][4]; float rm = -INFINITY; \
        _Pragma("unroll") for (int T = 0; T < 2; ++T) \
            _Pragma("unroll") for (int e = 0; e < 4; ++e) { const int dist = LBUF + fr - (32 * bq_ + 16 * T + 4 * g + e); \
                int w_ = (dist <= 128 ? 1 : 0) + (((dist & 3) == 0 && dist <= 512) ? 1 : 0) + (((dist & 15) == 0 && dist <= 2048) ? 1 : 0); \
                if (dist < 0 || fr >= 8) w_ = 0; \
                wgt[T][e] = (float)w_; if (w_ == 0) st[T][e] = -INFINITY; rm = fmaxf(rm, st[T][e]); } \
        rm = pg8::xrow16_max(rm); \
        const float mn = fmaxf(mrun, rm), al = ex2(mrun - mn); mrun = mn; \
        float ps = 0.f; \
        _Pragma("unroll") for (int T = 0; T < 2; ++T) \
            _Pragma("unroll") for (int e = 0; e < 4; ++e) { st[T][e] = wgt[T][e] * ex2(st[T][e] - mn); ps += st[T][e]; } \
        lsum = lsum * al + ps; \
        _Pragma("unroll") for (int c = 0; c < 4; ++c) o[c] = o[c] * al; \
        v4u pw; pw.x = pg8::cvt_pk_bf16(st[0][0], st[0][1]); pw.y = pg8::cvt_pk_bf16(st[0][2], st[0][3]); pw.z = pg8::cvt_pk_bf16(st[1][0], st[1][1]); pw.w = pg8::cvt_pk_bf16(st[1][2], st[1][3]); \
        const bf16x8 pb = __builtin_bit_cast(bf16x8, pw); \
        _Pragma("unroll") for (int c = 0; c < 4; ++c) { const s16x4 lo = vtr(trp + 32 * c), hi = vtr(trp + 16 * SF_STRIDE + 32 * c); \
            const bf16x8 va = (bf16x8){lo[0], lo[1], lo[2], lo[3], hi[0], hi[1], hi[2], hi[3]}; \
            o[c] = __builtin_amdgcn_mfma_f32_16x16x32_bf16(va, pb, o[c], 0, 0, 0); } } while (0)
    SF_LOAD(ra, b0); SF_LOAD(rb, b0 + 1);
#pragma unroll 1
    for (int b = b0; b < b1; b += 2) {
        SF_CONSUME(ra, b); SF_LOAD(ra, b + 2); SF_BAR(); SF_STEP(b); SF_BAR();
        SF_CONSUME(rb, b + 1); SF_LOAD(rb, b + 3); SF_BAR(); SF_STEP(b + 1); SF_BAR();
    }
#undef SF_LOAD
#undef SF_CONSUME
#undef SF_STEP
#undef SF_BAR
    lsum = pg8::xrow16_sum(lsum);
    if (fr < 8) { float* pp = PART + ((((size_t)n * NCH + part) * 8 + fr) * 8 + h) * 68;
#pragma unroll
        for (int c = 0; c < 4; ++c) *(f32x4*)(pp + 16 * c + 4 * g) = o[c];
        if (g == 0) { pp[64] = mrun; pp[65] = lsum; } }
}

__device__ __forceinline__ void conv_task(const float* __restrict__ U, const float* __restrict__ state, const float* __restrict__ cw, const float* __restrict__ cb, const float* __restrict__ lng, const float* __restrict__ lnb,
                                          bf16* MIX, float* out, LAS float* cl, int task, int lane) {
    asm volatile("" : "+v"(lane));
    const bool samp = task >= 2048; const int n = task - 2048, b = task >> 8, t0 = (task & 255) * 8;
    const size_t row0 = samp ? (size_t)MP + (size_t)n * 8 : (size_t)b * SEQ + t0;
    float sum[8];
#pragma unroll
    for (int t = 0; t < 8; ++t) sum[t] = 0.f;
#define CONV_LOAD(WIN, CG) do { const int ch_ = 64 * (CG) + lane; \
        if (samp) { \
            _Pragma("unroll") for (int j = 0; j < 30; ++j) WIN[j] = state[((size_t)n * 30 + j) * 512 + ch_]; \
            _Pragma("unroll") for (int j = 30; j < 38; ++j) WIN[j] = U[(row0 + (j - 30)) * 512 + ch_]; \
        } else { \
            _Pragma("unroll") for (int j = 0; j < 38; ++j) { const int tt = t0 - 30 + j; const float v = U[((size_t)b * SEQ + (tt < 0 ? 0 : tt)) * 512 + ch_]; WIN[j] = (tt >= 0) ? v : 0.f; } \
        } \
        } while (0)
    float win[38];
    CONV_LOAD(win, 0);
#pragma unroll 1
    for (int cg = 0; cg < 8; ++cg) { const int ch = 64 * cg + lane;
        float wv[31];
#pragma unroll
        for (int j = 0; j < 31; ++j) wv[j] = cw[j * 512 + ch];
        const float bias = cb[ch];
        float winn[38];
        CONV_LOAD(winn, (cg < 7 ? cg + 1 : 7));
#pragma unroll
        for (int t = 0; t < 8; ++t) { float a = bias;
#pragma unroll
            for (int j = 0; j < 31; ++j) a += wv[j] * win[t + j];
            cl[t * 512 + ch] = a; sum[t] += a; }
        if (samp) {
#pragma unroll
            for (int i = 0; i < 30; ++i) out[O_CS + ((size_t)n * 30 + i) * 512 + ch] = win[8 + i];
        } else if (t0 >= 2016) {
#pragma unroll
            for (int j = 30; j < 38; ++j) { const int tt = t0 - 30 + j; if (tt >= 2018) out[O_CP + ((size_t)b * 30 + (tt - 2018)) * 512 + ch] = win[j]; }
        }
#pragma unroll
        for (int j = 0; j < 38; ++j) win[j] = winn[j];
    }
#undef CONV_LOAD
    LDS_WAIT(); asm volatile("" ::: "memory");
    float mean[8], rstd[8], s2[8];
#pragma unroll
    for (int t = 0; t < 8; ++t) { mean[t] = wave_sum(sum[t]) * (1.f / 512.f); s2[t] = 0.f; }
#pragma unroll 1
    for (int cg = 0; cg < 8; ++cg) { const int ch = 64 * cg + lane;
#pragma unroll
        for (int t = 0; t < 8; ++t) { const float d = cl[t * 512 + ch] - mean[t]; s2[t] += d * d; } }
#pragma unroll
    for (int t = 0; t < 8; ++t) rstd[t] = 1.f / sqrtf(wave_sum(s2[t]) * (1.f / 512.f) + 1e-5f);
#pragma unroll 1
    for (int cg = 0; cg < 8; ++cg) { const int ch = 64 * cg + lane; const float gg = lng[ch], bb = lnb[ch];
#pragma unroll
        for (int t = 0; t < 8; ++t) { const float y = (cl[t * 512 + ch] - mean[t]) * rstd[t] * gg + bb; const float sw = y * pg8::sigmoidf_fast(y);
            MIX[(row0 + t) * 1024 + 512 + ch] = (bf16)f2bf(sw); } }
    LDS_WAIT(); asm volatile("" ::: "memory");
}

__device__ __forceinline__ void conv_samp_wg(const float* __restrict__ U, const float* __restrict__ state, const float* __restrict__ cw, const float* __restrict__ cb, const float* __restrict__ lng, const float* __restrict__ lnb,
                                             bf16* MIX, float* out, LAS float* red, int n, int wave, int lane) {
    asm volatile("" : "+v"(lane));
    const int ch = 64 * wave + lane; const size_t row0 = (size_t)MP + (size_t)n * 8;
    float win[38], wv[31];
#pragma unroll
    for (int j = 0; j < 30; ++j) win[j] = state[((size_t)n * 30 + j) * 512 + ch];
#pragma unroll
    for (int j = 30; j < 38; ++j) win[j] = U[(row0 + (j - 30)) * 512 + ch];
#pragma unroll
    for (int j = 0; j < 31; ++j) wv[j] = cw[j * 512 + ch];
    const float bias = cb[ch], gg = lng[ch], bb = lnb[ch];
    float a[8];
#pragma unroll
    for (int t = 0; t < 8; ++t) { float acc = bias;
#pragma unroll
        for (int j = 0; j < 31; ++j) acc += wv[j] * win[t + j];
        a[t] = acc; }
#pragma unroll
    for (int i = 0; i < 30; ++i) out[O_CS + ((size_t)n * 30 + i) * 512 + ch] = win[8 + i];
#pragma unroll
    for (int t = 0; t < 8; ++t) { const float sq = wave_sum(a[t]); if (lane == 0) red[wave * 8 + t] = sq; }
    __syncthreads();
#pragma unroll
    for (int t = 0; t < 8; ++t) { float sq = 0.f;
#pragma unroll
        for (int w = 0; w < 8; ++w) sq += red[w * 8 + t];
        a[t] -= sq * (1.f / 512.f);
        const float s2 = wave_sum(a[t] * a[t]); if (lane == 0) red[64 + wave * 8 + t] = s2; }
    __syncthreads();
#pragma unroll
    for (int t = 0; t < 8; ++t) { float s2 = 0.f;
#pragma unroll
        for (int w = 0; w < 8; ++w) s2 += red[64 + w * 8 + t];
        const float y = a[t] * (1.f / sqrtf(s2 * (1.f / 512.f) + 1e-5f)) * gg + bb; const float sw = y * pg8::sigmoidf_fast(y);
        MIX[(row0 + t) * 1024 + 512 + ch] = (bf16)f2bf(sw); }
    __syncthreads();
}

template <int MODE> __device__ __forceinline__ void small_gemm(const bf16* __restrict__ A, int lda, const bf16* __restrict__ Bt, int K, int tile, LAS float* red,
                                                               const float* __restrict__ xs, bf16* X1b, float* SSQ, float* y, int tid) {
    asm volatile("" : "+v"(tid));
    const int lane = tid & 63, wv = __builtin_amdgcn_readfirstlane(tid >> 6), fr = lane & 15, g = lane >> 4;
    const int tm = tile >> 4, tn = tile & 15, kw = K / 8, nst = kw / 32;
    f32x4 acc[4][4];
#pragma unroll
    for (int i = 0; i < 4; ++i)
#pragma unroll
        for (int j = 0; j < 4; ++j) acc[i][j] = (f32x4){0.f, 0.f, 0.f, 0.f};
    const bf16* ap = A + (size_t)(tm * 64 + fr) * lda + wv * kw + 8 * g;
    const bf16* bp = Bt + (size_t)(tn * 64 + fr) * K + wv * kw + 8 * g;
    bf16x8 a0[4], b0[4];
#pragma unroll
    for (int i = 0; i < 4; ++i) { a0[i] = *(const bf16x8*)(ap + (size_t)i * 16 * lda); b0[i] = *(const bf16x8*)(bp + (size_t)i * 16 * K); }
#pragma unroll 1
    for (int st = 0; st < nst; ++st) {
        bf16x8 a1[4], b1[4]; const int sn = (st + 1 < nst) ? st + 1 : st;
#pragma unroll
        for (int i = 0; i < 4; ++i) { a1[i] = *(const bf16x8*)(ap + (size_t)i * 16 * lda + 32 * sn); b1[i] = *(const bf16x8*)(bp + (size_t)i * 16 * K + 32 * sn); }
#pragma unroll
        for (int i = 0; i < 4; ++i)
#pragma unroll
            for (int j = 0; j < 4; ++j) acc[i][j] = __builtin_amdgcn_mfma_f32_16x16x32_bf16(a0[i], b0[j], acc[i][j], 0, 0, 0);
#pragma unroll
        for (int i = 0; i < 4; ++i) { a0[i] = a1[i]; b0[i] = b1[i]; }
    }
    LAS float* rw = red + wv * 4096;
#pragma unroll
    for (int i = 0; i < 4; ++i)
#pragma unroll
        for (int j = 0; j < 4; ++j)
#pragma unroll
            for (int e = 0; e < 4; ++e) rw[(16 * i + 4 * g + e) * 64 + 16 * j + fr] = acc[i][j][e];
    __syncthreads();
    const int row = tid >> 3, c0 = (tid & 7) * 8;
    f32x4 s0 = (f32x4){0.f, 0.f, 0.f, 0.f}, s1 = s0;
#pragma unroll
    for (int w = 0; w < 8; ++w) { const LAS float* rp = red + w * 4096 + row * 64 + c0; s0 = s0 + *(const LAS f32x4*)rp; s1 = s1 + *(const LAS f32x4*)(rp + 4); }
    const size_t grow = (size_t)MP + tm * 64 + row; const int col = tn * 64 + c0;
    if (MODE == 0) {
        const float* xr = xs + (size_t)(tm * 64 + row) * 1024 + col;
        const f32x4 v0 = s0 + *(const f32x4*)xr, v1 = s1 + *(const f32x4*)(xr + 4);
        v4u w; w.x = pg8::cvt_pk_bf16(v0[0], v0[1]); w.y = pg8::cvt_pk_bf16(v0[2], v0[3]); w.z = pg8::cvt_pk_bf16(v1[0], v1[1]); w.w = pg8::cvt_pk_bf16(v1[2], v1[3]);
        *(v4u*)(X1b + grow * 1024 + col) = w;
        float ss = (v0[0] * v0[0] + v0[1] * v0[1]) + (v0[2] * v0[2] + v0[3] * v0[3]) + (v1[0] * v1[0] + v1[1] * v1[1]) + (v1[2] * v1[2] + v1[3] * v1[3]);
        ss += dppf<0xB1>(ss); ss += dppf<0x4E>(ss); ss += dppf<0x141>(ss);
        if ((tid & 7) == 0) SSQ[grow * 16 + tn] = ss;
    } else {
        const v4u w = *(const v4u*)(X1b + grow * 1024 + col);
        const f32x4 r0 = (f32x4){__uint_as_float(w.x << 16), __uint_as_float(w.x & 0xffff0000u), __uint_as_float(w.y << 16), __uint_as_float(w.y & 0xffff0000u)};
        const f32x4 r1 = (f32x4){__uint_as_float(w.z << 16), __uint_as_float(w.z & 0xffff0000u), __uint_as_float(w.w << 16), __uint_as_float(w.w & 0xffff0000u)};
        *(f32x4*)(y + grow * 1024 + col) = s0 + r0; *(f32x4*)(y + grow * 1024 + col + 4) = s1 + r1;
    }
    __syncthreads();
}

struct Args { const float* in[18]; float* out; unsigned char* ws; };
__global__ void __launch_bounds__(NWAVES * 64, 2) hymba_fwd(Args args) {
    extern __shared__ __attribute__((aligned(16))) unsigned char lds[];
    LAS unsigned char* L = (LAS unsigned char*)lds;
    volatile LAS unsigned* MISC = (volatile LAS unsigned*)(L + MISC_OFF);
    const int tid = threadIdx.x, lane = tid & 63, wave = __builtin_amdgcn_readfirstlane(tid >> 6);
    const int G = gridDim.x; const int bx = blockIdx.x; const int vcu = (G % 8 == 0) ? (bx % 8) * (G / 8) + bx / 8 : bx;
    unsigned char* ws = args.ws; float* out = args.out;
    gu32* ctl = (gu32*)(ws + WS_CTL);
    const float* x_p = args.in[0]; const float* x_s = args.in[1]; const float* cache_k = args.in[2]; const float* cache_v = args.in[3]; const float* state_conv = args.in[4];
    const float* g_attn = args.in[5]; const float* w_in = args.in[6]; const float* g_q = args.in[7]; const float* g_k = args.in[8]; const float* conv_w = args.in[9]; const float* conv_b = args.in[10];
    const float* ln_g = args.in[11]; const float* ln_b = args.in[12]; const float* w_out = args.in[13]; const float* g_ffn = args.in[14]; const float* w_gate = args.in[15]; const float* w_up = args.in[16]; const float* w_down = args.in[17];
    bf16* W1t = (bf16*)(ws + WS_W1); bf16* W2t = (bf16*)(ws + WS_W2); bf16* W3t = (bf16*)(ws + WS_W3); bf16* W4t = (bf16*)(ws + WS_W4);
    bf16* H1 = (bf16*)(ws + WS_H1); bf16* Qb = (bf16*)(ws + WS_QB); bf16* Kb = (bf16*)(ws + WS_KB); bf16* Vb = (bf16*)(ws + WS_VB);
    float* U = (float*)(ws + WS_U); bf16* MIX = (bf16*)(ws + WS_MIX); bf16* X1b = (bf16*)(ws + WS_X1B); float* SSQ = (float*)(ws + WS_SSQ);
    bf16* HID = (bf16*)(ws + WS_HID); float* PART = (float*)(ws + WS_PART); float* NKs = (float*)(ws + WS_NKS); float* NVs = (float*)(ws + WS_NVS);

    for (int u = tid; u < (LDS_BYTES - LDSCTL_OFF) / 4; u += NWAVES * 64) ((LAS unsigned*)(L + LDSCTL_OFF))[u] = 0u;
    __syncthreads();
    XcdBarrier bar = xcd_barrier_post((unsigned*)(ctl + CW_BAR), MISC + 8);
    const int gw = vcu * NWAVES + wave, NGW = G * NWAVES;

    {
        LAS float* scr = (LAS float*)(L + RING_OFF + wave * 16384);
        constexpr int I_1 = (DM / 32) * (DIN / 64), I_2 = (DM / 32) * (DM / 64), I_3 = (DM / 32) * (DFF / 64), I_4 = (DFF / 32) * (DM / 64);
        constexpr int NITEMS = I_1 + I_2 + 2 * I_3 + I_4;
        auto dec = [&](int it) -> P0D { P0D d; int r = it;
            if (r < I_1) { d.W = w_in; d.WT = W1t; d.g = nullptr; d.K = DM; d.N = DIN; d.map = 1; }
            else if ((r -= I_1) < I_2) { d.W = w_out; d.WT = W2t; d.g = nullptr; d.K = DM; d.N = DM; d.map = 0; }
            else if ((r -= I_2) < I_3) { d.W = w_gate; d.WT = W3t; d.g = g_ffn; d.K = DM; d.N = DFF; d.map = 2; }
            else if ((r -= I_3) < I_3) { d.W = w_up; d.WT = W3t; d.g = g_ffn; d.K = DM; d.N = DFF; d.map = 3; }
            else { r -= I_3; d.W = w_down; d.WT = W4t; d.g = nullptr; d.K = DFF; d.N = DM; d.map = 0; }
            const int nblk = d.N / 64; d.k0 = 32 * (r / nblk); d.n0 = 64 * (r % nblk); return d; };
        for (int it = gw; it < NITEMS; it += 3 * NGW) {
            const int it2 = it + NGW, it3 = it + 2 * NGW; const bool has2 = it2 < NITEMS, has3 = it3 < NITEMS;
            const P0D da = dec(it), db = dec(has2 ? it2 : it), dc = dec(has3 ? it3 : it);
            f32x4 va[8], vb[8], vc[8];
            p0_load(da, va, lane); p0_load(db, vb, lane); p0_load(dc, vc, lane);
            p0_store(da, va, scr, lane);
            if (has2) p0_store(db, vb, scr, lane);
            if (has3) p0_store(dc, vc, scr, lane);
        }
        f32x4 gv[4];
#pragma unroll
        for (int j = 0; j < 4; ++j) gv[j] = *((const f32x4*)g_attn + lane + 64 * j);
        {
            f32x4 ra[4][4], rb[4][4]; int m = gw;
            if (m < M) { rms4_load(x_p, x_s, m, NGW, gw, ra, lane);
                for (;;) {
                    const int mb = m + 4 * NGW; rms4_load(x_p, x_s, mb, NGW, gw, rb, lane); rms4_finish(ra, m, NGW, gv, H1, lane); if (mb >= M) break;
                    m = mb + 4 * NGW;           rms4_load(x_p, x_s, m, NGW, gw, ra, lane);  rms4_finish(rb, mb, NGW, gv, H1, lane); if (m >= M) break;
                } }
        }
    }
    xcd_barrier(bar);

    {
        const int nc = G;
        pg8::Gemm g{H1, W1t, M, DIN, DM}; pg8::StaticOrder S; S.init(M, DIN, nc, bx);
        pg8::EpiIn E{Qb, Kb, Vb, U, out, g_q, g_k, NKs, NVs};
        pg8::gemm_phase<pg8::EpiIn, pg8::StaticOrder, true, true>(L + RING_OFF, g, S, E);
    }
    xcd_barrier(bar);

    {
        LAS unsigned char* vst = L + RING_OFF + wave * 16384;
        if (G == 256) { const int bh = vcu >> 2, p = vcu & 3;
            attn_block(Qb, Kb, Vb, MIX, L + RING_OFF, bh >> 3, bh & 7, p, tid); attn_block(Qb, Kb, Vb, MIX, L + RING_OFF, bh >> 3, bh & 7, 7 - p, tid); __syncthreads(); }
        for (int it = gw; it < 2048; it += NGW) conv_task(U, state_conv, conv_w, conv_b, ln_g, ln_b, MIX, out, (LAS float*)vst, it, lane);
    }
    xcd_barrier(bar);

    {
        pg8::Gemm g{MIX, W2t, MP, DM, DM}; pg8::StaticOrder S; S.init(MP, DM, G, bx);
        pg8::EpiOut E{x_p, x_s, X1b, SSQ};
        pg8::gemm_phase<pg8::EpiOut, pg8::StaticOrder, true, true>(L + RING_OFF, g, S, E);
    }
    xcd_barrier(bar);

#define P4_PROMPT() do { pg8::Gemm g{X1b, W3t, MP, 2 * DFF, DM}; pg8::StaticOrder S; S.init(MP, 2 * DFF, G, bx); pg8::EpiGateUp E{SSQ, HID, (LAS float*)(L + RSTAB_OFF), 0}; \
        pg8::gemm_phase<pg8::EpiGateUp, pg8::StaticOrder, true, true>(L + RING_OFF, g, S, E); } while (0)
#define STREAM_TASK() do { if (G == 256) { stream_fused(cache_k, cache_v, NKs, NVs, out, Qb, PART, L + RING_OFF, vcu >> 1, vcu & 1, tid); \
        if ((vcu & 1) == 0) conv_samp_wg(U, state_conv, conv_w, conv_b, ln_g, ln_b, MIX, out, (LAS float*)(L + RSTAB_OFF), vcu >> 1, wave, lane); } } while (0)
    if (vcu & 1) { P4_PROMPT(); __syncthreads(); STREAM_TASK(); }
    else         { STREAM_TASK(); __syncthreads(); P4_PROMPT(); }
#undef P4_PROMPT
#undef STREAM_TASK
    xcd_barrier(bar);

    for (int it = gw; it < 2 * MS; it += NGW) combine_task(PART, MIX, it >> 4, (it >> 1) & 7, it & 1, lane);
    xcd_barrier(bar);
    if (G == 256) small_gemm<0>(MIX + (size_t)MP * DM, DM, W2t, DM, vcu, (LAS float*)(L + RING_OFF), x_s, X1b, SSQ, out, tid);
    xcd_barrier(bar);
    {
        constexpr int N_P4S = (MS / 256) * (2 * DFF / 256);
        const bool has_p4s = bx < N_P4S;
        { pg8::Gemm g{X1b + (size_t)MP * DM, W3t, MS, 2 * DFF, DM}; pg8::StaticOrder S; S.init(MS, 2 * DFF, G, bx); pg8::EpiGateUp E{SSQ, HID, (LAS float*)(L + RSTAB_OFF), MP};
          pg8::gemm_phase<pg8::EpiGateUp, pg8::StaticOrder, true, true>(L + RING_OFF, g, S, E); }
        asm volatile("s_waitcnt vmcnt(0)" ::: "memory");
        __syncthreads();
        if (has_p4s && tid == 0) { __builtin_amdgcn_s_waitcnt(0); __builtin_amdgcn_fence(__ATOMIC_RELEASE, "agent"); asm volatile("s_waitcnt vmcnt(0)" ::: "memory"); (void)xb_add((unsigned*)(ctl + CW_P4S), 1u); }
        { pg8::Gemm g{HID, W4t, MP, DM, DFF}; pg8::StaticOrder S; S.init(MP, DM, G, bx); pg8::EpiDown E{X1b, out};
          pg8::gemm_phase<pg8::EpiDown, pg8::StaticOrder, true, true>(L + RING_OFF, g, S, E); }
        if (G == 256 && !has_p4s) {
            if (tid == 0) { unsigned* cnt = (unsigned*)(ctl + CW_P4S); XB_SPIN(xb_ld(cnt) < (unsigned)N_P4S, (unsigned*)(ctl + CW_BAR));
                __builtin_amdgcn_fence(__ATOMIC_ACQUIRE, "agent"); asm volatile("s_waitcnt vmcnt(0)" ::: "memory"); }
            __syncthreads();
            for (int tile = bx - N_P4S; tile < 256; tile += 256 - N_P4S)
                small_gemm<1>(HID + (size_t)MP * DFF, DFF, W4t, DFF, tile, (LAS float*)(L + RING_OFF), x_s, X1b, SSQ, out, tid);
        }
    }
}

extern "C" void kernel_launch(void* const* d_in, const int* in_sizes, int n_in, void* d_out, int out_size, void* d_ws, size_t ws_size, hipStream_t stream) {
    static int grid = 0;
    if (grid == 0) {
        if (n_in != 18 || (size_t)out_size != O_END || ws_size < WS_END) { fprintf(stderr, "kernel_launch: unexpected shapes (n_in %d, out %d, ws %zu); nothing launched\n", n_in, out_size, ws_size); grid = -1; return; }
        int dev = 0, cus = 0, per_cu = 0;
        if (hipGetDevice(&dev) != hipSuccess || hipDeviceGetAttribute(&cus, hipDeviceAttributeMultiprocessorCount, dev) != hipSuccess) { grid = -1; return; }
        if (hipFuncSetAttribute((const void*)hymba_fwd, hipFuncAttributeMaxDynamicSharedMemorySize, LDS_BYTES) != hipSuccess) { fprintf(stderr, "kernel_launch: hipFuncSetAttribute failed\n"); grid = -1; return; }
        if (hipOccupancyMaxActiveBlocksPerMultiprocessor(&per_cu, (const void*)hymba_fwd, NWAVES * 64, LDS_BYTES) != hipSuccess || per_cu < 1)
            fprintf(stderr, "kernel_launch: note: occupancy query reports %d workgroups per CU\n", per_cu);
        (void)hipGetLastError();
        grid = cus;
        if (grid != 256) fprintf(stderr, "kernel_launch: built for a 256-CU device (MI355X); %d CUs found: the sample-group phases will not run\n", grid);
    }
    if (grid < 0) return;
    if (hipMemsetAsync((char*)d_ws + WS_CTL, 0, CTL_ZERO_BYTES, stream) != hipSuccess) return;
    Args a{};
    for (int i = 0; i < 18; ++i) a.in[i] = (const float*)d_in[i];
    a.out = (float*)d_out; a.ws = (unsigned char*)d_ws;
    hipLaunchKernelGGL(hymba_fwd, dim3(grid), dim3(NWAVES * 64), LDS_BYTES, stream, a);
}
```
